# Optimizing an MI355X kernel written in HIP

```python
import math
import jax
import jax.numpy as jnp
from jax import lax
import numpy as np

D_MODEL = 1024
BATCH = 8
SEQ = 4096
DEPTH = 1

D_MIX = D_MODEL
HGRN_WIDTH = D_MIX // 2
RET_WIDTH = D_MIX - HGRN_WIDTH
HGRN_HEADS = 4
HGRN_DK = HGRN_WIDTH // HGRN_HEADS
HGRN_DV = HGRN_WIDTH // HGRN_HEADS
RET_HEADS = 4
RET_DK = RET_WIDTH // RET_HEADS
RET_DV = RET_WIDTH // RET_HEADS
CHUNK = 64
ROPE_BASE = 10000.0
PROJ_SIZES = (HGRN_HEADS * HGRN_DK, HGRN_HEADS * HGRN_DK, HGRN_HEADS * HGRN_DV, HGRN_HEADS * HGRN_DV,
              RET_HEADS * RET_DK, RET_HEADS * RET_DK, RET_HEADS * RET_DV, RET_HEADS * RET_DV)
D_PROJ = sum(PROJ_SIZES)
N_GROUPS = 4
EXPERTS_PER_GROUP = 8
N_EXPERTS = N_GROUPS * EXPERTS_PER_GROUP
TOP_K = 2
D_EXPERT = D_MODEL // 2
MOE_BLOCK = 128
DEEPNORM_ALPHA = (2.0 * DEPTH) ** 0.25
DEEPNORM_BETA = (8.0 * DEPTH) ** -0.25
LN_EPS = 1e-5

kernel_name = "hymba_style_hgrn2_retention_hmoe_deepnorm_adaln"


def _layer_norm(x, w=None, b=None):
    xf = x.astype(jnp.float32)
    mu = jnp.mean(xf, axis=-1, keepdims=True)
    var = jnp.mean(jnp.square(xf - mu), axis=-1, keepdims=True)
    y = (xf - mu) * lax.rsqrt(var + LN_EPS)
    if w is not None:
        y = y * w.astype(jnp.float32) + b.astype(jnp.float32)
    return y.astype(x.dtype)


def _head_rms_norm(o, w):
    H, d = o.shape[2], o.shape[3]
    o = o * lax.rsqrt(jnp.mean(jnp.square(o), axis=-1, keepdims=True) + LN_EPS)
    return o * w.astype(jnp.float32).reshape(H, d)


def _head_group_norm(o, w):
    H, d = o.shape[2], o.shape[3]
    mu = jnp.mean(o, axis=-1, keepdims=True)
    var = jnp.mean(jnp.square(o - mu), axis=-1, keepdims=True)
    return (o - mu) * lax.rsqrt(var + LN_EPS) * w.astype(jnp.float32).reshape(H, d)


def _to_chunks(t):
    B, S, H, d = t.shape
    return t.reshape(B, S // CHUNK, CHUNK, H, d).transpose(0, 3, 1, 2, 4)


def _from_chunks(t):
    B, H, N, C, d = t.shape
    return t.transpose(0, 2, 3, 1, 4).reshape(B, N * C, H, d)


def _chunk_state_scan(decay, kv):
    B, H, N, dk, dv = kv.shape

    def step(state, inp):
        d_n, kv_n = inp
        return d_n[..., None] * state + kv_n, state

    s0 = jnp.zeros((B, H, dk, dv), kv.dtype)
    _, s_before = lax.scan(step, s0, (jnp.moveaxis(decay, 2, 0), jnp.moveaxis(kv, 2, 0)))
    return jnp.moveaxis(s_before, 0, 2)


def _hgrn2_chunkwise(q, log_f, k, v):
    C = q.shape[3]
    causal = jnp.tril(jnp.ones((C, C), dtype=bool))
    b = jnp.cumsum(log_f, axis=3)
    q_in = q * jnp.exp(b)
    k_in = k * jnp.exp(-b)
    a = jnp.where(causal, jnp.einsum('bhntd,bhnsd->bhnts', q_in, k_in), 0.0)
    o_intra = jnp.einsum('bhnts,bhnsv->bhntv', a, v)
    b_last = b[:, :, :, -1:, :]
    kv = jnp.einsum('bhnsd,bhnsv->bhndv', k * jnp.exp(b_last - b), v)
    s_before = _chunk_state_scan(jnp.exp(b_last[:, :, :, 0, :]), kv)
    return o_intra + jnp.einsum('bhntd,bhndv->bhntv', q_in, s_before)


def _retention_chunkwise(q, k, v, log_gamma):
    C = q.shape[3]
    idx = jnp.arange(C, dtype=jnp.float32)
    rel = idx[:, None] - idx[None, :]
    causal = rel >= 0
    dmat = jnp.where(causal, jnp.exp(jnp.where(causal, rel, 0.0)[None] * log_gamma[:, None, None]), 0.0)
    scores = jnp.einsum('bhntd,bhnsd->bhnts', q, k) * dmat[None, :, None]
    o_intra = jnp.einsum('bhnts,bhnsv->bhntv', scores, v)
    k_decay = jnp.exp((C - 1.0 - idx)[None, :] * log_gamma[:, None])
    kv = jnp.einsum('bhnsd,bhnsv->bhndv', k * k_decay[None, :, None, :, None], v)
    B, H, N = q.shape[0], q.shape[1], q.shape[2]
    chunk_decay = jnp.broadcast_to(jnp.exp(C * log_gamma)[None, :, None, None], (B, H, N, 1))
    s_before = _chunk_state_scan(chunk_decay, kv)
    q_decay = jnp.exp((idx + 1.0)[None, :] * log_gamma[:, None])
    o_inter = jnp.einsum('bhntd,bhndv->bhntv', q, s_before) * q_decay[None, :, None, :, None]
    return o_intra + o_inter


def _rotary(t, cos, sin):
    half = t.shape[-1] // 2
    t1, t2 = t[..., :half], t[..., half:]
    return jnp.concatenate([t1 * cos - t2 * sin, t1 * sin + t2 * cos], axis=-1)


def _hybrid_mixer(h, positions, w_in, w_out, lb, hgrn_norm_w, ret_norm_w):
    B, S, _ = h.shape
    proj = jnp.einsum('bsd,de->bse', h, w_in).astype(jnp.float32)
    offs = np.cumsum(PROJ_SIZES)[:-1].tolist()
    hq, hf, hi, hg, rq, rk, rv, rg = jnp.split(proj, offs, axis=-1)

    lbh = lb.astype(jnp.float32).reshape(HGRN_HEADS, HGRN_DK)
    z = hf.reshape(B, S, HGRN_HEADS, HGRN_DK)
    log_f = jnp.log(lbh + (1.0 - lbh) * jax.nn.sigmoid(z))
    k_a = (1.0 - lbh) * jax.nn.sigmoid(-z)
    q_a = jax.nn.silu(hq.reshape(B, S, HGRN_HEADS, HGRN_DK))
    v_a = hi.reshape(B, S, HGRN_HEADS, HGRN_DV)
    o_a = _from_chunks(_hgrn2_chunkwise(_to_chunks(q_a), _to_chunks(log_f), _to_chunks(k_a), _to_chunks(v_a)))
    o_a = _head_rms_norm(o_a, hgrn_norm_w) * jax.nn.silu(hg.reshape(B, S, HGRN_HEADS, HGRN_DV))

    inv_freq = jnp.power(ROPE_BASE, -jnp.arange(0, RET_DK, 2, dtype=jnp.float32) / RET_DK)
    ang = positions.astype(jnp.float32)[..., None] * inv_freq
    cos = jnp.cos(ang)[:, :, None, :]
    sin = jnp.sin(ang)[:, :, None, :]
    q_b = _rotary(rq.reshape(B, S, RET_HEADS, RET_DK), cos, sin) * (RET_DK ** -0.5)
    k_b = _rotary(rk.reshape(B, S, RET_HEADS, RET_DK), cos, sin)
    v_b = rv.reshape(B, S, RET_HEADS, RET_DV)
    log_gamma = jnp.log(1.0 - jnp.exp2(-5.0 - jnp.arange(RET_HEADS, dtype=jnp.float32)))
    o_b = _from_chunks(_retention_chunkwise(_to_chunks(q_b), _to_chunks(k_b), _to_chunks(v_b), log_gamma))
    o_b = _head_group_norm(o_b, ret_norm_w) * jax.nn.silu(rg.reshape(B, S, RET_HEADS, RET_DV))

    o = jnp.concatenate([o_a.reshape(B, S, -1), o_b.reshape(B, S, -1)], axis=-1).astype(h.dtype)
    return jnp.einsum('bse,ed->bsd', o, w_out)


def _grouped_experts(x, expert_idx, gates, w_gate, w_up, w_down):
    N, D = x.shape
    K = expert_idx.shape[1]
    E = w_gate.shape[0]
    flat_e = expert_idx.reshape(-1)
    flat_tok = jnp.repeat(jnp.arange(N, dtype=jnp.int32), K)
    flat_g = gates.reshape(-1)
    order = jnp.argsort(flat_e)
    se, stok, sg = flat_e[order], flat_tok[order], flat_g[order]
    counts = jnp.bincount(flat_e, length=E).astype(jnp.int32)
    starts = jnp.cumsum(counts) - counts
    padded = ((counts + MOE_BLOCK - 1) // MOE_BLOCK) * MOE_BLOCK
    pends = jnp.cumsum(padded)
    pstarts = pends - padded
    dest = pstarts[se] + (jnp.arange(N * K, dtype=jnp.int32) - starts[se])
    n_slots = ((N * K + MOE_BLOCK - 1) // MOE_BLOCK) * MOE_BLOCK + E * MOE_BLOCK
    slot_tok = jnp.full((n_slots,), N, dtype=jnp.int32).at[dest].set(stok)
    slot_g = jnp.zeros((n_slots,), x.dtype).at[dest].set(sg)
    n_blocks = n_slots // MOE_BLOCK
    block_start = jnp.arange(n_blocks, dtype=jnp.int32) * MOE_BLOCK
    block_e = jnp.minimum(jnp.searchsorted(pends, block_start, side='right'), E - 1).astype(jnp.int32)
    x_pad = jnp.concatenate([x, jnp.zeros((1, D), x.dtype)], axis=0)
    xb = x_pad[slot_tok].reshape(n_blocks, MOE_BLOCK, D)

    def expert_block(args):
        xblk, e = args
        a = xblk @ w_gate[e]
        u = xblk @ w_up[e]
        return (jax.nn.silu(a) * u) @ w_down[e]

    yb = lax.map(expert_block, (xb, block_e)).reshape(n_slots, D)
    out = jnp.zeros((N + 1, D), x.dtype).at[slot_tok].add(yb * slot_g[:, None])
    return out[:N]


def _hierarchical_moe(h, w_rg, b_rg, w_re, b_re, w_gate, w_up, w_down):
    B, S, D = h.shape
    x = h.reshape(B * S, D)
    g_logits = (x @ w_rg).astype(jnp.float32) + b_rg.astype(jnp.float32)
    g_prob = jax.nn.softmax(g_logits, axis=-1)
    g_star = jnp.argmax(g_logits, axis=-1).astype(jnp.int32)
    p_star = jnp.take_along_axis(g_prob, g_star[:, None], axis=1)
    e_logits = ((x @ w_re).astype(jnp.float32) + b_re.astype(jnp.float32)).reshape(-1, N_GROUPS, EXPERTS_PER_GROUP)
    e_sel = jnp.take_along_axis(e_logits, g_star[:, None, None], axis=1)[:, 0]
    top_v, top_i = lax.top_k(e_sel, TOP_K)
    gates = (p_star * jax.nn.softmax(top_v, axis=-1)).astype(h.dtype)
    expert_idx = (g_star[:, None] * EXPERTS_PER_GROUP + top_i).astype(jnp.int32)
    y = _grouped_experts(x, expert_idx, gates, w_gate, w_up, w_down)
    return y.reshape(B, S, D)


def setup_inputs(seed: int = 0) -> dict:
    key = jax.random.key(seed)
    ks = jax.random.split(key, 24)
    f32 = jnp.float32

    def nrm(k, shape, s):
        return s * jax.random.normal(k, shape, f32)

    beta = DEEPNORM_BETA
    col_scale = jnp.concatenate([
        jnp.full((PROJ_SIZES[0],), 1.0, f32), jnp.full((PROJ_SIZES[1],), 1.0, f32),
        jnp.full((PROJ_SIZES[2],), beta, f32), jnp.full((PROJ_SIZES[3],), 1.0, f32),
        jnp.full((PROJ_SIZES[4],), 1.0, f32), jnp.full((PROJ_SIZES[5],), 1.0, f32),
        jnp.full((PROJ_SIZES[6],), beta, f32), jnp.full((PROJ_SIZES[7],), 1.0, f32)])
    return {
        "x": jax.random.normal(ks[0], (BATCH, SEQ, D_MODEL), f32),
        "c": jax.random.normal(ks[1], (BATCH, D_MODEL), f32),
        "positions": jnp.tile(jnp.arange(SEQ, dtype=jnp.int32)[None, :], (BATCH, 1)),
        "w_ada": nrm(ks[2], (DEPTH, D_MODEL, 6 * D_MODEL), 0.5 * D_MODEL ** -0.5),
        "b_ada": nrm(ks[3], (DEPTH, 6 * D_MODEL), 0.01),
        "w_in": nrm(ks[4], (DEPTH, D_MODEL, D_PROJ), D_MODEL ** -0.5) * col_scale,
        "w_out": nrm(ks[5], (DEPTH, D_MIX, D_MODEL), D_MIX ** -0.5) * beta,
        "hgrn_lb": nrm(ks[6], (DEPTH + 1, HGRN_HEADS * HGRN_DK), 0.1),
        "hgrn_norm_w": 1.0 + nrm(ks[7], (DEPTH, HGRN_HEADS * HGRN_DV), 0.02),
        "ret_norm_w": 1.0 + nrm(ks[8], (DEPTH, RET_HEADS * RET_DV), 0.02),
        "post_ln1_w": 1.0 + nrm(ks[9], (DEPTH, D_MODEL), 0.02),
        "post_ln1_b": nrm(ks[10], (DEPTH, D_MODEL), 0.02),
        "w_rg": nrm(ks[11], (DEPTH, D_MODEL, N_GROUPS), D_MODEL ** -0.5),
        "b_rg": nrm(ks[12], (DEPTH, N_GROUPS), 0.01),
        "w_re": nrm(ks[13], (DEPTH, D_MODEL, N_EXPERTS), D_MODEL ** -0.5),
        "b_re": nrm(ks[14], (DEPTH, N_EXPERTS), 0.01),
        "w_gate": nrm(ks[15], (DEPTH, N_EXPERTS, D_MODEL, D_EXPERT), D_MODEL ** -0.5),
        "w_up": nrm(ks[16], (DEPTH, N_EXPERTS, D_MODEL, D_EXPERT), D_MODEL ** -0.5) * beta,
        "w_down": nrm(ks[17], (DEPTH, N_EXPERTS, D_EXPERT, D_MODEL), D_EXPERT ** -0.5) * beta,
        "post_ln2_w": 1.0 + nrm(ks[18], (DEPTH, D_MODEL), 0.02),
        "post_ln2_b": nrm(ks[19], (DEPTH, D_MODEL), 0.02),
    }


def reference(x, c, positions, w_ada, b_ada, w_in, w_out, hgrn_lb, hgrn_norm_w, ret_norm_w,
              post_ln1_w, post_ln1_b, w_rg, b_rg, w_re, b_re, w_gate, w_up, w_down,
              post_ln2_w, post_ln2_b):
    lb_all = jnp.cumsum(jax.nn.softmax(hgrn_lb.astype(jnp.float32), axis=0), axis=0)
    c_act = jax.nn.silu(c)
    for l in range(DEPTH):
        mod = c_act @ w_ada[l] + b_ada[l]
        shift1, scale1, gate1, shift2, scale2, gate2 = jnp.split(mod, 6, axis=-1)
        h = _layer_norm(x) * (1.0 + scale1[:, None, :]) + shift1[:, None, :]
        y = _hybrid_mixer(h, positions, w_in[l], w_out[l], lb_all[l], hgrn_norm_w[l], ret_norm_w[l])
        x = _layer_norm(DEEPNORM_ALPHA * x + gate1[:, None, :] * y, post_ln1_w[l], post_ln1_b[l])
        h = _layer_norm(x) * (1.0 + scale2[:, None, :]) + shift2[:, None, :]
        y = _hierarchical_moe(h, w_rg[l], b_rg[l], w_re[l], b_re[l], w_gate[l], w_up[l], w_down[l])
        x = _layer_norm(DEEPNORM_ALPHA * x + gate2[:, None, :] * y, post_ln2_w[l], post_ln2_b[l])
    return x
```

```cpp
#include <hip/hip_runtime.h>
#include <stdint.h>
#include <cstdio>

constexpr int NB = 8, NS = 4096, DM = 1024, MTOK = NB * NS, DPROJ = 4096;
constexpr int NEXP = 32, DEXP = 512;
constexpr int NCHUNK = MTOK / 64;
constexpr float LN_EPS = 1e-5f;
constexpr float DN_ALPHA = 1.189207115002721f;
constexpr int NSLOT = 73728;

constexpr size_t MiB = 1u << 20;
constexpr size_t WS_CTL = 0;
constexpr size_t WS_MOD = 1 * MiB;
constexpr size_t WS_LB = 1 * MiB + 512 * 1024;
constexpr size_t WS_ROUTE = 2 * MiB;
constexpr size_t WS_LIST = 4 * MiB;
constexpr size_t WS_COS = 8 * MiB;
constexpr size_t WS_SIN = 16 * MiB;
constexpr size_t WS_DEC = 24 * MiB;
constexpr size_t WS_WIN = 26 * MiB;
constexpr size_t WS_WOUT = 34 * MiB;
constexpr size_t WS_WGU = 36 * MiB;
constexpr size_t WS_WDN = 100 * MiB;
constexpr size_t WS_HB = 132 * MiB;
constexpr size_t WS_QI = 196 * MiB;
constexpr size_t WS_KI = 260 * MiB;
constexpr size_t WS_V = 324 * MiB;
constexpr size_t WS_G = 388 * MiB;
constexpr size_t WS_ACT = 196 * MiB;
constexpr size_t WS_Y = 268 * MiB;
constexpr size_t WS_END = 452 * MiB;
constexpr int CW_CNT = 64;

typedef unsigned short bf16_t;
__device__ __forceinline__ bf16_t f2bf(float f) { unsigned u = __builtin_bit_cast(unsigned, f); return (bf16_t)((u + 0x7fffu + ((u >> 16) & 1u)) >> 16); }
__device__ __forceinline__ float bf2f(bf16_t h) { return __builtin_bit_cast(float, (unsigned)h << 16); }
__device__ __forceinline__ float sigmoidf_(float x) { return 1.f / (1.f + __expf(-x)); }
__device__ __forceinline__ float siluf_(float x) { return x / (1.f + __expf(-x)); }
__device__ __forceinline__ float wave_sum(float v) {
#pragma unroll
    for (int o = 1; o < 64; o <<= 1) v += __shfl_xor(v, o);
    return v;
}
__device__ __forceinline__ float log2gamma(int h) {
    return h == 0 ? -0.04580368961312479f : h == 1 ? -0.02272007650008353f : h == 2 ? -0.011315313227834146f : -0.005646563141142063f;
}

struct Ptrs {
    const float *x, *c; const int* pos; const float *w_ada, *b_ada, *w_in, *w_out, *hgrn_lb, *hgrn_nw, *ret_nw, *ln1w, *ln1b, *w_rg, *b_rg, *w_re, *b_re, *w_gate, *w_up, *w_down, *ln2w, *ln2b;
    float* out; unsigned char* ws;
};

__global__ void __launch_bounds__(256) k_prep(Ptrs p) {
    const int gt = blockIdx.x * blockDim.x + threadIdx.x, NT = gridDim.x * blockDim.x;
    float* mod = (float*)(p.ws + WS_MOD);
    for (int i = gt; i < 8 * 6144; i += NT) {
        const int b = i / 6144, j = i % 6144;
        float acc = p.b_ada[j];
        for (int k = 0; k < DM; ++k) acc += siluf_(p.c[b * DM + k]) * p.w_ada[(size_t)k * 6144 + j];
        mod[i] = acc;
    }
    float* lb = (float*)(p.ws + WS_LB);
    for (int i = gt; i < 512; i += NT) { const float a = p.hgrn_lb[i], b = p.hgrn_lb[512 + i]; const float mx = fmaxf(a, b); const float ea = __expf(a - mx), eb = __expf(b - mx); lb[i] = ea / (ea + eb); }
    float* cs = (float*)(p.ws + WS_COS); float* sn = (float*)(p.ws + WS_SIN);
    for (int i = gt; i < MTOK * 64; i += NT) {
        const int m = i >> 6, f = i & 63;
        const double inv = exp2(-(double)(2 * f) / 128.0 * 13.287712379549449);
        const double ang = (double)p.pos[m] * inv;
        double s, c; sincos(ang, &s, &c);
        cs[i] = (float)c; sn[i] = (float)s;
    }
}

__global__ void __launch_bounds__(256) k_h1(Ptrs p) {
    const int lane = threadIdx.x & 63, gw = (blockIdx.x * blockDim.x + threadIdx.x) >> 6, NW = (gridDim.x * blockDim.x) >> 6;
    const float* mod = (const float*)(p.ws + WS_MOD); bf16_t* hb = (bf16_t*)(p.ws + WS_HB);
    for (int m = gw; m < MTOK; m += NW) {
        const int b = m / NS; const float* xr = p.x + (size_t)m * DM;
        float v[16]; float s = 0.f;
#pragma unroll
        for (int j = 0; j < 16; ++j) { v[j] = xr[lane + 64 * j]; s += v[j]; }
        const float mean = wave_sum(s) * (1.f / DM); float q = 0.f;
#pragma unroll
        for (int j = 0; j < 16; ++j) { v[j] -= mean; q += v[j] * v[j]; }
        const float rstd = 1.f / sqrtf(wave_sum(q) * (1.f / DM) + LN_EPS);
#pragma unroll
        for (int j = 0; j < 16; ++j) { const int col = lane + 64 * j; hb[(size_t)m * DM + col] = f2bf(v[j] * rstd * (1.f + mod[b * 6144 + 1024 + col]) + mod[b * 6144 + col]); }
    }
}

template <class LA, class LB>
__device__ __forceinline__ void naive_tile(float (&acc)[4][4], LA la, LB lb, int K, float* As, float* Bs) {
    const int tid = threadIdx.x, ty = tid >> 4, tx = tid & 15;
#pragma unroll
    for (int i = 0; i < 4; ++i)
#pragma unroll
        for (int j = 0; j < 4; ++j) acc[i][j] = 0.f;
    for (int k0 = 0; k0 < K; k0 += 16) {
        __syncthreads();
#pragma unroll
        for (int i = 0; i < 4; ++i) { const int idx = tid + 256 * i; const int r = idx >> 4, k = idx & 15; As[k * 68 + r] = la(r, k0 + k); }
#pragma unroll
        for (int i = 0; i < 4; ++i) { const int idx = tid + 256 * i; const int k = idx >> 6, c = idx & 63; Bs[k * 64 + c] = lb(k0 + k, c); }
        __syncthreads();
#pragma unroll
        for (int kk = 0; kk < 16; ++kk) {
            float a[4], b[4];
#pragma unroll
            for (int i = 0; i < 4; ++i) a[i] = As[kk * 68 + ty * 4 + i];
#pragma unroll
            for (int j = 0; j < 4; ++j) b[j] = Bs[kk * 64 + tx * 4 + j];
#pragma unroll
            for (int i = 0; i < 4; ++i)
#pragma unroll
                for (int j = 0; j < 4; ++j) acc[i][j] += a[i] * b[j];
        }
    }
}

__global__ void __launch_bounds__(256) k_proj(Ptrs p) {
    __shared__ float As[16 * 68], Bs[16 * 64], L[64 * 65];
    const int rc = blockIdx.x, job = blockIdx.y, tid = threadIdx.x, ty = tid >> 4, tx = tid & 15;
    const bf16_t* hb = (const bf16_t*)(p.ws + WS_HB);
    bf16_t* QI = (bf16_t*)(p.ws + WS_QI); bf16_t* KI = (bf16_t*)(p.ws + WS_KI); bf16_t* V = (bf16_t*)(p.ws + WS_V); bf16_t* G = (bf16_t*)(p.ws + WS_G);
    const int m0 = rc * 64;
    auto la = [&](int r, int k) { return bf2f(hb[(size_t)(m0 + r) * DM + k]); };
    float a0[4][4], a1[4][4];
    if (job < 8) {
        const int h = job >> 1, cg = job & 1, c0 = h * 128 + cg * 64;
        naive_tile(a0, la, [&](int k, int c) { return p.w_in[(size_t)k * DPROJ + c0 + c]; }, DM, As, Bs);
        naive_tile(a1, la, [&](int k, int c) { return p.w_in[(size_t)k * DPROJ + 512 + c0 + c]; }, DM, As, Bs);
        const float* lbv = (const float*)(p.ws + WS_LB);
        float kk[4][4];
        __syncthreads();
#pragma unroll
        for (int i = 0; i < 4; ++i)
#pragma unroll
            for (int j = 0; j < 4; ++j) { const float lb = lbv[c0 + tx * 4 + j], z = a1[i][j]; const float f = lb + (1.f - lb) * sigmoidf_(z); L[(ty * 4 + i) * 65 + tx * 4 + j] = logf(f); kk[i][j] = (1.f - lb) * sigmoidf_(-z); }
        __syncthreads();
        if (tid < 64) { float s = 0.f; for (int r = 0; r < 64; ++r) { s += L[r * 65 + tid]; L[r * 65 + tid] = s; } }
        __syncthreads();
#pragma unroll
        for (int i = 0; i < 4; ++i)
#pragma unroll
            for (int j = 0; j < 4; ++j) { const int r = ty * 4 + i, c = tx * 4 + j; const float b = L[r * 65 + c]; const size_t o = (size_t)(m0 + r) * DM + c0 + c;
                QI[o] = f2bf(siluf_(a0[i][j]) * __expf(b)); KI[o] = f2bf(kk[i][j] * __expf(-b)); }
        if (tid < 64) ((float*)(p.ws + WS_DEC))[(size_t)rc * 512 + c0 + tid] = __expf(L[63 * 65 + tid]);
    } else if (job < 16) {
        const int isk = job >= 12, h = (job - 8) & 3, c0 = (isk ? 2560 : 2048) + h * 128;
        naive_tile(a0, la, [&](int k, int c) { return p.w_in[(size_t)k * DPROJ + c0 + c]; }, DM, As, Bs);
        naive_tile(a1, la, [&](int k, int c) { return p.w_in[(size_t)k * DPROJ + c0 + 64 + c]; }, DM, As, Bs);
        const float* cs = (const float*)(p.ws + WS_COS); const float* sn = (const float*)(p.ws + WS_SIN);
        bf16_t* dst = isk ? KI : QI;
#pragma unroll
        for (int i = 0; i < 4; ++i)
#pragma unroll
            for (int j = 0; j < 4; ++j) { const int r = ty * 4 + i, c = tx * 4 + j, m = m0 + r; const float co = cs[(size_t)m * 64 + c], si = sn[(size_t)m * 64 + c];
                const float t1 = a0[i][j], t2 = a1[i][j]; const float e = (float)(r + 1) * log2gamma(h);
                const float sc = isk ? exp2f(-e) : exp2f(e) * 0.08838834764831845f;
                const size_t o = (size_t)m * DM + 512 + h * 128 + c;
                dst[o] = f2bf((t1 * co - t2 * si) * sc); dst[o + 64] = f2bf((t1 * si + t2 * co) * sc); }
    } else {
        const int idx = job - 16, seg = idx >> 3, cb = idx & 7;
        const int c0 = (seg == 0 ? 1024 : seg == 1 ? 1536 : seg == 2 ? 3072 : 3584) + cb * 64;
        naive_tile(a0, la, [&](int k, int c) { return p.w_in[(size_t)k * DPROJ + c0 + c]; }, DM, As, Bs);
        bf16_t* dst = (seg == 0 || seg == 2) ? V : G; const int oc = (seg >= 2 ? 512 : 0) + cb * 64;
#pragma unroll
        for (int i = 0; i < 4; ++i)
#pragma unroll
            for (int j = 0; j < 4; ++j) { const int r = ty * 4 + i, c = tx * 4 + j; const float v = a0[i][j];
                dst[(size_t)(m0 + r) * DM + oc + c] = f2bf((seg == 0 || seg == 2) ? v : siluf_(v)); }
    }
}

__global__ void __launch_bounds__(512) k_mixer(Ptrs p) {
    __shared__ float qs[128], ks[128], part[4][128], red[16];
    const int b = blockIdx.x >> 3, mh = blockIdx.x & 7, tid = threadIdx.x, j = tid & 127, g = tid >> 7;
    const bf16_t* QI = (const bf16_t*)(p.ws + WS_QI); const bf16_t* KI = (const bf16_t*)(p.ws + WS_KI); const bf16_t* V = (const bf16_t*)(p.ws + WS_V); const bf16_t* G = (const bf16_t*)(p.ws + WS_G);
    const float* DEC = (const float*)(p.ws + WS_DEC); bf16_t* O = (bf16_t*)(p.ws + WS_HB);
    float st[32];
#pragma unroll
    for (int i = 0; i < 32; ++i) st[i] = 0.f;
    const float nw = mh < 4 ? p.hgrn_nw[mh * 128 + j] : p.ret_nw[(mh - 4) * 128 + j];
    for (int s = 0; s < NS; ++s) {
        const size_t m = (size_t)b * NS + s;
        __syncthreads();
        if (tid < 128) qs[tid] = bf2f(QI[m * DM + mh * 128 + tid]); else if (tid < 256) ks[tid - 128] = bf2f(KI[m * DM + mh * 128 + tid - 128]);
        const float v = bf2f(V[m * DM + mh * 128 + j]);
        __syncthreads();
        float acc = 0.f;
#pragma unroll
        for (int i = 0; i < 32; ++i) { st[i] += ks[g * 32 + i] * v; acc += st[i] * qs[g * 32 + i]; }
        part[g][j] = acc;
        if ((s & 63) == 63) {
            const int ch = (int)(m >> 6);
#pragma unroll
            for (int i = 0; i < 32; ++i) { const float d = mh < 4 ? DEC[(size_t)ch * 512 + mh * 128 + g * 32 + i] : exp2f(64.f * log2gamma(mh - 4)); st[i] *= d; }
        }
        __syncthreads();
        float o = 0.f, s1 = 0.f, s2 = 0.f;
        if (tid < 128) { o = part[0][j] + part[1][j] + part[2][j] + part[3][j]; s1 = wave_sum(o); s2 = wave_sum(o * o); if ((tid & 63) == 0) { red[(tid >> 6) * 2] = s1; red[(tid >> 6) * 2 + 1] = s2; } }
        __syncthreads();
        if (tid < 128) {
            const float t1 = red[0] + red[2], t2 = red[1] + red[3]; float r;
            if (mh < 4) r = o * (1.f / sqrtf(t2 * (1.f / 128.f) + LN_EPS));
            else { const float mu = t1 * (1.f / 128.f); const float var = fmaxf(t2 * (1.f / 128.f) - mu * mu, 0.f); r = (o - mu) * (1.f / sqrtf(var + LN_EPS)); }
            O[m * DM + mh * 128 + j] = f2bf(r * nw * bf2f(G[m * DM + mh * 128 + j]));
        }
    }
}

__global__ void __launch_bounds__(256) k_outproj(Ptrs p) {
    __shared__ float As[16 * 68], Bs[16 * 64];
    const int m0 = blockIdx.x * 64, c0 = blockIdx.y * 64, tid = threadIdx.x, ty = tid >> 4, tx = tid & 15;
    const bf16_t* hb = (const bf16_t*)(p.ws + WS_HB); const float* mod = (const float*)(p.ws + WS_MOD);
    float a0[4][4];
    naive_tile(a0, [&](int r, int k) { return bf2f(hb[(size_t)(m0 + r) * DM + k]); }, [&](int k, int c) { return p.w_out[(size_t)k * DM + c0 + c]; }, DM, As, Bs);
    const int b = m0 / NS;
#pragma unroll
    for (int i = 0; i < 4; ++i)
#pragma unroll
        for (int j = 0; j < 4; ++j) { const int m = m0 + ty * 4 + i, c = c0 + tx * 4 + j; p.out[(size_t)m * DM + c] = DN_ALPHA * p.x[(size_t)m * DM + c] + mod[b * 6144 + 2048 + c] * a0[i][j]; }
}

__global__ void __launch_bounds__(256) k_route(Ptrs p) {
    const int lane = threadIdx.x & 63, gw = (blockIdx.x * blockDim.x + threadIdx.x) >> 6, NW = (gridDim.x * blockDim.x) >> 6;
    const float* mod = (const float*)(p.ws + WS_MOD); bf16_t* hb = (bf16_t*)(p.ws + WS_HB);
    int* cnt = (int*)(p.ws + WS_CTL) + CW_CNT; int* list = (int*)(p.ws + WS_LIST);
    int* re = (int*)(p.ws + WS_ROUTE); int* rp = re + 2 * MTOK; float* rg = (float*)(rp + 2 * MTOK);
    for (int m = gw; m < MTOK; m += NW) {
        const int b = m / NS; const float* ur = p.out + (size_t)m * DM;
        float v[16]; float s = 0.f;
#pragma unroll
        for (int j = 0; j < 16; ++j) { v[j] = ur[lane + 64 * j]; s += v[j]; }
        float mean = wave_sum(s) * (1.f / DM); float q = 0.f;
#pragma unroll
        for (int j = 0; j < 16; ++j) { v[j] -= mean; q += v[j] * v[j]; }
        float rstd = 1.f / sqrtf(wave_sum(q) * (1.f / DM) + LN_EPS);
        s = 0.f;
#pragma unroll
        for (int j = 0; j < 16; ++j) { const int col = lane + 64 * j; v[j] = v[j] * rstd * p.ln1w[col] + p.ln1b[col]; s += v[j]; }
        mean = wave_sum(s) * (1.f / DM); q = 0.f;
#pragma unroll
        for (int j = 0; j < 16; ++j) { v[j] -= mean; q += v[j] * v[j]; }
        rstd = 1.f / sqrtf(wave_sum(q) * (1.f / DM) + LN_EPS);
        float lg[36];
#pragma unroll
        for (int e = 0; e < 36; ++e) lg[e] = 0.f;
#pragma unroll
        for (int j = 0; j < 16; ++j) { const int col = lane + 64 * j; const float h = v[j] * rstd * (1.f + mod[b * 6144 + 4096 + col]) + mod[b * 6144 + 3072 + col];
            hb[(size_t)m * DM + col] = f2bf(h);
#pragma unroll
            for (int e = 0; e < 4; ++e) lg[e] += h * p.w_rg[col * 4 + e];
#pragma unroll
            for (int e = 0; e < 32; ++e) lg[4 + e] += h * p.w_re[col * 32 + e]; }
#pragma unroll
        for (int e = 0; e < 36; ++e) lg[e] = wave_sum(lg[e]);
        if (lane == 0) {
            float gl[4]; int gs = 0;
#pragma unroll
            for (int e = 0; e < 4; ++e) gl[e] = lg[e] + p.b_rg[e];
            float gmax = gl[0];
#pragma unroll
            for (int e = 1; e < 4; ++e) if (gl[e] > gmax) { gmax = gl[e]; gs = e; }
            float den = 0.f;
#pragma unroll
            for (int e = 0; e < 4; ++e) den += __expf(gl[e] - gmax);
            const float pstar = 1.f / den;
            float el[8];
#pragma unroll
            for (int e = 0; e < 8; ++e) { float t = 0.f;
#pragma unroll
                for (int g4 = 0; g4 < 4; ++g4) t = (gs == g4) ? lg[4 + g4 * 8 + e] + p.b_re[g4 * 8 + e] : t;
                el[e] = t; }
            int i1 = 0; float v1 = el[0];
#pragma unroll
            for (int e = 1; e < 8; ++e) if (el[e] > v1) { v1 = el[e]; i1 = e; }
            int i2 = -1; float v2 = -3.0e38f;
#pragma unroll
            for (int e = 0; e < 8; ++e) if (e != i1 && el[e] > v2) { v2 = el[e]; i2 = e; }
            const float w1 = 1.f / (1.f + __expf(v2 - v1));
            const int e1 = gs * 8 + i1, e2 = gs * 8 + i2;
            const int p1 = atomicAdd(&cnt[e1], 1), p2 = atomicAdd(&cnt[e2], 1);
            list[e1 * MTOK + p1] = m; list[e2 * MTOK + p2] = m;
            re[m] = e1; re[MTOK + m] = e2; rp[m] = p1; rp[MTOK + m] = p2; rg[m] = pstar * w1; rg[MTOK + m] = pstar * (1.f - w1);
        }
    }
}

__device__ __forceinline__ void moe_find(const int* cnt, int tile64, int& e, int& t, int& off) {
    int acc = 0, o = 0; e = -1;
    for (int i = 0; i < NEXP; ++i) { const int c = cnt[i], nt = (c + 63) >> 6; if (e < 0 && tile64 < acc + nt) { e = i; t = tile64 - acc; off = o; } acc += nt; o += ((c + 255) >> 8) << 8; }
}

__global__ void __launch_bounds__(256) k_moe_up(Ptrs p) {
    __shared__ float As[16 * 68], Bs[16 * 64]; __shared__ int toks[64];
    const int* cnt = (const int*)(p.ws + WS_CTL) + CW_CNT; const int* list = (const int*)(p.ws + WS_LIST);
    int e, t, off; moe_find(cnt, blockIdx.x, e, t, off); if (e < 0) return;
    const int tid = threadIdx.x, ty = tid >> 4, tx = tid & 15, c0 = blockIdx.y * 64, n = cnt[e];
    if (tid < 64) toks[tid] = (t * 64 + tid < n) ? list[e * MTOK + t * 64 + tid] : 0;
    __syncthreads();
    const bf16_t* hb = (const bf16_t*)(p.ws + WS_HB); bf16_t* act = (bf16_t*)(p.ws + WS_ACT);
    const float* wg = p.w_gate + (size_t)e * DM * DEXP; const float* wu = p.w_up + (size_t)e * DM * DEXP;
    float a0[4][4], a1[4][4];
    auto la = [&](int r, int k) { return bf2f(hb[(size_t)toks[r] * DM + k]); };
    naive_tile(a0, la, [&](int k, int c) { return wg[(size_t)k * DEXP + c0 + c]; }, DM, As, Bs);
    naive_tile(a1, la, [&](int k, int c) { return wu[(size_t)k * DEXP + c0 + c]; }, DM, As, Bs);
#pragma unroll
    for (int i = 0; i < 4; ++i)
#pragma unroll
        for (int j = 0; j < 4; ++j) { const int r = t * 64 + ty * 4 + i; if (r < n) act[(size_t)(off + r) * DEXP + c0 + tx * 4 + j] = f2bf(siluf_(a0[i][j]) * a1[i][j]); }
}
__global__ void __launch_bounds__(256) k_moe_down(Ptrs p) {
    __shared__ float As[16 * 68], Bs[16 * 64];
    const int* cnt = (const int*)(p.ws + WS_CTL) + CW_CNT;
    int e, t, off; moe_find(cnt, blockIdx.x, e, t, off); if (e < 0) return;
    const int tid = threadIdx.x, ty = tid >> 4, tx = tid & 15, c0 = blockIdx.y * 64, n = cnt[e];
    const bf16_t* act = (const bf16_t*)(p.ws + WS_ACT); bf16_t* Y = (bf16_t*)(p.ws + WS_Y);
    const float* wd = p.w_down + (size_t)e * DEXP * DM;
    float a0[4][4];
    naive_tile(a0, [&](int r, int k) { const int rr = t * 64 + r; return rr < n ? bf2f(act[(size_t)(off + rr) * DEXP + k]) : 0.f; }, [&](int k, int c) { return wd[(size_t)k * DM + c0 + c]; }, DEXP, As, Bs);
#pragma unroll
    for (int i = 0; i < 4; ++i)
#pragma unroll
        for (int j = 0; j < 4; ++j) { const int r = t * 64 + ty * 4 + i; if (r < n) Y[(size_t)(off + r) * DM + c0 + tx * 4 + j] = f2bf(a0[i][j]); }
}

__global__ void __launch_bounds__(256) k_final(Ptrs p) {
    const int lane = threadIdx.x & 63, gw = (blockIdx.x * blockDim.x + threadIdx.x) >> 6, NW = (gridDim.x * blockDim.x) >> 6;
    const float* mod = (const float*)(p.ws + WS_MOD); const bf16_t* Y = (const bf16_t*)(p.ws + WS_Y);
    const int* cnt = (const int*)(p.ws + WS_CTL) + CW_CNT;
    const int* re = (const int*)(p.ws + WS_ROUTE); const int* rp = re + 2 * MTOK; const float* rg = (const float*)(rp + 2 * MTOK);
    int offs = 0, myoff = 0;
    for (int i = 0; i < NEXP; ++i) { if (i == (lane & 31)) myoff = offs; offs += ((cnt[i] + 255) >> 8) << 8; }
    for (int m = gw; m < MTOK; m += NW) {
        const int b = m / NS; float* ur = p.out + (size_t)m * DM;
        const int e1 = re[m], e2 = re[MTOK + m];
        const int s1 = __shfl(myoff, e1) + rp[m], s2 = __shfl(myoff, e2) + rp[MTOK + m];
        const float g1 = rg[m], g2 = rg[MTOK + m];
        float v[16]; float s = 0.f;
#pragma unroll
        for (int j = 0; j < 16; ++j) { v[j] = ur[lane + 64 * j]; s += v[j]; }
        float mean = wave_sum(s) * (1.f / DM); float q = 0.f;
#pragma unroll
        for (int j = 0; j < 16; ++j) { v[j] -= mean; q += v[j] * v[j]; }
        float rstd = 1.f / sqrtf(wave_sum(q) * (1.f / DM) + LN_EPS);
        s = 0.f;
#pragma unroll
        for (int j = 0; j < 16; ++j) { const int col = lane + 64 * j; const float x1 = v[j] * rstd * p.ln1w[col] + p.ln1b[col];
            const float y = g1 * bf2f(Y[(size_t)s1 * DM + col]) + g2 * bf2f(Y[(size_t)s2 * DM + col]);
            v[j] = DN_ALPHA * x1 + mod[b * 6144 + 5120 + col] * y; s += v[j]; }
        mean = wave_sum(s) * (1.f / DM); q = 0.f;
#pragma unroll
        for (int j = 0; j < 16; ++j) { v[j] -= mean; q += v[j] * v[j]; }
        rstd = 1.f / sqrtf(wave_sum(q) * (1.f / DM) + LN_EPS);
#pragma unroll
        for (int j = 0; j < 16; ++j) { const int col = lane + 64 * j; ur[col] = v[j] * rstd * p.ln2w[col] + p.ln2b[col]; }
    }
}

extern "C" void kernel_launch(void* const* d_in, const int* in_sizes, int n_in, void* d_out, int out_size, void* d_ws, size_t ws_size, hipStream_t stream) {
    if (n_in != 21 || out_size != MTOK * DM || ws_size < WS_END) { fprintf(stderr, "kernel_launch: unexpected shapes (n_in %d out %d ws %zu)\n", n_in, out_size, ws_size); return; }
    Ptrs p{};
    p.x = (const float*)d_in[0]; p.c = (const float*)d_in[1]; p.pos = (const int*)d_in[2]; p.w_ada = (const float*)d_in[3]; p.b_ada = (const float*)d_in[4];
    p.w_in = (const float*)d_in[5]; p.w_out = (const float*)d_in[6]; p.hgrn_lb = (const float*)d_in[7]; p.hgrn_nw = (const float*)d_in[8]; p.ret_nw = (const float*)d_in[9];
    p.ln1w = (const float*)d_in[10]; p.ln1b = (const float*)d_in[11]; p.w_rg = (const float*)d_in[12]; p.b_rg = (const float*)d_in[13]; p.w_re = (const float*)d_in[14]; p.b_re = (const float*)d_in[15];
    p.w_gate = (const float*)d_in[16]; p.w_up = (const float*)d_in[17]; p.w_down = (const float*)d_in[18]; p.ln2w = (const float*)d_in[19]; p.ln2b = (const float*)d_in[20];
    p.out = (float*)d_out; p.ws = (unsigned char*)d_ws;
    (void)hipMemsetAsync((char*)d_ws + WS_CTL, 0, MiB, stream);
    hipLaunchKernelGGL(k_prep, dim3(1024), dim3(256), 0, stream, p);
    hipLaunchKernelGGL(k_h1, dim3(1024), dim3(256), 0, stream, p);
    hipLaunchKernelGGL(k_proj, dim3(NCHUNK, 48), dim3(256), 0, stream, p);
    hipLaunchKernelGGL(k_mixer, dim3(64), dim3(512), 0, stream, p);
    hipLaunchKernelGGL(k_outproj, dim3(MTOK / 64, DM / 64), dim3(256), 0, stream, p);
    hipLaunchKernelGGL(k_route, dim3(1024), dim3(256), 0, stream, p);
    hipLaunchKernelGGL(k_moe_up, dim3(65536 / 64 + NEXP, DEXP / 64), dim3(256), 0, stream, p);
    hipLaunchKernelGGL(k_moe_down, dim3(65536 / 64 + NEXP, DM / 64), dim3(256), 0, stream, p);
    hipLaunchKernelGGL(k_final, dim3(1024), dim3(256), 0, stream, p);
}
```

```cpp
#include <hip/hip_runtime.h>
#include <stdint.h>
#include <cstdio>

constexpr int NB = 8, NS = 4096, DM = 1024, MTOK = NB * NS, DPROJ = 4096;
constexpr int NEXP = 32, DEXP = 512;
constexpr int NCHUNK = MTOK / 64;
constexpr float LN_EPS = 1e-5f;
constexpr float DN_ALPHA = 1.189207115002721f;
constexpr int NSLOT = 73728;

constexpr size_t MiB = 1u << 20;
constexpr size_t WS_CTL = 0;
constexpr size_t WS_MOD = 1 * MiB;
constexpr size_t WS_LB = 1 * MiB + 512 * 1024;
constexpr size_t WS_ROUTE = 2 * MiB;
constexpr size_t WS_LIST = 4 * MiB;
constexpr size_t WS_COS = 8 * MiB;
constexpr size_t WS_SIN = 16 * MiB;
constexpr size_t WS_DEC = 24 * MiB;
constexpr size_t WS_WIN = 26 * MiB;
constexpr size_t WS_WOUT = 34 * MiB;
constexpr size_t WS_WGU = 36 * MiB;
constexpr size_t WS_WDN = 100 * MiB;
constexpr size_t WS_HB = 132 * MiB;
constexpr size_t WS_QI = 196 * MiB;
constexpr size_t WS_KI = 260 * MiB;
constexpr size_t WS_V = 324 * MiB;
constexpr size_t WS_G = 388 * MiB;
constexpr size_t WS_ACT = 196 * MiB;
constexpr size_t WS_Y = 268 * MiB;
constexpr size_t WS_END = 452 * MiB;
constexpr int CW_CNT = 64;

typedef unsigned short bf16_t;
__device__ __forceinline__ bf16_t f2bf(float f) { unsigned u = __builtin_bit_cast(unsigned, f); return (bf16_t)((u + 0x7fffu + ((u >> 16) & 1u)) >> 16); }
__device__ __forceinline__ float bf2f(bf16_t h) { return __builtin_bit_cast(float, (unsigned)h << 16); }
__device__ __forceinline__ float sigmoidf_(float x) { return 1.f / (1.f + __expf(-x)); }
__device__ __forceinline__ float siluf_(float x) { return x / (1.f + __expf(-x)); }
__device__ __forceinline__ float wave_sum(float v) {
#pragma unroll
    for (int o = 1; o < 64; o <<= 1) v += __shfl_xor(v, o);
    return v;
}
__device__ __forceinline__ float log2gamma(int h) {
    return h == 0 ? -0.04580368961312479f : h == 1 ? -0.02272007650008353f : h == 2 ? -0.011315313227834146f : -0.005646563141142063f;
}

struct Ptrs {
    const float *x, *c; const int* pos; const float *w_ada, *b_ada, *w_in, *w_out, *hgrn_lb, *hgrn_nw, *ret_nw, *ln1w, *ln1b, *w_rg, *b_rg, *w_re, *b_re, *w_gate, *w_up, *w_down, *ln2w, *ln2b;
    float* out; unsigned char* ws;
};

__global__ void __launch_bounds__(256) k_prep(Ptrs p) {
    const int gt = blockIdx.x * blockDim.x + threadIdx.x, NT = gridDim.x * blockDim.x;
    float* mod = (float*)(p.ws + WS_MOD);
    for (int i = gt; i < 8 * 6144; i += NT) {
        const int b = i / 6144, j = i % 6144;
        float acc = p.b_ada[j];
        for (int k = 0; k < DM; ++k) acc += siluf_(p.c[b * DM + k]) * p.w_ada[(size_t)k * 6144 + j];
        mod[i] = acc;
    }
    float* lb = (float*)(p.ws + WS_LB);
    for (int i = gt; i < 512; i += NT) { const float a = p.hgrn_lb[i], b = p.hgrn_lb[512 + i]; const float mx = fmaxf(a, b); const float ea = __expf(a - mx), eb = __expf(b - mx); lb[i] = ea / (ea + eb); }
    float* cs = (float*)(p.ws + WS_COS); float* sn = (float*)(p.ws + WS_SIN);
    for (int i = gt; i < MTOK * 64; i += NT) {
        const int m = i >> 6, f = i & 63;
        const double inv = exp2(-(double)(2 * f) / 128.0 * 13.287712379549449);
        const double ang = (double)p.pos[m] * inv;
        double s, c; sincos(ang, &s, &c);
        cs[i] = (float)c; sn[i] = (float)s;
    }
}

__global__ void __launch_bounds__(256) k_h1(Ptrs p) {
    const int lane = threadIdx.x & 63, gw = (blockIdx.x * blockDim.x + threadIdx.x) >> 6, NW = (gridDim.x * blockDim.x) >> 6;
    const float* mod = (const float*)(p.ws + WS_MOD); bf16_t* hb = (bf16_t*)(p.ws + WS_HB);
    for (int m = gw; m < MTOK; m += NW) {
        const int b = m / NS; const float* xr = p.x + (size_t)m * DM;
        float v[16]; float s = 0.f;
#pragma unroll
        for (int j = 0; j < 16; ++j) { v[j] = xr[lane + 64 * j]; s += v[j]; }
        const float mean = wave_sum(s) * (1.f / DM); float q = 0.f;
#pragma unroll
        for (int j = 0; j < 16; ++j) { v[j] -= mean; q += v[j] * v[j]; }
        const float rstd = 1.f / sqrtf(wave_sum(q) * (1.f / DM) + LN_EPS);
#pragma unroll
        for (int j = 0; j < 16; ++j) { const int col = lane + 64 * j; hb[(size_t)m * DM + col] = f2bf(v[j] * rstd * (1.f + mod[b * 6144 + 1024 + col]) + mod[b * 6144 + col]); }
    }
}

template <class LA, class LB>
__device__ __forceinline__ void naive_tile(float (&acc)[4][4], LA la, LB lb, int K, float* As, float* Bs) {
    const int tid = threadIdx.x, ty = tid >> 4, tx = tid & 15;
#pragma unroll
    for (int i = 0; i < 4; ++i)
#pragma unroll
        for (int j = 0; j < 4; ++j) acc[i][j] = 0.f;
    for (int k0 = 0; k0 < K; k0 += 16) {
        __syncthreads();
#pragma unroll
        for (int i = 0; i < 4; ++i) { const int idx = tid + 256 * i; const int r = idx >> 4, k = idx & 15; As[k * 68 + r] = la(r, k0 + k); }
#pragma unroll
        for (int i = 0; i < 4; ++i) { const int idx = tid + 256 * i; const int k = idx >> 6, c = idx & 63; Bs[k * 64 + c] = lb(k0 + k, c); }
        __syncthreads();
#pragma unroll
        for (int kk = 0; kk < 16; ++kk) {
            float a[4], b[4];
#pragma unroll
            for (int i = 0; i < 4; ++i) a[i] = As[kk * 68 + ty * 4 + i];
#pragma unroll
            for (int j = 0; j < 4; ++j) b[j] = Bs[kk * 64 + tx * 4 + j];
#pragma unroll
            for (int i = 0; i < 4; ++i)
#pragma unroll
                for (int j = 0; j < 4; ++j) acc[i][j] += a[i] * b[j];
        }
    }
}

__global__ void __launch_bounds__(256) k_proj(Ptrs p) {
    __shared__ float As[16 * 68], Bs[16 * 64], L[64 * 65];
    const int rc = blockIdx.x, job = blockIdx.y, tid = threadIdx.x, ty = tid >> 4, tx = tid & 15;
    const bf16_t* hb = (const bf16_t*)(p.ws + WS_HB);
    bf16_t* QI = (bf16_t*)(p.ws + WS_QI); bf16_t* KI = (bf16_t*)(p.ws + WS_KI); bf16_t* V = (bf16_t*)(p.ws + WS_V); bf16_t* G = (bf16_t*)(p.ws + WS_G);
    const int m0 = rc * 64;
    auto la = [&](int r, int k) { return bf2f(hb[(size_t)(m0 + r) * DM + k]); };
    float a0[4][4], a1[4][4];
    if (job < 8) {
        const int h = job >> 1, cg = job & 1, c0 = h * 128 + cg * 64;
        naive_tile(a0, la, [&](int k, int c) { return p.w_in[(size_t)k * DPROJ + c0 + c]; }, DM, As, Bs);
        naive_tile(a1, la, [&](int k, int c) { return p.w_in[(size_t)k * DPROJ + 512 + c0 + c]; }, DM, As, Bs);
        const float* lbv = (const float*)(p.ws + WS_LB);
        float kk[4][4];
        __syncthreads();
#pragma unroll
        for (int i = 0; i < 4; ++i)
#pragma unroll
            for (int j = 0; j < 4; ++j) { const float lb = lbv[c0 + tx * 4 + j], z = a1[i][j]; const float f = lb + (1.f - lb) * sigmoidf_(z); L[(ty * 4 + i) * 65 + tx * 4 + j] = logf(f); kk[i][j] = (1.f - lb) * sigmoidf_(-z); }
        __syncthreads();
        if (tid < 64) { float s = 0.f; for (int r = 0; r < 64; ++r) { s += L[r * 65 + tid]; L[r * 65 + tid] = s; } }
        __syncthreads();
#pragma unroll
        for (int i = 0; i < 4; ++i)
#pragma unroll
            for (int j = 0; j < 4; ++j) { const int r = ty * 4 + i, c = tx * 4 + j; const float b = L[r * 65 + c]; const size_t o = (size_t)(m0 + r) * DM + c0 + c;
                QI[o] = f2bf(siluf_(a0[i][j]) * __expf(b)); KI[o] = f2bf(kk[i][j] * __expf(-b)); }
        if (tid < 64) ((float*)(p.ws + WS_DEC))[(size_t)rc * 512 + c0 + tid] = __expf(L[63 * 65 + tid]);
    } else if (job < 16) {
        const int isk = job >= 12, h = (job - 8) & 3, c0 = (isk ? 2560 : 2048) + h * 128;
        naive_tile(a0, la, [&](int k, int c) { return p.w_in[(size_t)k * DPROJ + c0 + c]; }, DM, As, Bs);
        naive_tile(a1, la, [&](int k, int c) { return p.w_in[(size_t)k * DPROJ + c0 + 64 + c]; }, DM, As, Bs);
        const float* cs = (const float*)(p.ws + WS_COS); const float* sn = (const float*)(p.ws + WS_SIN);
        bf16_t* dst = isk ? KI : QI;
#pragma unroll
        for (int i = 0; i < 4; ++i)
#pragma unroll
            for (int j = 0; j < 4; ++j) { const int r = ty * 4 + i, c = tx * 4 + j, m = m0 + r; const float co = cs[(size_t)m * 64 + c], si = sn[(size_t)m * 64 + c];
                const float t1 = a0[i][j], t2 = a1[i][j]; const float e = (float)(r + 1) * log2gamma(h);
                const float sc = isk ? exp2f(-e) : exp2f(e) * 0.08838834764831845f;
                const size_t o = (size_t)m * DM + 512 + h * 128 + c;
                dst[o] = f2bf((t1 * co - t2 * si) * sc); dst[o + 64] = f2bf((t1 * si + t2 * co) * sc); }
    } else {
        const int idx = job - 16, seg = idx >> 3, cb = idx & 7;
        const int c0 = (seg == 0 ? 1024 : seg == 1 ? 1536 : seg == 2 ? 3072 : 3584) + cb * 64;
        naive_tile(a0, la, [&](int k, int c) { return p.w_in[(size_t)k * DPROJ + c0 + c]; }, DM, As, Bs);
        bf16_t* dst = (seg == 0 || seg == 2) ? V : G; const int oc = (seg >= 2 ? 512 : 0) + cb * 64;
#pragma unroll
        for (int i = 0; i < 4; ++i)
#pragma unroll
            for (int j = 0; j < 4; ++j) { const int r = ty * 4 + i, c = tx * 4 + j; const float v = a0[i][j];
                dst[(size_t)(m0 + r) * DM + oc + c] = f2bf((seg == 0 || seg == 2) ? v : siluf_(v)); }
    }
}

__global__ void __launch_bounds__(512) k_mixer(Ptrs p) {
    __shared__ float qs[128], ks[128], part[4][128], red[16];
    const int b = blockIdx.x >> 3, mh = blockIdx.x & 7, tid = threadIdx.x, j = tid & 127, g = tid >> 7;
    const bf16_t* QI = (const bf16_t*)(p.ws + WS_QI); const bf16_t* KI = (const bf16_t*)(p.ws + WS_KI); const bf16_t* V = (const bf16_t*)(p.ws + WS_V); const bf16_t* G = (const bf16_t*)(p.ws + WS_G);
    const float* DEC = (const float*)(p.ws + WS_DEC); bf16_t* O = (bf16_t*)(p.ws + WS_HB);
    float st[32];
#pragma unroll
    for (int i = 0; i < 32; ++i) st[i] = 0.f;
    const float nw = mh < 4 ? p.hgrn_nw[mh * 128 + j] : p.ret_nw[(mh - 4) * 128 + j];
    for (int s = 0; s < NS; ++s) {
        const size_t m = (size_t)b * NS + s;
        __syncthreads();
        if (tid < 128) qs[tid] = bf2f(QI[m * DM + mh * 128 + tid]); else if (tid < 256) ks[tid - 128] = bf2f(KI[m * DM + mh * 128 + tid - 128]);
        const float v = bf2f(V[m * DM + mh * 128 + j]);
        __syncthreads();
        float acc = 0.f;
#pragma unroll
        for (int i = 0; i < 32; ++i) { st[i] += ks[g * 32 + i] * v; acc += st[i] * qs[g * 32 + i]; }
        part[g][j] = acc;
        if ((s & 63) == 63) {
            const int ch = (int)(m >> 6);
#pragma unroll
            for (int i = 0; i < 32; ++i) { const float d = mh < 4 ? DEC[(size_t)ch * 512 + mh * 128 + g * 32 + i] : exp2f(64.f * log2gamma(mh - 4)); st[i] *= d; }
        }
        __syncthreads();
        float o = 0.f, s1 = 0.f, s2 = 0.f;
        if (tid < 128) { o = part[0][j] + part[1][j] + part[2][j] + part[3][j]; s1 = wave_sum(o); s2 = wave_sum(o * o); if ((tid & 63) == 0) { red[(tid >> 6) * 2] = s1; red[(tid >> 6) * 2 + 1] = s2; } }
        __syncthreads();
        if (tid < 128) {
            const float t1 = red[0] + red[2], t2 = red[1] + red[3]; float r;
            if (mh < 4) r = o * (1.f / sqrtf(t2 * (1.f / 128.f) + LN_EPS));
            else { const float mu = t1 * (1.f / 128.f); const float var = fmaxf(t2 * (1.f / 128.f) - mu * mu, 0.f); r = (o - mu) * (1.f / sqrtf(var + LN_EPS)); }
            O[m * DM + mh * 128 + j] = f2bf(r * nw * bf2f(G[m * DM + mh * 128 + j]));
        }
    }
}

__global__ void __launch_bounds__(256) k_outproj(Ptrs p) {
    __shared__ float As[16 * 68], Bs[16 * 64];
    const int m0 = blockIdx.x * 64, c0 = blockIdx.y * 64, tid = threadIdx.x, ty = tid >> 4, tx = tid & 15;
    const bf16_t* hb = (const bf16_t*)(p.ws + WS_HB); const float* mod = (const float*)(p.ws + WS_MOD);
    float a0[4][4];
    naive_tile(a0, [&](int r, int k) { return bf2f(hb[(size_t)(m0 + r) * DM + k]); }, [&](int k, int c) { return p.w_out[(size_t)k * DM + c0 + c]; }, DM, As, Bs);
    const int b = m0 / NS;
#pragma unroll
    for (int i = 0; i < 4; ++i)
#pragma unroll
        for (int j = 0; j < 4; ++j) { const int m = m0 + ty * 4 + i, c = c0 + tx * 4 + j; p.out[(size_t)m * DM + c] = DN_ALPHA * p.x[(size_t)m * DM + c] + mod[b * 6144 + 2048 + c] * a0[i][j]; }
}

__global__ void __launch_bounds__(256) k_route(Ptrs p) {
    const int lane = threadIdx.x & 63, gw = (blockIdx.x * blockDim.x + threadIdx.x) >> 6, NW = (gridDim.x * blockDim.x) >> 6;
    const float* mod = (const float*)(p.ws + WS_MOD); bf16_t* hb = (bf16_t*)(p.ws + WS_HB);
    int* cnt = (int*)(p.ws + WS_CTL) + CW_CNT; int* list = (int*)(p.ws + WS_LIST);
    int* re = (int*)(p.ws + WS_ROUTE); int* rp = re + 2 * MTOK; float* rg = (float*)(rp + 2 * MTOK);
    for (int m = gw; m < MTOK; m += NW) {
        const int b = m / NS; const float* ur = p.out + (size_t)m * DM;
        float v[16]; float s = 0.f;
#pragma unroll
        for (int j = 0; j < 16; ++j) { v[j] = ur[lane + 64 * j]; s += v[j]; }
        float mean = wave_sum(s) * (1.f / DM); float q = 0.f;
#pragma unroll
        for (int j = 0; j < 16; ++j) { v[j] -= mean; q += v[j] * v[j]; }
        float rstd = 1.f / sqrtf(wave_sum(q) * (1.f / DM) + LN_EPS);
        s = 0.f;
#pragma unroll
        for (int j = 0; j < 16; ++j) { const int col = lane + 64 * j; v[j] = v[j] * rstd * p.ln1w[col] + p.ln1b[col]; s += v[j]; }
        mean = wave_sum(s) * (1.f / DM); q = 0.f;
#pragma unroll
        for (int j = 0; j < 16; ++j) { v[j] -= mean; q += v[j] * v[j]; }
        rstd = 1.f / sqrtf(wave_sum(q) * (1.f / DM) + LN_EPS);
        float lg[36];
#pragma unroll
        for (int e = 0; e < 36; ++e) lg[e] = 0.f;
#pragma unroll
        for (int j = 0; j < 16; ++j) { const int col = lane + 64 * j; const float h = v[j] * rstd * (1.f + mod[b * 6144 + 4096 + col]) + mod[b * 6144 + 3072 + col];
            hb[(size_t)m * DM + col] = f2bf(h);
#pragma unroll
            for (int e = 0; e < 4; ++e) lg[e] += h * p.w_rg[col * 4 + e];
#pragma unroll
            for (int e = 0; e < 32; ++e) lg[4 + e] += h * p.w_re[col * 32 + e]; }
#pragma unroll
        for (int e = 0; e < 36; ++e) lg[e] = wave_sum(lg[e]);
        if (lane == 0) {
            float gl[4]; int gs = 0;
#pragma unroll
            for (int e = 0; e < 4; ++e) gl[e] = lg[e] + p.b_rg[e];
            float gmax = gl[0];
#pragma unroll
            for (int e = 1; e < 4; ++e) if (gl[e] > gmax) { gmax = gl[e]; gs = e; }
            float den = 0.f;
#pragma unroll
            for (int e = 0; e < 4; ++e) den += __expf(gl[e] - gmax);
            const float pstar = 1.f / den;
            float el[8];
#pragma unroll
            for (int e = 0; e < 8; ++e) { float t = 0.f;
#pragma unroll
                for (int g4 = 0; g4 < 4; ++g4) t = (gs == g4) ? lg[4 + g4 * 8 + e] + p.b_re[g4 * 8 + e] : t;
                el[e] = t; }
            int i1 = 0; float v1 = el[0];
#pragma unroll
            for (int e = 1; e < 8; ++e) if (el[e] > v1) { v1 = el[e]; i1 = e; }
            int i2 = -1; float v2 = -3.0e38f;
#pragma unroll
            for (int e = 0; e < 8; ++e) if (e != i1 && el[e] > v2) { v2 = el[e]; i2 = e; }
            const float w1 = 1.f / (1.f + __expf(v2 - v1));
            const int e1 = gs * 8 + i1, e2 = gs * 8 + i2;
            const int p1 = atomicAdd(&cnt[e1], 1), p2 = atomicAdd(&cnt[e2], 1);
            list[e1 * MTOK + p1] = m; list[e2 * MTOK + p2] = m;
            re[m] = e1; re[MTOK + m] = e2; rp[m] = p1; rp[MTOK + m] = p2; rg[m] = pstar * w1; rg[MTOK + m] = pstar * (1.f - w1);
        }
    }
}

__device__ __forceinline__ void moe_find(const int* cnt, int tile64, int& e, int& t, int& off) {
    int acc = 0, o = 0; e = -1;
    for (int i = 0; i < NEXP; ++i) { const int c = cnt[i], nt = (c + 63) >> 6; if (e < 0 && tile64 < acc + nt) { e = i; t = tile64 - acc; off = o; } acc += nt; o += ((c + 255) >> 8) << 8; }
}

__global__ void __launch_bounds__(256) k_moe_up(Ptrs p) {
    __shared__ float As[16 * 68], Bs[16 * 64]; __shared__ int toks[64];
    const int* cnt = (const int*)(p.ws + WS_CTL) + CW_CNT; const int* list = (const int*)(p.ws + WS_LIST);
    int e, t, off; moe_find(cnt, blockIdx.x, e, t, off); if (e < 0) return;
    const int tid = threadIdx.x, ty = tid >> 4, tx = tid & 15, c0 = blockIdx.y * 64, n = cnt[e];
    if (tid < 64) toks[tid] = (t * 64 + tid < n) ? list[e * MTOK + t * 64 + tid] : 0;
    __syncthreads();
    const bf16_t* hb = (const bf16_t*)(p.ws + WS_HB); bf16_t* act = (bf16_t*)(p.ws + WS_ACT);
    const float* wg = p.w_gate + (size_t)e * DM * DEXP; const float* wu = p.w_up + (size_t)e * DM * DEXP;
    float a0[4][4], a1[4][4];
    auto la = [&](int r, int k) { return bf2f(hb[(size_t)toks[r] * DM + k]); };
    naive_tile(a0, la, [&](int k, int c) { return wg[(size_t)k * DEXP + c0 + c]; }, DM, As, Bs);
    naive_tile(a1, la, [&](int k, int c) { return wu[(size_t)k * DEXP + c0 + c]; }, DM, As, Bs);
#pragma unroll
    for (int i = 0; i < 4; ++i)
#pragma unroll
        for (int j = 0; j < 4; ++j) { const int r = t * 64 + ty * 4 + i; if (r < n) act[(size_t)(off + r) * DEXP + c0 + tx * 4 + j] = f2bf(siluf_(a0[i][j]) * a1[i][j]); }
}
__global__ void __launch_bounds__(256) k_moe_down(Ptrs p) {
    __shared__ float As[16 * 68], Bs[16 * 64];
    const int* cnt = (const int*)(p.ws + WS_CTL) + CW_CNT;
    int e, t, off; moe_find(cnt, blockIdx.x, e, t, off); if (e < 0) return;
    const int tid = threadIdx.x, ty = tid >> 4, tx = tid & 15, c0 = blockIdx.y * 64, n = cnt[e];
    const bf16_t* act = (const bf16_t*)(p.ws + WS_ACT); bf16_t* Y = (bf16_t*)(p.ws + WS_Y);
    const float* wd = p.w_down + (size_t)e * DEXP * DM;
    float a0[4][4];
    naive_tile(a0, [&](int r, int k) { const int rr = t * 64 + r; return rr < n ? bf2f(act[(size_t)(off + rr) * DEXP + k]) : 0.f; }, [&](int k, int c) { return wd[(size_t)k * DM + c0 + c]; }, DEXP, As, Bs);
#pragma unroll
    for (int i = 0; i < 4; ++i)
#pragma unroll
        for (int j = 0; j < 4; ++j) { const int r = t * 64 + ty * 4 + i; if (r < n) Y[(size_t)(off + r) * DM + c0 + tx * 4 + j] = f2bf(a0[i][j]); }
}

__global__ void __launch_bounds__(256) k_final(Ptrs p) {
    const int lane = threadIdx.x & 63, gw = (blockIdx.x * blockDim.x + threadIdx.x) >> 6, NW = (gridDim.x * blockDim.x) >> 6;
    const float* mod = (const float*)(p.ws + WS_MOD); const bf16_t* Y = (const bf16_t*)(p.ws + WS_Y);
    const int* cnt = (const int*)(p.ws + WS_CTL) + CW_CNT;
    const int* re = (const int*)(p.ws + WS_ROUTE); const int* rp = re + 2 * MTOK; const float* rg = (const float*)(rp + 2 * MTOK);
    int offs = 0, myoff = 0;
    for (int i = 0; i < NEXP; ++i) { if (i == (lane & 31)) myoff = offs; offs += ((cnt[i] + 255) >> 8) << 8; }
    for (int m = gw; m < MTOK; m += NW) {
        const int b = m / NS; float* ur = p.out + (size_t)m * DM;
        const int e1 = re[m], e2 = re[MTOK + m];
        const int s1 = __shfl(myoff, e1) + rp[m], s2 = __shfl(myoff, e2) + rp[MTOK + m];
        const float g1 = rg[m], g2 = rg[MTOK + m];
        float v[16]; float s = 0.f;
#pragma unroll
        for (int j = 0; j < 16; ++j) { v[j] = ur[lane + 64 * j]; s += v[j]; }
        float mean = wave_sum(s) * (1.f / DM); float q = 0.f;
#pragma unroll
        for (int j = 0; j < 16; ++j) { v[j] -= mean; q += v[j] * v[j]; }
        float rstd = 1.f / sqrtf(wave_sum(q) * (1.f / DM) + LN_EPS);
        s = 0.f;
#pragma unroll
        for (int j = 0; j < 16; ++j) { const int col = lane + 64 * j; const float x1 = v[j] * rstd * p.ln1w[col] + p.ln1b[col];
            const float y = g1 * bf2f(Y[(size_t)s1 * DM + col]) + g2 * bf2f(Y[(size_t)s2 * DM + col]);
            v[j] = DN_ALPHA * x1 + mod[b * 6144 + 5120 + col] * y; s += v[j]; }
        mean = wave_sum(s) * (1.f / DM); q = 0.f;
#pragma unroll
        for (int j = 0; j < 16; ++j) { v[j] -= mean; q += v[j] * v[j]; }
        rstd = 1.f / sqrtf(wave_sum(q) * (1.f / DM) + LN_EPS);
#pragma unroll
        for (int j = 0; j < 16; ++j) { const int col = lane + 64 * j; ur[col] = v[j] * rstd * p.ln2w[col] + p.ln2b[col]; }
    }
}


#define GAS __attribute__((address_space(1)))
#define LAS __attribute__((address_space(3)))
typedef short bf16x8 __attribute__((ext_vector_type(8)));
typedef float f32x4 __attribute__((ext_vector_type(4)));
typedef float f32x2 __attribute__((ext_vector_type(2)));
typedef unsigned u32x4 __attribute__((ext_vector_type(4)));
typedef unsigned u32x2 __attribute__((ext_vector_type(2)));
constexpr int NWAVES = 8;
constexpr int LDS_BYTES = 163840;
constexpr int RING_BYTES = 131072;
constexpr int MISC_OFF = 147456;
constexpr int TAB_OFF = 147456 + 1024;
constexpr int CW_BAR = 4096;

__device__ __forceinline__ unsigned cvt_pk_bf16(float lo, float hi) { unsigned r; asm volatile("v_cvt_pk_bf16_f32 %0, %1, %2" : "=v"(r) : "v"(lo), "v"(hi)); return r; }
#define LDS_WAIT() asm volatile("s_waitcnt lgkmcnt(0)" ::: "memory")
#define VM_WAIT() asm volatile("s_waitcnt vmcnt(0)" ::: "memory")

#define XB_TMO      128
#define XB_XCNT(j)  (256  + 64 * (j))
#define XB_XSUB(j)  (1280 + 64 * (j))
#define XB_XGEN(j)  (2304 + 64 * (j))
#define XB_TOP      3328
#define XB_TOPGEN   3392
#define XCD_BAR_WORDS 3456
#define XB_SPIN_CAP (1u << 18)
__device__ __forceinline__ unsigned xb_ld(unsigned* p)              { return __hip_atomic_load(p, __ATOMIC_RELAXED, __HIP_MEMORY_SCOPE_AGENT); }
__device__ __forceinline__ unsigned xb_add(unsigned* p, unsigned v) { return __hip_atomic_fetch_add(p, v, __ATOMIC_RELAXED, __HIP_MEMORY_SCOPE_AGENT); }
__device__ __forceinline__ unsigned xb_xcc_id() { return (unsigned)__builtin_amdgcn_s_getreg((3 << 11) | 20) & 0xFu; }
#define XB_SPIN(cond, bar) do { unsigned _sp = 0; while (cond) { __builtin_amdgcn_s_sleep(1); \
    if ((++_sp & 255u) == 0u) { if (xb_ld(&(bar)[XB_TMO])) break; if (_sp > XB_SPIN_CAP) { atomicAdd(&(bar)[XB_TMO], 1u); break; } } } } while (0)
struct XcdBarrier { unsigned* bar; unsigned x; volatile LAS unsigned* st; };
__device__ __forceinline__ XcdBarrier xcd_barrier_post(unsigned* bar, volatile LAS unsigned* st) {
    XcdBarrier b; b.bar = bar; b.x = xb_xcc_id(); b.st = st;
    if (threadIdx.x == 0) (void)xb_add(&bar[XB_XCNT(b.x)], 1u);
    return b;
}
__device__ __forceinline__ void xcd_barrier_complete(unsigned* bar, unsigned x, unsigned& nloc, unsigned& nx) {
    const unsigned G = gridDim.x * gridDim.y * gridDim.z;
    unsigned sum, cnt, mine, sp = 0u;
    for (;;) {
        sum = 0u; cnt = 0u; mine = 0u;
#pragma unroll
        for (unsigned j = 0; j < 16; ++j) { const unsigned c = xb_ld(&bar[XB_XCNT(j)]); sum += c; cnt += (c > 0u) ? 1u : 0u; mine = (j == x) ? c : mine; }
        if (sum == G) break;
        __builtin_amdgcn_s_sleep(1);
        if ((++sp & 255u) == 0u) { if (xb_ld(&bar[XB_TMO])) break; if (sp > XB_SPIN_CAP) { atomicAdd(&bar[XB_TMO], 1u); break; } }
    }
    nloc = mine > 0u ? mine : 1u; nx = cnt > 0u ? cnt : 1u;
}
__device__ __forceinline__ void xcd_barrier(const XcdBarrier& b) {
    asm volatile("s_waitcnt vmcnt(0)" ::: "memory");
    __syncthreads();
    if (threadIdx.x == 0) {
        unsigned* bar = b.bar;
        __builtin_amdgcn_s_waitcnt(0);
        unsigned nloc = b.st[0], nx = b.st[1];
        if (nloc == 0u) { xcd_barrier_complete(bar, b.x, nloc, nx); b.st[0] = nloc; b.st[1] = nx; }
        const unsigned old = xb_add(&bar[XB_XSUB(b.x)], 1u);
        const unsigned gen = old / nloc;
        if (old + 1u == (gen + 1u) * nloc) {
            __builtin_amdgcn_fence(__ATOMIC_RELEASE, "agent");
            asm volatile("s_waitcnt vmcnt(0)" ::: "memory");
            const unsigned og = xb_add(&bar[XB_TOP], 1u);
            const unsigned tg = og / nx;
            if (og + 1u == (tg + 1u) * nx) xb_add(&bar[XB_TOPGEN], 1u);
            else XB_SPIN(xb_ld(&bar[XB_TOPGEN]) == tg, bar);
            __builtin_amdgcn_fence(__ATOMIC_ACQUIRE, "agent");
            xb_add(&bar[XB_XGEN(b.x)], 1u);
            asm volatile("s_waitcnt vmcnt(0)" ::: "memory");
        } else {
            XB_SPIN(xb_ld(&bar[XB_XGEN(b.x)]) == gen, bar);
            __builtin_amdgcn_fence(__ATOMIC_ACQUIRE, "agent");
            asm volatile("s_waitcnt vmcnt(0)" ::: "memory");
        }
    }
    __syncthreads();
}

namespace pg8 {
constexpr int BM = 256, BK = 64, HALF = 128, HTB = HALF * BK * 2, NXCD = 8, WGM = 8;
__device__ __forceinline__ int lds_byte(int r, int c) { const int st = (r >> 4) * 2 + (c >> 5), rr = r & 15, cc = c & 31, ob = rr * 64 + cc * 2; return st * 1024 + (ob ^ (((ob >> 9) & 1) << 5)); }
__device__ __forceinline__ void stage_rc(int b, int& R, int& C) { const int st = b / 1024, sb = b % 1024, swz = sb ^ (((sb >> 9) & 1) << 5); R = (st >> 1) * 16 + swz / 64; C = (st & 1) * 32 + (swz % 64) / 2; }
__device__ __forceinline__ int perm32(int rho) { const int n = rho >> 4, i = rho & 15; return 8 * (i >> 2) + 4 * n + (i & 3); }

struct Unit { int pm, pn; const char* A; const char* B; const int* rows; int nrows; };

__device__ __forceinline__ void tile_of(int L, int nM, int nN, int& pm, int& pn) {
    const int nwg = nM * nN; int wgid = L;
    { const int q = nwg / NXCD, r = nwg % NXCD, xcd = wgid % NXCD, off = wgid / NXCD; wgid = (xcd < r ? xcd * (q + 1) : r * (q + 1) + (xcd - r) * q) + off; }
    const int nig = WGM * nN, gid = wgid / nig, fm = gid * WGM, gsz = (nM - fm) < WGM ? (nM - fm) : WGM;
    pm = fm + ((wgid % nig) % gsz); pn = (wgid % nig) / gsz;
}
struct DenseOrder {
    const char* A; const char* Bt; int nM, nN, K, G, c;
    __device__ __forceinline__ bool next(int i, Unit& u) const {
        const long L = (long)i * G + c; if (L >= (long)nM * nN) return false;
        tile_of((int)L, nM, nN, u.pm, u.pn);
        const size_t tstep = (size_t)BM * K * 2; u.A = A + (size_t)u.pm * tstep; u.B = Bt + (size_t)u.pn * tstep; u.rows = nullptr; u.nrows = 256; return true;
    }
};

template <class Epi, class Sched, bool GATHER>
__device__ __forceinline__ void gemm_phase(LAS unsigned char* lds, const int K, const Sched& S, const Epi& E) {
    const int tid = threadIdx.x, wid = __builtin_amdgcn_readfirstlane(tid >> 6), lane = tid & 63, wr = wid >> 2, wc = wid & 3, fr = lane & 15, fq = lane >> 4;
    const int nt = K / BK;
    int RA[2], CA[2]; unsigned voffB[2];
#pragma unroll
    for (int i = 0; i < 2; ++i) { int R, C; stage_rc(tid * 16 + i * 8192, R, C); const int Rb = Epi::PERM ? ((R & ~31) + perm32(R & 31)) : R; RA[i] = R; CA[i] = C; voffB[i] = (unsigned)(Rb * K + C) * 2u; }
    const size_t kstep = (size_t)(BK * 2);
    const size_t hstep = (size_t)HALF * K * 2;
    const unsigned ldsw = (unsigned)wid * 1024u;
    const int aoff = lds_byte(wr * 64 + fr, fq * 8), boff = lds_byte(wc * 32 + fr, fq * 8);
#define PG8_SA(b, h) (((b) * 2 + (h)) * HTB)
#define PG8_SB(b, h) ((4 + (b) * 2 + (h)) * HTB)
#define PG8_STAGE_B(bufoff, gbase) do { _Pragma("unroll") for (int _i = 0; _i < 2; ++_i) \
        __builtin_amdgcn_global_load_lds((const unsigned*)((const char*)(gbase) + voffB[_i]), (LAS unsigned*)(lds + (bufoff) + ldsw + _i * 8192), 16, 0, 0); } while (0)
#define PG8_STAGE_A(bufoff, gbase, o, h) do { _Pragma("unroll") for (int _i = 0; _i < 2; ++_i) \
        __builtin_amdgcn_global_load_lds((const unsigned*)((const char*)(gbase) + (o)[h][_i]), (LAS unsigned*)(lds + (bufoff) + ldsw + _i * 8192), 16, 0, 0); } while (0)
#define PG8_MKOFF(u, o) do { _Pragma("unroll") for (int _h = 0; _h < 2; ++_h) _Pragma("unroll") for (int _i = 0; _i < 2; ++_i) { \
        if (GATHER) { const int _row = 128 * _h + RA[_i]; const int _tok = (_row < (u).nrows) ? (u).rows[_row] : 0; (o)[_h][_i] = (unsigned)_tok * (unsigned)(K * 2) + (unsigned)(CA[_i] * 2); } \
        else (o)[_h][_i] = (unsigned)((RA[_i] + 128 * _h) * K + CA[_i]) * 2u; } } while (0)
#define PG8_LDA(dst, b, h) do { _Pragma("unroll") for (int m = 0; m < 4; ++m) _Pragma("unroll") for (int k = 0; k < 2; ++k) dst[m][k] = *(const LAS bf16x8*)(lds + PG8_SA(b, h) + aoff + m * 2048 + k * 1024); } while (0)
#define PG8_LDB(dst, b, h) do { _Pragma("unroll") for (int n = 0; n < 2; ++n) _Pragma("unroll") for (int k = 0; k < 2; ++k) dst[n][k] = *(const LAS bf16x8*)(lds + PG8_SB(b, h) + boff + n * 2048 + k * 1024); } while (0)
#define PG8_MMA(ai, bj, At, Bt) do { __builtin_amdgcn_s_setprio(1); _Pragma("unroll") for (int m = 0; m < 4; ++m) _Pragma("unroll") for (int n = 0; n < 2; ++n) _Pragma("unroll") for (int k = 0; k < 2; ++k) \
        acc[ai][bj][m][n] = __builtin_amdgcn_mfma_f32_16x16x32_bf16(Bt[n][k], At[m][k], acc[ai][bj][m][n], 0, 0, 0); __builtin_amdgcn_s_setprio(0); } while (0)
#define PG8_WAIT_V(n) asm volatile("s_waitcnt vmcnt(" #n ")" ::: "memory")
#define PG8_WAIT_L(n) asm volatile("s_waitcnt lgkmcnt(" #n ")" ::: "memory")
#define PG8_BAR __builtin_amdgcn_s_barrier()
#define PG8_SCHED __builtin_amdgcn_sched_barrier(0)
    Unit cur, nxt; int ui = 0;
    if (!S.next(0, cur)) return;
    f32x4 acc[2][2][4][2];
#pragma unroll
    for (int a = 0; a < 2; ++a)
#pragma unroll
        for (int b = 0; b < 2; ++b)
#pragma unroll
            for (int m = 0; m < 4; ++m)
#pragma unroll
                for (int n = 0; n < 2; ++n) acc[a][b][m][n] = (f32x4){0.f, 0.f, 0.f, 0.f};
    bf16x8 At[4][2], B0[2][2], B1[2][2];
    unsigned cO[2][2], nO[2][2];
    PG8_MKOFF(cur, cO);
    const char* cA = cur.A; const char* cB = cur.B;
    PG8_STAGE_B(PG8_SB(0, 0), cB); PG8_STAGE_B(PG8_SB(0, 1), cB + hstep); PG8_STAGE_A(PG8_SA(0, 0), cA, cO, 0); PG8_STAGE_A(PG8_SA(0, 1), cA, cO, 1);
    if (wr == 1) PG8_BAR;
    PG8_WAIT_V(2); PG8_BAR;
    PG8_STAGE_B(PG8_SB(1, 0), cB + kstep); PG8_STAGE_A(PG8_SA(1, 0), cA + kstep, cO, 0); PG8_STAGE_B(PG8_SB(1, 1), cB + hstep + kstep);
    PG8_WAIT_V(6); PG8_BAR;
    for (;;) {
        const bool has_next = S.next(ui + 1, nxt);
        const char* nA = has_next ? nxt.A : cA; const char* nB = has_next ? nxt.B : cB;
        if (has_next) { PG8_MKOFF(nxt, nO); } else {
#pragma unroll
            for (int h = 0; h < 2; ++h)
#pragma unroll
                for (int i = 0; i < 2; ++i) nO[h][i] = cO[h][i]; }
        for (int t = 0; t < nt; t += 2) {
            const bool last = (t == nt - 2);
            const char* a1 = cA + (size_t)(t + 1) * kstep;
            const char* a2 = last ? nA : cA + (size_t)(t + 2) * kstep; const char* b2 = last ? nB : cB + (size_t)(t + 2) * kstep;
            const char* a3 = a2 + kstep; const char* b3 = b2 + kstep;
            unsigned o2[2][2];
#pragma unroll
            for (int h = 0; h < 2; ++h)
#pragma unroll
                for (int i = 0; i < 2; ++i) o2[h][i] = last ? nO[h][i] : cO[h][i];
            PG8_LDB(B0, 0, 0); PG8_LDB(B1, 0, 1); PG8_SCHED; PG8_LDA(At, 0, 0); PG8_STAGE_A(PG8_SA(1, 1), a1, cO, 1);
            PG8_WAIT_V(8); PG8_WAIT_L(0); PG8_BAR; PG8_MMA(0, 0, At, B0); PG8_MMA(0, 1, At, B1); PG8_BAR; PG8_SCHED;
            PG8_LDA(At, 0, 1); PG8_STAGE_B(PG8_SB(0, 0), b2); PG8_STAGE_B(PG8_SB(0, 1), b2 + hstep); PG8_STAGE_A(PG8_SA(0, 0), a2, o2, 0);
            PG8_WAIT_V(8); PG8_WAIT_L(0); PG8_BAR; PG8_MMA(1, 0, At, B0); PG8_MMA(1, 1, At, B1); PG8_BAR; PG8_SCHED;
            PG8_LDB(B0, 1, 0); PG8_LDB(B1, 1, 1); PG8_SCHED; PG8_LDA(At, 1, 0); PG8_STAGE_A(PG8_SA(0, 1), a2, o2, 1);
            PG8_WAIT_V(8); PG8_WAIT_L(0); PG8_BAR; PG8_MMA(0, 0, At, B0); PG8_MMA(0, 1, At, B1); PG8_BAR; PG8_SCHED;
            PG8_LDA(At, 1, 1); PG8_STAGE_B(PG8_SB(1, 0), b3); PG8_STAGE_B(PG8_SB(1, 1), b3 + hstep); PG8_STAGE_A(PG8_SA(1, 0), a3, o2, 0);
            PG8_WAIT_V(8); PG8_WAIT_L(0); PG8_BAR; PG8_MMA(1, 0, At, B0); PG8_MMA(1, 1, At, B1); PG8_BAR; PG8_SCHED;
        }
        if (wr == 0) PG8_BAR;
        E(acc, cur, wr, wc, fr, fq);
        if (!has_next) break;
#pragma unroll
        for (int a = 0; a < 2; ++a)
#pragma unroll
            for (int b = 0; b < 2; ++b)
#pragma unroll
                for (int m = 0; m < 4; ++m)
#pragma unroll
                    for (int n = 0; n < 2; ++n) acc[a][b][m][n] = (f32x4){0.f, 0.f, 0.f, 0.f};
        cur = nxt; cA = nA; cB = nB; ++ui;
#pragma unroll
        for (int h = 0; h < 2; ++h)
#pragma unroll
            for (int i = 0; i < 2; ++i) cO[h][i] = nO[h][i];
        if (wr == 1) PG8_BAR;
    }
    PG8_WAIT_V(0);
    PG8_BAR;
#undef PG8_SA
#undef PG8_SB
#undef PG8_STAGE_A
#undef PG8_STAGE_B
#undef PG8_MKOFF
#undef PG8_LDA
#undef PG8_LDB
#undef PG8_MMA
#undef PG8_WAIT_V
#undef PG8_WAIT_L
#undef PG8_BAR
#undef PG8_SCHED
}

template <int CTRL> __device__ __forceinline__ float dpp_mov0(float v) { return __builtin_bit_cast(float, __builtin_amdgcn_update_dpp(0, __builtin_bit_cast(int, v), CTRL, 0xf, 0xf, true)); }
__device__ __forceinline__ float row_scan16(float v) {
    v += dpp_mov0<0x111>(v); v += dpp_mov0<0x112>(v); v += dpp_mov0<0x114>(v); v += dpp_mov0<0x118>(v); return v;
}

struct EpiProj {
    static constexpr bool PERM = true;
    bf16_t *QI, *KI, *V, *G; float* DEC; const float *LB, *COS, *SIN;
    __device__ __forceinline__ void operator()(const f32x4 (&acc)[2][2][4][2], const Unit& u, int wr, int wc, int fr, int fq) const {
        const int typ = u.pn >> 2, h = u.pn & 3, lane = threadIdx.x & 63;
        const int cb = wc * 32 + 8 * fq;
        const int rowb = u.pm * BM + wr * 64 + fr;
        if (typ == 0) {
            const f32x4 lb0 = *(const f32x4*)(LB + h * 128 + cb), lb1 = *(const f32x4*)(LB + h * 128 + cb + 4);
#pragma unroll
            for (int ai = 0; ai < 2; ++ai) {
                unsigned oq[4][4], ok[4][4]; f32x4 dec[2];
#pragma unroll
                for (int n = 0; n < 2; ++n) {
                    float qv[4][4], kv[4][4];
#pragma unroll
                    for (int j = 0; j < 4; ++j) {
                        const float lb = n ? lb1[j] : lb0[j], oml = 1.f - lb;
                        float lf[4], kk[4];
#pragma unroll
                        for (int m = 0; m < 4; ++m) { const float z = fminf(fmaxf(acc[ai][1][m][n][j], -30.f), 30.f); const float e = __expf(-z), r = __builtin_amdgcn_rcpf(1.f + e);
                            lf[m] = __logf(lb + oml * r); kk[m] = oml * e * r; lf[m] = row_scan16(lf[m]); }
                        const float t0 = __shfl(lf[0], lane | 15), t1 = __shfl(lf[1], lane | 15), t2 = __shfl(lf[2], lane | 15);
                        lf[1] += t0; lf[2] += t0 + t1; lf[3] += (t0 + t1) + t2;
#pragma unroll
                        for (int m = 0; m < 4; ++m) { const float eb = __expf(lf[m]), x = acc[ai][0][m][n][j]; qv[m][j] = x * __builtin_amdgcn_rcpf(1.f + __expf(-x)) * eb; kv[m][j] = kk[m] * __expf(-lf[m]); if (m == 3) dec[n][j] = eb; }
                    }
#pragma unroll
                    for (int m = 0; m < 4; ++m) { oq[m][2 * n] = cvt_pk_bf16(qv[m][0], qv[m][1]); oq[m][2 * n + 1] = cvt_pk_bf16(qv[m][2], qv[m][3]); ok[m][2 * n] = cvt_pk_bf16(kv[m][0], kv[m][1]); ok[m][2 * n + 1] = cvt_pk_bf16(kv[m][2], kv[m][3]); }
                }
#pragma unroll
                for (int m = 0; m < 4; ++m) { const size_t o = (size_t)(rowb + ai * HALF + m * 16) * DM + h * 128 + cb;
                    *(u32x4*)(QI + o) = (u32x4){oq[m][0], oq[m][1], oq[m][2], oq[m][3]}; *(u32x4*)(KI + o) = (u32x4){ok[m][0], ok[m][1], ok[m][2], ok[m][3]}; }
                if (fr == 15) { float* d = DEC + (size_t)(u.pm * 4 + ai * 2 + wr) * 512 + h * 128 + cb; *(f32x4*)d = dec[0]; *(f32x4*)(d + 4) = dec[1]; }
            }
        } else if (typ == 2) {
            const bool isk = wc >= 2; const int i0 = (wc & 1) * 32 + 8 * fq;
            bf16_t* dst = isk ? KI : QI; const float l2g = log2gamma(h);
#pragma unroll
            for (int ai = 0; ai < 2; ++ai)
#pragma unroll
                for (int m = 0; m < 4; ++m) { const int row = rowb + ai * HALF + m * 16; const float e = (float)(m * 16 + fr + 1) * l2g;
                    const float sc = isk ? __builtin_amdgcn_exp2f(-e) : __builtin_amdgcn_exp2f(e) * 0.08838834764831845f;
                    const f32x4 c0 = *(const f32x4*)(COS + (size_t)row * 64 + i0), c1 = *(const f32x4*)(COS + (size_t)row * 64 + i0 + 4);
                    const f32x4 s0 = *(const f32x4*)(SIN + (size_t)row * 64 + i0), s1 = *(const f32x4*)(SIN + (size_t)row * 64 + i0 + 4);
                    const f32x4 a0 = acc[ai][0][m][0], a1 = acc[ai][0][m][1], b0 = acc[ai][1][m][0], b1 = acc[ai][1][m][1];
                    const f32x4 x0 = (a0 * c0 - b0 * s0) * sc, x1 = (a1 * c1 - b1 * s1) * sc, y0 = (a0 * s0 + b0 * c0) * sc, y1 = (a1 * s1 + b1 * c1) * sc;
                    const size_t o = (size_t)row * DM + 512 + h * 128 + i0;
                    *(u32x4*)(dst + o) = (u32x4){cvt_pk_bf16(x0[0], x0[1]), cvt_pk_bf16(x0[2], x0[3]), cvt_pk_bf16(x1[0], x1[1]), cvt_pk_bf16(x1[2], x1[3])};
                    *(u32x4*)(dst + o + 64) = (u32x4){cvt_pk_bf16(y0[0], y0[1]), cvt_pk_bf16(y0[2], y0[3]), cvt_pk_bf16(y1[0], y1[1]), cvt_pk_bf16(y1[2], y1[3])}; }
        } else {
            const int mh = (typ == 1 ? 0 : 4) + h;
#pragma unroll
            for (int ai = 0; ai < 2; ++ai)
#pragma unroll
                for (int m = 0; m < 4; ++m) { const size_t o = (size_t)(rowb + ai * HALF + m * 16) * DM + mh * 128 + cb;
                    const f32x4 v0 = acc[ai][0][m][0], v1 = acc[ai][0][m][1]; f32x4 g0 = acc[ai][1][m][0], g1 = acc[ai][1][m][1];
#pragma unroll
                    for (int j = 0; j < 4; ++j) { g0[j] = g0[j] * __builtin_amdgcn_rcpf(1.f + __expf(-g0[j])); g1[j] = g1[j] * __builtin_amdgcn_rcpf(1.f + __expf(-g1[j])); }
                    *(u32x4*)(V + o) = (u32x4){cvt_pk_bf16(v0[0], v0[1]), cvt_pk_bf16(v0[2], v0[3]), cvt_pk_bf16(v1[0], v1[1]), cvt_pk_bf16(v1[2], v1[3])};
                    *(u32x4*)(G + o) = (u32x4){cvt_pk_bf16(g0[0], g0[1]), cvt_pk_bf16(g0[2], g0[3]), cvt_pk_bf16(g1[0], g1[1]), cvt_pk_bf16(g1[2], g1[3])}; }
        }
    }
};

struct EpiResid {
    static constexpr bool PERM = false;
    const float* x; const float* mod; float* out;
    __device__ __forceinline__ void operator()(const f32x4 (&acc)[2][2][4][2], const Unit& u, int wr, int wc, int fr, int fq) const {
        const int row0 = u.pm * BM + wr * 64 + fr, col0 = u.pn * BM + wc * 32 + 4 * fq;
        const float* gm = mod + (size_t)((u.pm * BM) / NS) * 6144 + 2048 + col0;
        f32x4 gv[2][2];
#pragma unroll
        for (int bj = 0; bj < 2; ++bj)
#pragma unroll
            for (int n = 0; n < 2; ++n) gv[bj][n] = *(const f32x4*)(gm + bj * HALF + n * 16);
#pragma unroll
        for (int ai = 0; ai < 2; ++ai)
#pragma unroll
            for (int m = 0; m < 4; ++m) { const size_t off = (size_t)(row0 + ai * HALF + m * 16) * DM + col0;
#pragma unroll
                for (int bj = 0; bj < 2; ++bj)
#pragma unroll
                    for (int n = 0; n < 2; ++n) { const f32x4 xv = *(const f32x4*)(x + off + bj * HALF + n * 16); *(f32x4*)(out + off + bj * HALF + n * 16) = xv * DN_ALPHA + gv[bj][n] * acc[ai][bj][m][n]; } }
    }
};

struct EpiSwiglu {
    static constexpr bool PERM = true;
    bf16_t* ACT;
    __device__ __forceinline__ void operator()(const f32x4 (&acc)[2][2][4][2], const Unit& u, int wr, int wc, int fr, int fq) const {
        const int row0 = u.pm * BM + wr * 64 + fr, col0 = u.pn * HALF + wc * 32 + 8 * fq;
#pragma unroll
        for (int ai = 0; ai < 2; ++ai)
#pragma unroll
            for (int m = 0; m < 4; ++m) { f32x4 a0 = acc[ai][0][m][0], a1 = acc[ai][0][m][1]; const f32x4 u0 = acc[ai][1][m][0], u1 = acc[ai][1][m][1];
#pragma unroll
                for (int j = 0; j < 4; ++j) { a0[j] = a0[j] * __builtin_amdgcn_rcpf(1.f + __expf(-a0[j])) * u0[j]; a1[j] = a1[j] * __builtin_amdgcn_rcpf(1.f + __expf(-a1[j])) * u1[j]; }
                *(u32x4*)(ACT + (size_t)(row0 + ai * HALF + m * 16) * DEXP + col0) = (u32x4){cvt_pk_bf16(a0[0], a0[1]), cvt_pk_bf16(a0[2], a0[3]), cvt_pk_bf16(a1[0], a1[1]), cvt_pk_bf16(a1[2], a1[3])}; }
    }
};
struct EpiY {
    static constexpr bool PERM = true;
    bf16_t* Y;
    __device__ __forceinline__ void operator()(const f32x4 (&acc)[2][2][4][2], const Unit& u, int wr, int wc, int fr, int fq) const {
        const int row0 = u.pm * BM + wr * 64 + fr, col0 = u.pn * BM + wc * 32 + 8 * fq;
#pragma unroll
        for (int ai = 0; ai < 2; ++ai)
#pragma unroll
            for (int m = 0; m < 4; ++m)
#pragma unroll
                for (int bj = 0; bj < 2; ++bj) { const f32x4 v0 = acc[ai][bj][m][0], v1 = acc[ai][bj][m][1];
                    *(u32x4*)(Y + (size_t)(row0 + ai * HALF + m * 16) * DM + col0 + bj * HALF) = (u32x4){cvt_pk_bf16(v0[0], v0[1]), cvt_pk_bf16(v0[2], v0[3]), cvt_pk_bf16(v1[0], v1[1]), cvt_pk_bf16(v1[2], v1[3])}; }
    }
};
struct MoeOrder {
    const LAS int* tab; int nT; int G, c; bool up; const char* HBp; const char* ACTp; const char* W; const int* list;
    __device__ __forceinline__ bool next(int i, Unit& u) const {
        const long L = (long)i * G + c; if (L >= (long)nT * 4) return false;
        int mt, pn; tile_of((int)L, nT, 4, mt, pn);
        int e = 0;
#pragma unroll 1
        for (int k = 16; k > 0; k >>= 1) if (tab[e + k] <= mt) e += k;
        const int t = mt - tab[e], so = tab[40 + e], n = tab[80 + e];
        u.pm = (so >> 8) + t; u.pn = pn;
        if (up) { u.A = HBp; u.B = W + (size_t)e * (1024 * 1024 * 2) + (size_t)pn * (256 * 1024 * 2); u.rows = list + (size_t)e * MTOK + t * 256; u.nrows = n - t * 256; }
        else { u.A = ACTp + (size_t)u.pm * (256 * DEXP * 2); u.B = W + (size_t)e * (1024 * DEXP * 2) + (size_t)pn * (256 * DEXP * 2); u.rows = nullptr; u.nrows = 256; }
        return true;
    }
};
}

struct Frame { LAS unsigned char* lds; int tid, lane, wave, vcu, G; };
struct Args { Ptrs p; int ph_lo, ph_hi, li, pad; };

__device__ __forceinline__ int srcmap_in(int d) {
    const int pn = d >> 8, bj = (d >> 7) & 1, cc = d & 127, t = pn >> 2, h = pn & 3;
    if (t == 0) return (bj ? 512 : 0) + h * 128 + cc;
    if (t == 1) return (bj ? 1536 : 1024) + h * 128 + cc;
    if (t == 2) return (cc < 64 ? 2048 : 2560 - 64) + h * 128 + bj * 64 + cc;
    return (bj ? 3584 : 3072) + h * 128 + cc;
}
__device__ __forceinline__ void tr_item(const float* W, int ldw, int scol0, int k0, bf16_t* WT, int K, int drow0, LAS float* scr, int lane) {
#pragma unroll 8
    for (int i = 0; i < 32; ++i) { const int kk = 2 * i + (lane >> 5); scr[kk * 33 + (lane & 31)] = W[(size_t)(k0 + kk) * ldw + scol0 + (lane & 31)]; }
    LDS_WAIT(); asm volatile("" ::: "memory");
    const int c = lane & 7;
#pragma unroll
    for (int j = 0; j < 4; ++j) { const int n = (lane >> 3) + 8 * j; const LAS float* s = scr + (8 * c) * 33 + n;
        u32x4 o; o.x = cvt_pk_bf16(s[0 * 33], s[1 * 33]); o.y = cvt_pk_bf16(s[2 * 33], s[3 * 33]); o.z = cvt_pk_bf16(s[4 * 33], s[5 * 33]); o.w = cvt_pk_bf16(s[6 * 33], s[7 * 33]);
        *(u32x4*)(WT + (size_t)(drow0 + n) * K + k0 + 8 * c) = o; }
    LDS_WAIT(); asm volatile("" ::: "memory");
}
__device__ __forceinline__ void p0_prologue(const Ptrs& p, const Frame& F) {
    float* mod = (float*)(p.ws + WS_MOD);
    for (int item = F.vcu; item < 96; item += F.G) {
        LAS float* sc = (LAS float*)F.lds; LAS float* part = (LAS float*)(F.lds + 32768);
        for (int i = F.tid; i < 8192; i += 512) sc[i] = siluf_(p.c[i]);
        __syncthreads();
        const int j = 64 * item + F.lane; float acc[8];
#pragma unroll
        for (int b = 0; b < 8; ++b) acc[b] = 0.f;
#pragma unroll 8
        for (int k = F.wave * 128; k < F.wave * 128 + 128; ++k) { const float w = p.w_ada[(size_t)k * 6144 + j];
#pragma unroll
            for (int b = 0; b < 8; ++b) acc[b] += sc[b * 1024 + k] * w; }
#pragma unroll
        for (int b = 0; b < 8; ++b) part[(F.wave * 8 + b) * 64 + F.lane] = acc[b];
        __syncthreads();
        { const int b = F.wave; float s = p.b_ada[j];
#pragma unroll
            for (int w = 0; w < 8; ++w) s += part[(w * 8 + b) * 64 + F.lane];
            mod[b * 6144 + j] = s; }
        __syncthreads();
    }
    if (F.vcu == F.G - 1) { float* lb = (float*)(p.ws + WS_LB); const int i = F.tid; const float a = p.hgrn_lb[i], b = p.hgrn_lb[512 + i]; const float mx = fmaxf(a, b); const float ea = __expf(a - mx), eb = __expf(b - mx); lb[i] = ea / (ea + eb); }
    { float* cs = (float*)(p.ws + WS_COS); float* sn = (float*)(p.ws + WS_SIN);
      for (int i = F.vcu * 512 + F.tid; i < MTOK * 64; i += F.G * 512) { const int m = i >> 6, f = i & 63;
          const double inv = exp2(-(double)(2 * f) / 128.0 * 13.287712379549449); const double ang = (double)p.pos[m] * inv; double s, c; sincos(ang, &s, &c); cs[i] = (float)c; sn[i] = (float)s; } }
    LAS float* scr = (LAS float*)(F.lds + F.wave * 16384);
    const int gw = F.vcu * NWAVES + F.wave, NGW = F.G * NWAVES;
    constexpr int I_IN = 16 * 128, I_OUT = 16 * 32, I_GU = 32 * 16 * 32, I_DN = 32 * 8 * 32;
    bf16_t* WIN = (bf16_t*)(p.ws + WS_WIN); bf16_t* WOUT = (bf16_t*)(p.ws + WS_WOUT); bf16_t* WGU = (bf16_t*)(p.ws + WS_WGU); bf16_t* WDN = (bf16_t*)(p.ws + WS_WDN);
    for (int it = gw; it < I_IN + I_OUT + I_GU + I_DN; it += NGW) {
        int r = it;
        if (r < I_IN) { const int kb = r >> 7, nb = r & 127; tr_item(p.w_in, DPROJ, srcmap_in(32 * nb), 64 * kb, WIN, DM, 32 * nb, scr, F.lane); continue; } r -= I_IN;
        if (r < I_OUT) { const int kb = r >> 5, nb = r & 31; tr_item(p.w_out, DM, 32 * nb, 64 * kb, WOUT, DM, 32 * nb, scr, F.lane); continue; } r -= I_OUT;
        if (r < I_GU) { const int e = r >> 9, kb = (r >> 5) & 15, nb = r & 31, d0 = 32 * nb, pn = d0 >> 8, bj = (d0 >> 7) & 1, cc = d0 & 127;
            tr_item((bj ? p.w_up : p.w_gate) + (size_t)e * DM * DEXP, DEXP, 128 * pn + cc, 64 * kb, WGU + (size_t)e * 1024 * 1024, DM, d0, scr, F.lane); continue; } r -= I_GU;
        { const int e = r >> 8, kb = (r >> 5) & 7, nb = r & 31; tr_item(p.w_down + (size_t)e * DEXP * DM, DM, 32 * nb, 64 * kb, WDN + (size_t)e * 1024 * DEXP, DEXP, 32 * nb, scr, F.lane); }
    }
}

__device__ __forceinline__ void p1_h1(const Ptrs& p, const Frame& F) {
    const float* mod = (const float*)(p.ws + WS_MOD); bf16_t* hb = (bf16_t*)(p.ws + WS_HB);
    const int gw = F.vcu * NWAVES + F.wave, NGW = F.G * NWAVES;
    for (int m = gw; m < MTOK; m += NGW) {
        const int b = m / NS; const f32x4* xr = (const f32x4*)(p.x + (size_t)m * DM) + F.lane;
        f32x4 v[4]; float s = 0.f;
#pragma unroll
        for (int j = 0; j < 4; ++j) { v[j] = xr[64 * j]; s += (v[j].x + v[j].y) + (v[j].z + v[j].w); }
        const float mean = wave_sum(s) * (1.f / DM); float q = 0.f;
#pragma unroll
        for (int j = 0; j < 4; ++j) { v[j] = v[j] - mean; q += (v[j].x * v[j].x + v[j].y * v[j].y) + (v[j].z * v[j].z + v[j].w * v[j].w); }
        const float rstd = 1.f / sqrtf(wave_sum(q) * (1.f / DM) + LN_EPS);
        const f32x4* sh = (const f32x4*)(mod + b * 6144) + F.lane; const f32x4* scl = (const f32x4*)(mod + b * 6144 + 1024) + F.lane;
        u32x2* o8 = (u32x2*)(hb + (size_t)m * DM) + F.lane;
#pragma unroll
        for (int j = 0; j < 4; ++j) { const f32x4 r = v[j] * rstd * (scl[64 * j] + 1.f) + sh[64 * j]; o8[64 * j] = (u32x2){cvt_pk_bf16(r.x, r.y), cvt_pk_bf16(r.z, r.w)}; }
    }
}

__device__ __forceinline__ void p3_mixer_naive(const Ptrs& p, const Frame& F) {
    if (F.vcu >= 64) return;
    LAS float* qs = (LAS float*)F.lds; LAS float* ks = qs + 128; LAS float* part = ks + 128; LAS float* red = part + 512;
    const int b = F.vcu >> 3, mh = F.vcu & 7, tid = F.tid, j = tid & 127, g = tid >> 7;
    const bf16_t* QI = (const bf16_t*)(p.ws + WS_QI); const bf16_t* KI = (const bf16_t*)(p.ws + WS_KI); const bf16_t* V = (const bf16_t*)(p.ws + WS_V); const bf16_t* G = (const bf16_t*)(p.ws + WS_G);
    const float* DEC = (const float*)(p.ws + WS_DEC); bf16_t* O = (bf16_t*)(p.ws + WS_HB);
    float st[32];
#pragma unroll
    for (int i = 0; i < 32; ++i) st[i] = 0.f;
    const float nw = mh < 4 ? p.hgrn_nw[mh * 128 + j] : p.ret_nw[(mh - 4) * 128 + j];
    for (int s = 0; s < NS; ++s) {
        const size_t m = (size_t)b * NS + s;
        __syncthreads();
        if (tid < 128) qs[tid] = bf2f(QI[m * DM + mh * 128 + tid]); else if (tid < 256) ks[tid - 128] = bf2f(KI[m * DM + mh * 128 + tid - 128]);
        const float v = bf2f(V[m * DM + mh * 128 + j]);
        __syncthreads();
        float acc = 0.f;
#pragma unroll
        for (int i = 0; i < 32; ++i) { st[i] += ks[g * 32 + i] * v; acc += st[i] * qs[g * 32 + i]; }
        part[g * 128 + j] = acc;
        if ((s & 63) == 63) { const int ch = (int)(m >> 6);
#pragma unroll
            for (int i = 0; i < 32; ++i) { const float d = mh < 4 ? DEC[(size_t)ch * 512 + mh * 128 + g * 32 + i] : exp2f(64.f * log2gamma(mh - 4)); st[i] *= d; } }
        __syncthreads();
        float o = 0.f, s1 = 0.f, s2 = 0.f;
        if (tid < 128) { o = part[j] + part[128 + j] + part[256 + j] + part[384 + j]; s1 = wave_sum(o); s2 = wave_sum(o * o); if ((tid & 63) == 0) { red[(tid >> 6) * 2] = s1; red[(tid >> 6) * 2 + 1] = s2; } }
        __syncthreads();
        if (tid < 128) { const float t1 = red[0] + red[2], t2 = red[1] + red[3]; float r;
            if (mh < 4) r = o * (1.f / sqrtf(t2 * (1.f / 128.f) + LN_EPS));
            else { const float mu = t1 * (1.f / 128.f); const float var = fmaxf(t2 * (1.f / 128.f) - mu * mu, 0.f); r = (o - mu) * (1.f / sqrtf(var + LN_EPS)); }
            O[m * DM + mh * 128 + j] = f2bf(r * nw * bf2f(G[m * DM + mh * 128 + j])); }
    }
    __syncthreads();
}

__device__ __forceinline__ void p5_route(const Ptrs& p, const Frame& F) {
    LAS float* WL = (LAS float*)F.lds;
    for (int i = F.tid; i < 1024 * 36; i += 512) { const int col = i / 36, e = i % 36; WL[i] = e < 4 ? p.w_rg[col * 4 + e] : p.w_re[col * 32 + e - 4]; }
    __syncthreads();
    const float* mod = (const float*)(p.ws + WS_MOD); bf16_t* hb = (bf16_t*)(p.ws + WS_HB);
    int* cnt = (int*)(p.ws + WS_CTL) + CW_CNT; int* list = (int*)(p.ws + WS_LIST);
    int* re = (int*)(p.ws + WS_ROUTE); int* rp = re + 2 * MTOK; float* rg = (float*)(rp + 2 * MTOK);
    const int lane = F.lane, gw = F.vcu * NWAVES + F.wave, NGW = F.G * NWAVES;
    const float bias = lane < 4 ? p.b_rg[lane] : (lane < 36 ? p.b_re[lane - 4] : 0.f);
    for (int m = gw; m < MTOK; m += NGW) {
        const int b = m / NS; const float* ur = p.out + (size_t)m * DM;
        float v[16]; float s = 0.f;
#pragma unroll
        for (int j = 0; j < 16; ++j) { v[j] = ur[lane + 64 * j]; s += v[j]; }
        float mean = wave_sum(s) * (1.f / DM); float q = 0.f;
#pragma unroll
        for (int j = 0; j < 16; ++j) { v[j] -= mean; q += v[j] * v[j]; }
        float rstd = 1.f / sqrtf(wave_sum(q) * (1.f / DM) + LN_EPS);
        s = 0.f;
#pragma unroll
        for (int j = 0; j < 16; ++j) { const int col = lane + 64 * j; v[j] = v[j] * rstd * p.ln1w[col] + p.ln1b[col]; s += v[j]; }
        mean = wave_sum(s) * (1.f / DM); q = 0.f;
#pragma unroll
        for (int j = 0; j < 16; ++j) { v[j] -= mean; q += v[j] * v[j]; }
        rstd = 1.f / sqrtf(wave_sum(q) * (1.f / DM) + LN_EPS);
        f32x4 lg[9];
#pragma unroll
        for (int e = 0; e < 9; ++e) lg[e] = (f32x4){0.f, 0.f, 0.f, 0.f};
#pragma unroll
        for (int j = 0; j < 16; ++j) { const int col = lane + 64 * j; const float hv = v[j] * rstd * (1.f + mod[b * 6144 + 4096 + col]) + mod[b * 6144 + 3072 + col];
            hb[(size_t)m * DM + col] = f2bf(hv);
            const LAS f32x4* wrow = (const LAS f32x4*)(WL + col * 36);
#pragma unroll
            for (int e = 0; e < 9; ++e) lg[e] += wrow[e] * hv;
            asm volatile("" ::: "memory"); }
        float tot = 0.f;
#pragma unroll
        for (int e = 0; e < 9; ++e)
#pragma unroll
            for (int c = 0; c < 4; ++c) { const float t = wave_sum(lg[e][c]); tot = (lane == e * 4 + c) ? t : tot; }
        tot += bias;
        const float g0 = __shfl(tot, 0), g1 = __shfl(tot, 1), g2 = __shfl(tot, 2), g3 = __shfl(tot, 3);
        int gs = 0; float gmax = g0;
        if (g1 > gmax) { gmax = g1; gs = 1; } if (g2 > gmax) { gmax = g2; gs = 2; } if (g3 > gmax) { gmax = g3; gs = 3; }
        const float pstar = 1.f / (__expf(g0 - gmax) + __expf(g1 - gmax) + __expf(g2 - gmax) + __expf(g3 - gmax));
        float el[8];
#pragma unroll
        for (int e = 0; e < 8; ++e) el[e] = __shfl(tot, 4 + gs * 8 + e);
        int i1 = 0; float v1 = el[0];
#pragma unroll
        for (int e = 1; e < 8; ++e) if (el[e] > v1) { v1 = el[e]; i1 = e; }
        int i2 = -1; float v2 = -3.0e38f;
#pragma unroll
        for (int e = 0; e < 8; ++e) if (e != i1 && el[e] > v2) { v2 = el[e]; i2 = e; }
        if (lane == 0) {
            const float w1 = 1.f / (1.f + __expf(v2 - v1));
            const int e1 = gs * 8 + i1, e2 = gs * 8 + i2;
            const int p1 = atomicAdd(&cnt[e1], 1), p2 = atomicAdd(&cnt[e2], 1);
            list[e1 * MTOK + p1] = m; list[e2 * MTOK + p2] = m;
            re[m] = e1; re[MTOK + m] = e2; rp[m] = p1; rp[MTOK + m] = p2; rg[m] = pstar * w1; rg[MTOK + m] = pstar * (1.f - w1);
        }
    }
    __syncthreads();
}

__device__ __forceinline__ int moe_tables(const Ptrs& p, const Frame& F) {
    LAS int* tab = (LAS int*)(F.lds + TAB_OFF);
    const int* cnt = (const int*)(p.ws + WS_CTL) + CW_CNT;
    if (F.tid == 0) { int t = 0;
        for (int e = 0; e < NEXP; ++e) { const int c = __hip_atomic_load(cnt + e, __ATOMIC_RELAXED, __HIP_MEMORY_SCOPE_AGENT); tab[e] = t; tab[40 + e] = t * 256; tab[80 + e] = c; t += (c + 255) >> 8; }
        tab[120] = t; }
    __syncthreads();
    return tab[120];
}

__device__ __forceinline__ void p8_final(const Ptrs& p, const Frame& F) {
    const LAS int* tab = (const LAS int*)(F.lds + TAB_OFF);
    const float* mod = (const float*)(p.ws + WS_MOD); const bf16_t* Y = (const bf16_t*)(p.ws + WS_Y);
    const int* re = (const int*)(p.ws + WS_ROUTE); const int* rp = re + 2 * MTOK; const float* rg = (const float*)(rp + 2 * MTOK);
    const int lane = F.lane, gw = F.vcu * NWAVES + F.wave, NGW = F.G * NWAVES;
    for (int m = gw; m < MTOK; m += NGW) {
        const int b = m / NS; f32x4* ur = (f32x4*)(p.out + (size_t)m * DM) + lane;
        const int e1 = re[m], e2 = re[MTOK + m];
        const size_t s1 = (size_t)(tab[40 + e1] + rp[m]), s2 = (size_t)(tab[40 + e2] + rp[MTOK + m]);
        const float g1 = rg[m], g2 = rg[MTOK + m];
        const u32x2* y1 = (const u32x2*)(Y + s1 * DM) + lane; const u32x2* y2 = (const u32x2*)(Y + s2 * DM) + lane;
        const f32x4* w1 = (const f32x4*)p.ln1w + lane; const f32x4* b1 = (const f32x4*)p.ln1b + lane;
        const f32x4* gm = (const f32x4*)(mod + b * 6144 + 5120) + lane;
        f32x4 v[4]; float s = 0.f;
#pragma unroll
        for (int j = 0; j < 4; ++j) { v[j] = ur[64 * j]; s += (v[j].x + v[j].y) + (v[j].z + v[j].w); }
        float mean = wave_sum(s) * (1.f / DM); float q = 0.f;
#pragma unroll
        for (int j = 0; j < 4; ++j) { v[j] = v[j] - mean; q += (v[j].x * v[j].x + v[j].y * v[j].y) + (v[j].z * v[j].z + v[j].w * v[j].w); }
        float rstd = 1.f / sqrtf(wave_sum(q) * (1.f / DM) + LN_EPS);
        s = 0.f;
#pragma unroll
        for (int j = 0; j < 4; ++j) { const f32x4 x1 = v[j] * rstd * w1[64 * j] + b1[64 * j]; const u32x2 a = y1[64 * j], c = y2[64 * j];
            f32x4 y; y.x = g1 * __builtin_bit_cast(float, a.x << 16) + g2 * __builtin_bit_cast(float, c.x << 16); y.y = g1 * __builtin_bit_cast(float, a.x & 0xffff0000u) + g2 * __builtin_bit_cast(float, c.x & 0xffff0000u);
            y.z = g1 * __builtin_bit_cast(float, a.y << 16) + g2 * __builtin_bit_cast(float, c.y << 16); y.w = g1 * __builtin_bit_cast(float, a.y & 0xffff0000u) + g2 * __builtin_bit_cast(float, c.y & 0xffff0000u);
            v[j] = x1 * DN_ALPHA + gm[64 * j] * y; s += (v[j].x + v[j].y) + (v[j].z + v[j].w); }
        mean = wave_sum(s) * (1.f / DM); q = 0.f;
#pragma unroll
        for (int j = 0; j < 4; ++j) { v[j] = v[j] - mean; q += (v[j].x * v[j].x + v[j].y * v[j].y) + (v[j].z * v[j].z + v[j].w * v[j].w); }
        rstd = 1.f / sqrtf(wave_sum(q) * (1.f / DM) + LN_EPS);
        const f32x4* w2 = (const f32x4*)p.ln2w + lane; const f32x4* b2 = (const f32x4*)p.ln2b + lane;
#pragma unroll
        for (int j = 0; j < 4; ++j) ur[64 * j] = v[j] * rstd * w2[64 * j] + b2[64 * j];
    }
}

__global__ void __launch_bounds__(NWAVES * 64, 2) mega_fwd(Args args) {
    extern __shared__ __attribute__((aligned(16))) unsigned char lds_raw[];
    Frame F; F.lds = (LAS unsigned char*)lds_raw;
    F.tid = threadIdx.x; F.lane = F.tid & 63; F.wave = __builtin_amdgcn_readfirstlane(F.tid >> 6);
    F.G = gridDim.x; { const int bx = blockIdx.x; F.vcu = (F.G % 8 == 0) ? (bx % 8) * (F.G / 8) + bx / 8 : bx; }
    const Ptrs& p = args.p;
    volatile LAS unsigned* MISC = (volatile LAS unsigned*)(F.lds + MISC_OFF);
    for (int u = F.tid; u < 256; u += NWAVES * 64) MISC[u] = 0u;
    __syncthreads();
    unsigned* ctl = (unsigned*)(p.ws + WS_CTL);
    XcdBarrier bar = xcd_barrier_post(ctl + CW_BAR + args.li * XCD_BAR_WORDS, MISC + 8);
    const int lo = args.ph_lo, hi = args.ph_hi;
#ifndef PHMASK
#define PHMASK 0x1ff
#endif
#define IN(k) (((PHMASK >> (k)) & 1) && lo <= (k) && (k) < hi)
#define SEAM(k) do { if (IN(k) && IN((k) + 1)) xcd_barrier(bar); } while (0)
    if (IN(0)) { p0_prologue(p, F); } SEAM(0);
    if (IN(1)) { p1_h1(p, F); } SEAM(1);
    if (IN(2)) {
        pg8::DenseOrder S{(const char*)(p.ws + WS_HB), (const char*)(p.ws + WS_WIN), MTOK / 256, DPROJ / 256, DM, F.G, (int)blockIdx.x};
        pg8::EpiProj E{(bf16_t*)(p.ws + WS_QI), (bf16_t*)(p.ws + WS_KI), (bf16_t*)(p.ws + WS_V), (bf16_t*)(p.ws + WS_G), (float*)(p.ws + WS_DEC), (const float*)(p.ws + WS_LB), (const float*)(p.ws + WS_COS), (const float*)(p.ws + WS_SIN)};
        pg8::gemm_phase<pg8::EpiProj, pg8::DenseOrder, false>(F.lds, DM, S, E);
    } SEAM(2);
    if (IN(3)) { p3_mixer_naive(p, F); } SEAM(3);
    if (IN(4)) {
        pg8::DenseOrder S{(const char*)(p.ws + WS_HB), (const char*)(p.ws + WS_WOUT), MTOK / 256, DM / 256, DM, F.G, (int)blockIdx.x};
        pg8::EpiResid E{p.x, (const float*)(p.ws + WS_MOD), p.out};
        pg8::gemm_phase<pg8::EpiResid, pg8::DenseOrder, false>(F.lds, DM, S, E);
    } SEAM(4);
    if (IN(5)) { p5_route(p, F); } SEAM(5);
    int nT = 0;
    if (IN(6) || IN(7) || IN(8)) nT = moe_tables(p, F);
    if (IN(6)) {
        pg8::MoeOrder S{(const LAS int*)(F.lds + TAB_OFF), nT, F.G, (int)blockIdx.x, true, (const char*)(p.ws + WS_HB), nullptr, (const char*)(p.ws + WS_WGU), (const int*)(p.ws + WS_LIST)};
        pg8::EpiSwiglu E{(bf16_t*)(p.ws + WS_ACT)};
        pg8::gemm_phase<pg8::EpiSwiglu, pg8::MoeOrder, true>(F.lds, DM, S, E);
    } SEAM(6);
    if (IN(7)) {
        pg8::MoeOrder S{(const LAS int*)(F.lds + TAB_OFF), nT, F.G, (int)blockIdx.x, false, nullptr, (const char*)(p.ws + WS_ACT), (const char*)(p.ws + WS_WDN), nullptr};
        pg8::EpiY E{(bf16_t*)(p.ws + WS_Y)};
        pg8::gemm_phase<pg8::EpiY, pg8::MoeOrder, false>(F.lds, DEXP, S, E);
    } SEAM(7);
    if (IN(8)) { p8_final(p, F); }
#undef IN
#undef SEAM
}

static int g_grid = 0;
static bool mega_setup() {
    if (g_grid != 0) return g_grid > 0;
    int dev = 0, cus = 0, per_cu = 0;
    if (hipGetDevice(&dev) != hipSuccess || hipDeviceGetAttribute(&cus, hipDeviceAttributeMultiprocessorCount, dev) != hipSuccess) { g_grid = -1; return false; }
    if (hipFuncSetAttribute((const void*)mega_fwd, hipFuncAttributeMaxDynamicSharedMemorySize, LDS_BYTES) != hipSuccess) { fprintf(stderr, "kernel_launch: hipFuncSetAttribute failed\n"); g_grid = -1; return false; }
    if (hipOccupancyMaxActiveBlocksPerMultiprocessor(&per_cu, (const void*)mega_fwd, NWAVES * 64, LDS_BYTES) != hipSuccess || per_cu < 1) { fprintf(stderr, "kernel_launch: occupancy query says %d blocks/CU; not launching\n", per_cu); (void)hipGetLastError(); g_grid = -1; return false; }
    g_grid = cus;
    return true;
}
static void mega_launch(const Ptrs& p, int lo, int hi, int li, hipStream_t stream) {
    Args a{}; a.p = p; a.ph_lo = lo; a.ph_hi = hi; a.li = li; a.pad = 0;
    hipLaunchKernelGGL(mega_fwd, dim3(g_grid), dim3(NWAVES * 64), LDS_BYTES, stream, a);
}

extern "C" void kernel_launch(void* const* d_in, const int* in_sizes, int n_in, void* d_out, int out_size, void* d_ws, size_t ws_size, hipStream_t stream) {
    if (n_in != 21 || out_size != MTOK * DM || ws_size < WS_END) { fprintf(stderr, "kernel_launch: unexpected shapes (n_in %d out %d ws %zu)\n", n_in, out_size, ws_size); return; }
    if (!mega_setup()) return;
    Ptrs p{};
    p.x = (const float*)d_in[0]; p.c = (const float*)d_in[1]; p.pos = (const int*)d_in[2]; p.w_ada = (const float*)d_in[3]; p.b_ada = (const float*)d_in[4];
    p.w_in = (const float*)d_in[5]; p.w_out = (const float*)d_in[6]; p.hgrn_lb = (const float*)d_in[7]; p.hgrn_nw = (const float*)d_in[8]; p.ret_nw = (const float*)d_in[9];
    p.ln1w = (const float*)d_in[10]; p.ln1b = (const float*)d_in[11]; p.w_rg = (const float*)d_in[12]; p.b_rg = (const float*)d_in[13]; p.w_re = (const float*)d_in[14]; p.b_re = (const float*)d_in[15];
    p.w_gate = (const float*)d_in[16]; p.w_up = (const float*)d_in[17]; p.w_down = (const float*)d_in[18]; p.ln2w = (const float*)d_in[19]; p.ln2b = (const float*)d_in[20];
    p.out = (float*)d_out; p.ws = (unsigned char*)d_ws;
    (void)hipMemsetAsync((char*)d_ws + WS_CTL, 0, MiB, stream);
    mega_launch(p, 0, 9, 0, stream);
}
```

```cpp
#include <hip/hip_runtime.h>
#include <stdint.h>
#include <cstdio>

constexpr int NB = 8, NS = 4096, DM = 1024, MTOK = NB * NS, DPROJ = 4096;
constexpr int NEXP = 32, DEXP = 512;
constexpr int NCHUNK = MTOK / 64;
constexpr float LN_EPS = 1e-5f;
constexpr float DN_ALPHA = 1.189207115002721f;
constexpr int NSLOT = 73728;

constexpr size_t MiB = 1u << 20;
constexpr size_t WS_CTL = 0;
constexpr size_t WS_MOD = 1 * MiB;
constexpr size_t WS_LB = 1 * MiB + 512 * 1024;
constexpr size_t WS_ROUTE = 2 * MiB;
constexpr size_t WS_LIST = 4 * MiB;
constexpr size_t WS_COS = 8 * MiB;
constexpr size_t WS_SIN = 16 * MiB;
constexpr size_t WS_DEC = 24 * MiB;
constexpr size_t WS_WIN = 26 * MiB;
constexpr size_t WS_WOUT = 34 * MiB;
constexpr size_t WS_WGU = 36 * MiB;
constexpr size_t WS_WDN = 100 * MiB;
constexpr size_t WS_HB = 132 * MiB;
constexpr size_t WS_QI = 196 * MiB;
constexpr size_t WS_KI = 260 * MiB;
constexpr size_t WS_V = 324 * MiB;
constexpr size_t WS_G = 388 * MiB;
constexpr size_t WS_ACT = 196 * MiB;
constexpr size_t WS_Y = 268 * MiB;
constexpr size_t WS_END = 452 * MiB;
constexpr int CW_CNT = 64;

typedef unsigned short bf16_t;
__device__ __forceinline__ bf16_t f2bf(float f) { unsigned u = __builtin_bit_cast(unsigned, f); return (bf16_t)((u + 0x7fffu + ((u >> 16) & 1u)) >> 16); }
__device__ __forceinline__ float bf2f(bf16_t h) { return __builtin_bit_cast(float, (unsigned)h << 16); }
__device__ __forceinline__ float sigmoidf_(float x) { return 1.f / (1.f + __expf(-x)); }
__device__ __forceinline__ float siluf_(float x) { return x / (1.f + __expf(-x)); }
__device__ __forceinline__ float wave_sum(float v) {
#pragma unroll
    for (int o = 1; o < 64; o <<= 1) v += __shfl_xor(v, o);
    return v;
}
__device__ __forceinline__ float log2gamma(int h) {
    return h == 0 ? -0.04580368961312479f : h == 1 ? -0.02272007650008353f : h == 2 ? -0.011315313227834146f : -0.005646563141142063f;
}

struct Ptrs {
    const float *x, *c; const int* pos; const float *w_ada, *b_ada, *w_in, *w_out, *hgrn_lb, *hgrn_nw, *ret_nw, *ln1w, *ln1b, *w_rg, *b_rg, *w_re, *b_re, *w_gate, *w_up, *w_down, *ln2w, *ln2b;
    float* out; unsigned char* ws;
};

__global__ void __launch_bounds__(256) k_prep(Ptrs p) {
    const int gt = blockIdx.x * blockDim.x + threadIdx.x, NT = gridDim.x * blockDim.x;
    float* mod = (float*)(p.ws + WS_MOD);
    for (int i = gt; i < 8 * 6144; i += NT) {
        const int b = i / 6144, j = i % 6144;
        float acc = p.b_ada[j];
        for (int k = 0; k < DM; ++k) acc += siluf_(p.c[b * DM + k]) * p.w_ada[(size_t)k * 6144 + j];
        mod[i] = acc;
    }
    float* lb = (float*)(p.ws + WS_LB);
    for (int i = gt; i < 512; i += NT) { const float a = p.hgrn_lb[i], b = p.hgrn_lb[512 + i]; const float mx = fmaxf(a, b); const float ea = __expf(a - mx), eb = __expf(b - mx); lb[i] = ea / (ea + eb); }
    float* cs = (float*)(p.ws + WS_COS); float* sn = (float*)(p.ws + WS_SIN);
    for (int i = gt; i < MTOK * 64; i += NT) {
        const int m = i >> 6, f = i & 63;
        const double inv = exp2(-(double)(2 * f) / 128.0 * 13.287712379549449);
        const double ang = (double)p.pos[m] * inv;
        double s, c; sincos(ang, &s, &c);
        cs[i] = (float)c; sn[i] = (float)s;
    }
}

__global__ void __launch_bounds__(256) k_h1(Ptrs p) {
    const int lane = threadIdx.x & 63, gw = (blockIdx.x * blockDim.x + threadIdx.x) >> 6, NW = (gridDim.x * blockDim.x) >> 6;
    const float* mod = (const float*)(p.ws + WS_MOD); bf16_t* hb = (bf16_t*)(p.ws + WS_HB);
    for (int m = gw; m < MTOK; m += NW) {
        const int b = m / NS; const float* xr = p.x + (size_t)m * DM;
        float v[16]; float s = 0.f;
#pragma unroll
        for (int j = 0; j < 16; ++j) { v[j] = xr[lane + 64 * j]; s += v[j]; }
        const float mean = wave_sum(s) * (1.f / DM); float q = 0.f;
#pragma unroll
        for (int j = 0; j < 16; ++j) { v[j] -= mean; q += v[j] * v[j]; }
        const float rstd = 1.f / sqrtf(wave_sum(q) * (1.f / DM) + LN_EPS);
#pragma unroll
        for (int j = 0; j < 16; ++j) { const int col = lane + 64 * j; hb[(size_t)m * DM + col] = f2bf(v[j] * rstd * (1.f + mod[b * 6144 + 1024 + col]) + mod[b * 6144 + col]); }
    }
}

template <class LA, class LB>
__device__ __forceinline__ void naive_tile(float (&acc)[4][4], LA la, LB lb, int K, float* As, float* Bs) {
    const int tid = threadIdx.x, ty = tid >> 4, tx = tid & 15;
#pragma unroll
    for (int i = 0; i < 4; ++i)
#pragma unroll
        for (int j = 0; j < 4; ++j) acc[i][j] = 0.f;
    for (int k0 = 0; k0 < K; k0 += 16) {
        __syncthreads();
#pragma unroll
        for (int i = 0; i < 4; ++i) { const int idx = tid + 256 * i; const int r = idx >> 4, k = idx & 15; As[k * 68 + r] = la(r, k0 + k); }
#pragma unroll
        for (int i = 0; i < 4; ++i) { const int idx = tid + 256 * i; const int k = idx >> 6, c = idx & 63; Bs[k * 64 + c] = lb(k0 + k, c); }
        __syncthreads();
#pragma unroll
        for (int kk = 0; kk < 16; ++kk) {
            float a[4], b[4];
#pragma unroll
            for (int i = 0; i < 4; ++i) a[i] = As[kk * 68 + ty * 4 + i];
#pragma unroll
            for (int j = 0; j < 4; ++j) b[j] = Bs[kk * 64 + tx * 4 + j];
#pragma unroll
            for (int i = 0; i < 4; ++i)
#pragma unroll
                for (int j = 0; j < 4; ++j) acc[i][j] += a[i] * b[j];
        }
    }
}

__global__ void __launch_bounds__(256) k_proj(Ptrs p) {
    __shared__ float As[16 * 68], Bs[16 * 64], L[64 * 65];
    const int rc = blockIdx.x, job = blockIdx.y, tid = threadIdx.x, ty = tid >> 4, tx = tid & 15;
    const bf16_t* hb = (const bf16_t*)(p.ws + WS_HB);
    bf16_t* QI = (bf16_t*)(p.ws + WS_QI); bf16_t* KI = (bf16_t*)(p.ws + WS_KI); bf16_t* V = (bf16_t*)(p.ws + WS_V); bf16_t* G = (bf16_t*)(p.ws + WS_G);
    const int m0 = rc * 64;
    auto la = [&](int r, int k) { return bf2f(hb[(size_t)(m0 + r) * DM + k]); };
    float a0[4][4], a1[4][4];
    if (job < 8) {
        const int h = job >> 1, cg = job & 1, c0 = h * 128 + cg * 64;
        naive_tile(a0, la, [&](int k, int c) { return p.w_in[(size_t)k * DPROJ + c0 + c]; }, DM, As, Bs);
        naive_tile(a1, la, [&](int k, int c) { return p.w_in[(size_t)k * DPROJ + 512 + c0 + c]; }, DM, As, Bs);
        const float* lbv = (const float*)(p.ws + WS_LB);
        float kk[4][4];
        __syncthreads();
#pragma unroll
        for (int i = 0; i < 4; ++i)
#pragma unroll
            for (int j = 0; j < 4; ++j) { const float lb = lbv[c0 + tx * 4 + j], z = a1[i][j]; const float f = lb + (1.f - lb) * sigmoidf_(z); L[(ty * 4 + i) * 65 + tx * 4 + j] = logf(f); kk[i][j] = (1.f - lb) * sigmoidf_(-z); }
        __syncthreads();
        if (tid < 64) { float s = 0.f; for (int r = 0; r < 64; ++r) { s += L[r * 65 + tid]; L[r * 65 + tid] = s; } }
        __syncthreads();
#pragma unroll
        for (int i = 0; i < 4; ++i)
#pragma unroll
            for (int j = 0; j < 4; ++j) { const int r = ty * 4 + i, c = tx * 4 + j; const float b = L[r * 65 + c]; const size_t o = (size_t)(m0 + r) * DM + c0 + c;
                QI[o] = f2bf(siluf_(a0[i][j]) * __expf(b)); KI[o] = f2bf(kk[i][j] * __expf(-b)); }
        if (tid < 64) ((float*)(p.ws + WS_DEC))[(size_t)rc * 512 + c0 + tid] = __expf(L[63 * 65 + tid]);
    } else if (job < 16) {
        const int isk = job >= 12, h = (job - 8) & 3, c0 = (isk ? 2560 : 2048) + h * 128;
        naive_tile(a0, la, [&](int k, int c) { return p.w_in[(size_t)k * DPROJ + c0 + c]; }, DM, As, Bs);
        naive_tile(a1, la, [&](int k, int c) { return p.w_in[(size_t)k * DPROJ + c0 + 64 + c]; }, DM, As, Bs);
        const float* cs = (const float*)(p.ws + WS_COS); const float* sn = (const float*)(p.ws + WS_SIN);
        bf16_t* dst = isk ? KI : QI;
#pragma unroll
        for (int i = 0; i < 4; ++i)
#pragma unroll
            for (int j = 0; j < 4; ++j) { const int r = ty * 4 + i, c = tx * 4 + j, m = m0 + r; const float co = cs[(size_t)m * 64 + c], si = sn[(size_t)m * 64 + c];
                const float t1 = a0[i][j], t2 = a1[i][j]; const float e = (float)(r + 1) * log2gamma(h);
                const float sc = isk ? exp2f(-e) : exp2f(e) * 0.08838834764831845f;
                const size_t o = (size_t)m * DM + 512 + h * 128 + c;
                dst[o] = f2bf((t1 * co - t2 * si) * sc); dst[o + 64] = f2bf((t1 * si + t2 * co) * sc); }
    } else {
        const int idx = job - 16, seg = idx >> 3, cb = idx & 7;
        const int c0 = (seg == 0 ? 1024 : seg == 1 ? 1536 : seg == 2 ? 3072 : 3584) + cb * 64;
        naive_tile(a0, la, [&](int k, int c) { return p.w_in[(size_t)k * DPROJ + c0 + c]; }, DM, As, Bs);
        bf16_t* dst = (seg == 0 || seg == 2) ? V : G; const int oc = (seg >= 2 ? 512 : 0) + cb * 64;
#pragma unroll
        for (int i = 0; i < 4; ++i)
#pragma unroll
            for (int j = 0; j < 4; ++j) { const int r = ty * 4 + i, c = tx * 4 + j; const float v = a0[i][j];
                dst[(size_t)(m0 + r) * DM + oc + c] = f2bf((seg == 0 || seg == 2) ? v : siluf_(v)); }
    }
}

__global__ void __launch_bounds__(512) k_mixer(Ptrs p) {
    __shared__ float qs[128], ks[128], part[4][128], red[16];
    const int b = blockIdx.x >> 3, mh = blockIdx.x & 7, tid = threadIdx.x, j = tid & 127, g = tid >> 7;
    const bf16_t* QI = (const bf16_t*)(p.ws + WS_QI); const bf16_t* KI = (const bf16_t*)(p.ws + WS_KI); const bf16_t* V = (const bf16_t*)(p.ws + WS_V); const bf16_t* G = (const bf16_t*)(p.ws + WS_G);
    const float* DEC = (const float*)(p.ws + WS_DEC); bf16_t* O = (bf16_t*)(p.ws + WS_HB);
    float st[32];
#pragma unroll
    for (int i = 0; i < 32; ++i) st[i] = 0.f;
    const float nw = mh < 4 ? p.hgrn_nw[mh * 128 + j] : p.ret_nw[(mh - 4) * 128 + j];
    for (int s = 0; s < NS; ++s) {
        const size_t m = (size_t)b * NS + s;
        __syncthreads();
        if (tid < 128) qs[tid] = bf2f(QI[m * DM + mh * 128 + tid]); else if (tid < 256) ks[tid - 128] = bf2f(KI[m * DM + mh * 128 + tid - 128]);
        const float v = bf2f(V[m * DM + mh * 128 + j]);
        __syncthreads();
        float acc = 0.f;
#pragma unroll
        for (int i = 0; i < 32; ++i) { st[i] += ks[g * 32 + i] * v; acc += st[i] * qs[g * 32 + i]; }
        part[g][j] = acc;
        if ((s & 63) == 63) {
            const int ch = (int)(m >> 6);
#pragma unroll
            for (int i = 0; i < 32; ++i) { const float d = mh < 4 ? DEC[(size_t)ch * 512 + mh * 128 + g * 32 + i] : exp2f(64.f * log2gamma(mh - 4)); st[i] *= d; }
        }
        __syncthreads();
        float o = 0.f, s1 = 0.f, s2 = 0.f;
        if (tid < 128) { o = part[0][j] + part[1][j] + part[2][j] + part[3][j]; s1 = wave_sum(o); s2 = wave_sum(o * o); if ((tid & 63) == 0) { red[(tid >> 6) * 2] = s1; red[(tid >> 6) * 2 + 1] = s2; } }
        __syncthreads();
        if (tid < 128) {
            const float t1 = red[0] + red[2], t2 = red[1] + red[3]; float r;
            if (mh < 4) r = o * (1.f / sqrtf(t2 * (1.f / 128.f) + LN_EPS));
            else { const float mu = t1 * (1.f / 128.f); const float var = fmaxf(t2 * (1.f / 128.f) - mu * mu, 0.f); r = (o - mu) * (1.f / sqrtf(var + LN_EPS)); }
            O[m * DM + mh * 128 + j] = f2bf(r * nw * bf2f(G[m * DM + mh * 128 + j]));
        }
    }
}

__global__ void __launch_bounds__(256) k_outproj(Ptrs p) {
    __shared__ float As[16 * 68], Bs[16 * 64];
    const int m0 = blockIdx.x * 64, c0 = blockIdx.y * 64, tid = threadIdx.x, ty = tid >> 4, tx = tid & 15;
    const bf16_t* hb = (const bf16_t*)(p.ws + WS_HB); const float* mod = (const float*)(p.ws + WS_MOD);
    float a0[4][4];
    naive_tile(a0, [&](int r, int k) { return bf2f(hb[(size_t)(m0 + r) * DM + k]); }, [&](int k, int c) { return p.w_out[(size_t)k * DM + c0 + c]; }, DM, As, Bs);
    const int b = m0 / NS;
#pragma unroll
    for (int i = 0; i < 4; ++i)
#pragma unroll
        for (int j = 0; j < 4; ++j) { const int m = m0 + ty * 4 + i, c = c0 + tx * 4 + j; p.out[(size_t)m * DM + c] = DN_ALPHA * p.x[(size_t)m * DM + c] + mod[b * 6144 + 2048 + c] * a0[i][j]; }
}

__global__ void __launch_bounds__(256) k_route(Ptrs p) {
    const int lane = threadIdx.x & 63, gw = (blockIdx.x * blockDim.x + threadIdx.x) >> 6, NW = (gridDim.x * blockDim.x) >> 6;
    const float* mod = (const float*)(p.ws + WS_MOD); bf16_t* hb = (bf16_t*)(p.ws + WS_HB);
    int* cnt = (int*)(p.ws + WS_CTL) + CW_CNT; int* list = (int*)(p.ws + WS_LIST);
    int* re = (int*)(p.ws + WS_ROUTE); int* rp = re + 2 * MTOK; float* rg = (float*)(rp + 2 * MTOK);
    for (int m = gw; m < MTOK; m += NW) {
        const int b = m / NS; const float* ur = p.out + (size_t)m * DM;
        float v[16]; float s = 0.f;
#pragma unroll
        for (int j = 0; j < 16; ++j) { v[j] = ur[lane + 64 * j]; s += v[j]; }
        float mean = wave_sum(s) * (1.f / DM); float q = 0.f;
#pragma unroll
        for (int j = 0; j < 16; ++j) { v[j] -= mean; q += v[j] * v[j]; }
        float rstd = 1.f / sqrtf(wave_sum(q) * (1.f / DM) + LN_EPS);
        s = 0.f;
#pragma unroll
        for (int j = 0; j < 16; ++j) { const int col = lane + 64 * j; v[j] = v[j] * rstd * p.ln1w[col] + p.ln1b[col]; s += v[j]; }
        mean = wave_sum(s) * (1.f / DM); q = 0.f;
#pragma unroll
        for (int j = 0; j < 16; ++j) { v[j] -= mean; q += v[j] * v[j]; }
        rstd = 1.f / sqrtf(wave_sum(q) * (1.f / DM) + LN_EPS);
        float lg[36];
#pragma unroll
        for (int e = 0; e < 36; ++e) lg[e] = 0.f;
#pragma unroll
        for (int j = 0; j < 16; ++j) { const int col = lane + 64 * j; const float h = v[j] * rstd * (1.f + mod[b * 6144 + 4096 + col]) + mod[b * 6144 + 3072 + col];
            hb[(size_t)m * DM + col] = f2bf(h);
#pragma unroll
            for (int e = 0; e < 4; ++e) lg[e] += h * p.w_rg[col * 4 + e];
#pragma unroll
            for (int e = 0; e < 32; ++e) lg[4 + e] += h * p.w_re[col * 32 + e]; }
#pragma unroll
        for (int e = 0; e < 36; ++e) lg[e] = wave_sum(lg[e]);
        if (lane == 0) {
            float gl[4]; int gs = 0;
#pragma unroll
            for (int e = 0; e < 4; ++e) gl[e] = lg[e] + p.b_rg[e];
            float gmax = gl[0];
#pragma unroll
            for (int e = 1; e < 4; ++e) if (gl[e] > gmax) { gmax = gl[e]; gs = e; }
            float den = 0.f;
#pragma unroll
            for (int e = 0; e < 4; ++e) den += __expf(gl[e] - gmax);
            const float pstar = 1.f / den;
            float el[8];
#pragma unroll
            for (int e = 0; e < 8; ++e) { float t = 0.f;
#pragma unroll
                for (int g4 = 0; g4 < 4; ++g4) t = (gs == g4) ? lg[4 + g4 * 8 + e] + p.b_re[g4 * 8 + e] : t;
                el[e] = t; }
            int i1 = 0; float v1 = el[0];
#pragma unroll
            for (int e = 1; e < 8; ++e) if (el[e] > v1) { v1 = el[e]; i1 = e; }
            int i2 = -1; float v2 = -3.0e38f;
#pragma unroll
            for (int e = 0; e < 8; ++e) if (e != i1 && el[e] > v2) { v2 = el[e]; i2 = e; }
            const float w1 = 1.f / (1.f + __expf(v2 - v1));
            const int e1 = gs * 8 + i1, e2 = gs * 8 + i2;
            const int p1 = atomicAdd(&cnt[e1], 1), p2 = atomicAdd(&cnt[e2], 1);
            list[e1 * MTOK + p1] = m; list[e2 * MTOK + p2] = m;
            re[m] = e1; re[MTOK + m] = e2; rp[m] = p1; rp[MTOK + m] = p2; rg[m] = pstar * w1; rg[MTOK + m] = pstar * (1.f - w1);
        }
    }
}

__device__ __forceinline__ void moe_find(const int* cnt, int tile64, int& e, int& t, int& off) {
    int acc = 0, o = 0; e = -1;
    for (int i = 0; i < NEXP; ++i) { const int c = cnt[i], nt = (c + 63) >> 6; if (e < 0 && tile64 < acc + nt) { e = i; t = tile64 - acc; off = o; } acc += nt; o += ((c + 255) >> 8) << 8; }
}

__global__ void __launch_bounds__(256) k_moe_up(Ptrs p) {
    __shared__ float As[16 * 68], Bs[16 * 64]; __shared__ int toks[64];
    const int* cnt = (const int*)(p.ws + WS_CTL) + CW_CNT; const int* list = (const int*)(p.ws + WS_LIST);
    int e, t, off; moe_find(cnt, blockIdx.x, e, t, off); if (e < 0) return;
    const int tid = threadIdx.x, ty = tid >> 4, tx = tid & 15, c0 = blockIdx.y * 64, n = cnt[e];
    if (tid < 64) toks[tid] = (t * 64 + tid < n) ? list[e * MTOK + t * 64 + tid] : 0;
    __syncthreads();
    const bf16_t* hb = (const bf16_t*)(p.ws + WS_HB); bf16_t* act = (bf16_t*)(p.ws + WS_ACT);
    const float* wg = p.w_gate + (size_t)e * DM * DEXP; const float* wu = p.w_up + (size_t)e * DM * DEXP;
    float a0[4][4], a1[4][4];
    auto la = [&](int r, int k) { return bf2f(hb[(size_t)toks[r] * DM + k]); };
    naive_tile(a0, la, [&](int k, int c) { return wg[(size_t)k * DEXP + c0 + c]; }, DM, As, Bs);
    naive_tile(a1, la, [&](int k, int c) { return wu[(size_t)k * DEXP + c0 + c]; }, DM, As, Bs);
#pragma unroll
    for (int i = 0; i < 4; ++i)
#pragma unroll
        for (int j = 0; j < 4; ++j) { const int r = t * 64 + ty * 4 + i; if (r < n) act[(size_t)(off + r) * DEXP + c0 + tx * 4 + j] = f2bf(siluf_(a0[i][j]) * a1[i][j]); }
}
__global__ void __launch_bounds__(256) k_moe_down(Ptrs p) {
    __shared__ float As[16 * 68], Bs[16 * 64];
    const int* cnt = (const int*)(p.ws + WS_CTL) + CW_CNT;
    int e, t, off; moe_find(cnt, blockIdx.x, e, t, off); if (e < 0) return;
    const int tid = threadIdx.x, ty = tid >> 4, tx = tid & 15, c0 = blockIdx.y * 64, n = cnt[e];
    const bf16_t* act = (const bf16_t*)(p.ws + WS_ACT); bf16_t* Y = (bf16_t*)(p.ws + WS_Y);
    const float* wd = p.w_down + (size_t)e * DEXP * DM;
    float a0[4][4];
    naive_tile(a0, [&](int r, int k) { const int rr = t * 64 + r; return rr < n ? bf2f(act[(size_t)(off + rr) * DEXP + k]) : 0.f; }, [&](int k, int c) { return wd[(size_t)k * DM + c0 + c]; }, DEXP, As, Bs);
#pragma unroll
    for (int i = 0; i < 4; ++i)
#pragma unroll
        for (int j = 0; j < 4; ++j) { const int r = t * 64 + ty * 4 + i; if (r < n) Y[(size_t)(off + r) * DM + c0 + tx * 4 + j] = f2bf(a0[i][j]); }
}

__global__ void __launch_bounds__(256) k_final(Ptrs p) {
    const int lane = threadIdx.x & 63, gw = (blockIdx.x * blockDim.x + threadIdx.x) >> 6, NW = (gridDim.x * blockDim.x) >> 6;
    const float* mod = (const float*)(p.ws + WS_MOD); const bf16_t* Y = (const bf16_t*)(p.ws + WS_Y);
    const int* cnt = (const int*)(p.ws + WS_CTL) + CW_CNT;
    const int* re = (const int*)(p.ws + WS_ROUTE); const int* rp = re + 2 * MTOK; const float* rg = (const float*)(rp + 2 * MTOK);
    int offs = 0, myoff = 0;
    for (int i = 0; i < NEXP; ++i) { if (i == (lane & 31)) myoff = offs; offs += ((cnt[i] + 255) >> 8) << 8; }
    for (int m = gw; m < MTOK; m += NW) {
        const int b = m / NS; float* ur = p.out + (size_t)m * DM;
        const int e1 = re[m], e2 = re[MTOK + m];
        const int s1 = __shfl(myoff, e1) + rp[m], s2 = __shfl(myoff, e2) + rp[MTOK + m];
        const float g1 = rg[m], g2 = rg[MTOK + m];
        float v[16]; float s = 0.f;
#pragma unroll
        for (int j = 0; j < 16; ++j) { v[j] = ur[lane + 64 * j]; s += v[j]; }
        float mean = wave_sum(s) * (1.f / DM); float q = 0.f;
#pragma unroll
        for (int j = 0; j < 16; ++j) { v[j] -= mean; q += v[j] * v[j]; }
        float rstd = 1.f / sqrtf(wave_sum(q) * (1.f / DM) + LN_EPS);
        s = 0.f;
#pragma unroll
        for (int j = 0; j < 16; ++j) { const int col = lane + 64 * j; const float x1 = v[j] * rstd * p.ln1w[col] + p.ln1b[col];
            const float y = g1 * bf2f(Y[(size_t)s1 * DM + col]) + g2 * bf2f(Y[(size_t)s2 * DM + col]);
            v[j] = DN_ALPHA * x1 + mod[b * 6144 + 5120 + col] * y; s += v[j]; }
        mean = wave_sum(s) * (1.f / DM); q = 0.f;
#pragma unroll
        for (int j = 0; j < 16; ++j) { v[j] -= mean; q += v[j] * v[j]; }
        rstd = 1.f / sqrtf(wave_sum(q) * (1.f / DM) + LN_EPS);
#pragma unroll
        for (int j = 0; j < 16; ++j) { const int col = lane + 64 * j; ur[col] = v[j] * rstd * p.ln2w[col] + p.ln2b[col]; }
    }
}


#define GAS __attribute__((address_space(1)))
#define LAS __attribute__((address_space(3)))
typedef short bf16x8 __attribute__((ext_vector_type(8)));
typedef float f32x4 __attribute__((ext_vector_type(4)));
typedef float f32x2 __attribute__((ext_vector_type(2)));
typedef unsigned u32x4 __attribute__((ext_vector_type(4)));
typedef unsigned u32x2 __attribute__((ext_vector_type(2)));
constexpr int NWAVES = 8;
constexpr int LDS_BYTES = 163840;
constexpr int RING_BYTES = 131072;
constexpr int MISC_OFF = 147456;
constexpr int TAB_OFF = 147456 + 1024;
constexpr int CW_BAR = 4096;

__device__ __forceinline__ unsigned cvt_pk_bf16(float lo, float hi) { unsigned r; asm volatile("v_cvt_pk_bf16_f32 %0, %1, %2" : "=v"(r) : "v"(lo), "v"(hi)); return r; }
#define LDS_WAIT() asm volatile("s_waitcnt lgkmcnt(0)" ::: "memory")
#define VM_WAIT() asm volatile("s_waitcnt vmcnt(0)" ::: "memory")

#define XB_TMO      128
#define XB_XCNT(j)  (256  + 64 * (j))
#define XB_XSUB(j)  (1280 + 64 * (j))
#define XB_XGEN(j)  (2304 + 64 * (j))
#define XB_TOP      3328
#define XB_TOPGEN   3392
#define XCD_BAR_WORDS 3456
#define XB_SPIN_CAP (1u << 18)
__device__ __forceinline__ unsigned xb_ld(unsigned* p)              { return __hip_atomic_load(p, __ATOMIC_RELAXED, __HIP_MEMORY_SCOPE_AGENT); }
__device__ __forceinline__ unsigned xb_add(unsigned* p, unsigned v) { return __hip_atomic_fetch_add(p, v, __ATOMIC_RELAXED, __HIP_MEMORY_SCOPE_AGENT); }
__device__ __forceinline__ unsigned xb_xcc_id() { return (unsigned)__builtin_amdgcn_s_getreg((3 << 11) | 20) & 0xFu; }
#define XB_SPIN(cond, bar) do { unsigned _sp = 0; while (cond) { __builtin_amdgcn_s_sleep(1); \
    if ((++_sp & 255u) == 0u) { if (xb_ld(&(bar)[XB_TMO])) break; if (_sp > XB_SPIN_CAP) { atomicAdd(&(bar)[XB_TMO], 1u); break; } } } } while (0)
struct XcdBarrier { unsigned* bar; unsigned x; volatile LAS unsigned* st; };
__device__ __forceinline__ XcdBarrier xcd_barrier_post(unsigned* bar, volatile LAS unsigned* st) {
    XcdBarrier b; b.bar = bar; b.x = xb_xcc_id(); b.st = st;
    if (threadIdx.x == 0) (void)xb_add(&bar[XB_XCNT(b.x)], 1u);
    return b;
}
__device__ __forceinline__ void xcd_barrier_complete(unsigned* bar, unsigned x, unsigned& nloc, unsigned& nx) {
    const unsigned G = gridDim.x * gridDim.y * gridDim.z;
    unsigned sum, cnt, mine, sp = 0u;
    for (;;) {
        sum = 0u; cnt = 0u; mine = 0u;
#pragma unroll
        for (unsigned j = 0; j < 16; ++j) { const unsigned c = xb_ld(&bar[XB_XCNT(j)]); sum += c; cnt += (c > 0u) ? 1u : 0u; mine = (j == x) ? c : mine; }
        if (sum == G) break;
        __builtin_amdgcn_s_sleep(1);
        if ((++sp & 255u) == 0u) { if (xb_ld(&bar[XB_TMO])) break; if (sp > XB_SPIN_CAP) { atomicAdd(&bar[XB_TMO], 1u); break; } }
    }
    nloc = mine > 0u ? mine : 1u; nx = cnt > 0u ? cnt : 1u;
}
__device__ __forceinline__ void xcd_barrier(const XcdBarrier& b) {
    asm volatile("s_waitcnt vmcnt(0)" ::: "memory");
    __syncthreads();
    if (threadIdx.x == 0) {
        unsigned* bar = b.bar;
        __builtin_amdgcn_s_waitcnt(0);
        unsigned nloc = b.st[0], nx = b.st[1];
        if (nloc == 0u) { xcd_barrier_complete(bar, b.x, nloc, nx); b.st[0] = nloc; b.st[1] = nx; }
        const unsigned old = xb_add(&bar[XB_XSUB(b.x)], 1u);
        const unsigned gen = old / nloc;
        if (old + 1u == (gen + 1u) * nloc) {
            __builtin_amdgcn_fence(__ATOMIC_RELEASE, "agent");
            asm volatile("s_waitcnt vmcnt(0)" ::: "memory");
            const unsigned og = xb_add(&bar[XB_TOP], 1u);
            const unsigned tg = og / nx;
            if (og + 1u == (tg + 1u) * nx) xb_add(&bar[XB_TOPGEN], 1u);
            else XB_SPIN(xb_ld(&bar[XB_TOPGEN]) == tg, bar);
            __builtin_amdgcn_fence(__ATOMIC_ACQUIRE, "agent");
            xb_add(&bar[XB_XGEN(b.x)], 1u);
            asm volatile("s_waitcnt vmcnt(0)" ::: "memory");
        } else {
            XB_SPIN(xb_ld(&bar[XB_XGEN(b.x)]) == gen, bar);
            __builtin_amdgcn_fence(__ATOMIC_ACQUIRE, "agent");
            asm volatile("s_waitcnt vmcnt(0)" ::: "memory");
        }
    }
    __syncthreads();
}

namespace pg8 {
constexpr int BM = 256, BK = 64, HALF = 128, HTB = HALF * BK * 2, NXCD = 8, WGM = 8;
__device__ __forceinline__ int lds_byte(int r, int c) { const int st = (r >> 4) * 2 + (c >> 5), rr = r & 15, cc = c & 31, ob = rr * 64 + cc * 2; return st * 1024 + (ob ^ (((ob >> 9) & 1) << 5)); }
__device__ __forceinline__ void stage_rc(int b, int& R, int& C) { const int st = b / 1024, sb = b % 1024, swz = sb ^ (((sb >> 9) & 1) << 5); R = (st >> 1) * 16 + swz / 64; C = (st & 1) * 32 + (swz % 64) / 2; }
__device__ __forceinline__ int perm32(int rho) { const int n = rho >> 4, i = rho & 15; return 8 * (i >> 2) + 4 * n + (i & 3); }

struct Unit { int pm, pn; const char* A; const char* B; const int* rows; int nrows; };

__device__ __forceinline__ void tile_of(int L, int nM, int nN, int& pm, int& pn) {
    const int nwg = nM * nN; int wgid = L;
    { const int q = nwg / NXCD, r = nwg % NXCD, xcd = wgid % NXCD, off = wgid / NXCD; wgid = (xcd < r ? xcd * (q + 1) : r * (q + 1) + (xcd - r) * q) + off; }
    const int nig = WGM * nN, gid = wgid / nig, fm = gid * WGM, gsz = (nM - fm) < WGM ? (nM - fm) : WGM;
    pm = fm + ((wgid % nig) % gsz); pn = (wgid % nig) / gsz;
}
struct DenseOrder {
    const char* A; const char* Bt; int nM, nN, K, G, c;
    __device__ __forceinline__ bool next(int i, Unit& u) const {
        const long L = (long)i * G + c; if (L >= (long)nM * nN) return false;
        tile_of((int)L, nM, nN, u.pm, u.pn);
        const size_t tstep = (size_t)BM * K * 2; u.A = A + (size_t)u.pm * tstep; u.B = Bt + (size_t)u.pn * tstep; u.rows = nullptr; u.nrows = 256; return true;
    }
};

template <class Epi, class Sched, bool GATHER>
__device__ __forceinline__ void gemm_phase(LAS unsigned char* lds, const int K, const Sched& S, const Epi& E) {
    const int tid = threadIdx.x, wid = __builtin_amdgcn_readfirstlane(tid >> 6), lane = tid & 63, wr = wid >> 2, wc = wid & 3, fr = lane & 15, fq = lane >> 4;
    const int nt = K / BK;
    int RA[2], CA[2]; unsigned voffB[2];
#pragma unroll
    for (int i = 0; i < 2; ++i) { int R, C; stage_rc(tid * 16 + i * 8192, R, C); const int Rb = Epi::PERM ? ((R & ~31) + perm32(R & 31)) : R; RA[i] = R; CA[i] = C; voffB[i] = (unsigned)(Rb * K + C) * 2u; }
    const size_t kstep = (size_t)(BK * 2);
    const size_t hstep = (size_t)HALF * K * 2;
    const unsigned ldsw = (unsigned)wid * 1024u;
    const int aoff = lds_byte(wr * 64 + fr, fq * 8), boff = lds_byte(wc * 32 + fr, fq * 8);
#define PG8_SA(b, h) (((b) * 2 + (h)) * HTB)
#define PG8_SB(b, h) ((4 + (b) * 2 + (h)) * HTB)
#define PG8_STAGE_B(bufoff, gbase) do { _Pragma("unroll") for (int _i = 0; _i < 2; ++_i) \
        __builtin_amdgcn_global_load_lds((const unsigned*)((const char*)(gbase) + voffB[_i]), (LAS unsigned*)(lds + (bufoff) + ldsw + _i * 8192), 16, 0, 0); } while (0)
#define PG8_STAGE_A(bufoff, gbase, o, h) do { _Pragma("unroll") for (int _i = 0; _i < 2; ++_i) \
        __builtin_amdgcn_global_load_lds((const unsigned*)((const char*)(gbase) + (o)[h][_i]), (LAS unsigned*)(lds + (bufoff) + ldsw + _i * 8192), 16, 0, 0); } while (0)
#define PG8_MKOFF(u, o) do { _Pragma("unroll") for (int _h = 0; _h < 2; ++_h) _Pragma("unroll") for (int _i = 0; _i < 2; ++_i) { \
        if (GATHER) { const int _row = 128 * _h + RA[_i]; const int _tok = (_row < (u).nrows) ? (u).rows[_row] : 0; (o)[_h][_i] = (unsigned)_tok * (unsigned)(K * 2) + (unsigned)(CA[_i] * 2); } \
        else (o)[_h][_i] = (unsigned)((RA[_i] + 128 * _h) * K + CA[_i]) * 2u; } } while (0)
#define PG8_LDA(dst, b, h) do { _Pragma("unroll") for (int m = 0; m < 4; ++m) _Pragma("unroll") for (int k = 0; k < 2; ++k) dst[m][k] = *(const LAS bf16x8*)(lds + PG8_SA(b, h) + aoff + m * 2048 + k * 1024); } while (0)
#define PG8_LDB(dst, b, h) do { _Pragma("unroll") for (int n = 0; n < 2; ++n) _Pragma("unroll") for (int k = 0; k < 2; ++k) dst[n][k] = *(const LAS bf16x8*)(lds + PG8_SB(b, h) + boff + n * 2048 + k * 1024); } while (0)
#define PG8_MMA(ai, bj, At, Bt) do { __builtin_amdgcn_s_setprio(1); _Pragma("unroll") for (int m = 0; m < 4; ++m) _Pragma("unroll") for (int n = 0; n < 2; ++n) _Pragma("unroll") for (int k = 0; k < 2; ++k) \
        acc[ai][bj][m][n] = __builtin_amdgcn_mfma_f32_16x16x32_bf16(Bt[n][k], At[m][k], acc[ai][bj][m][n], 0, 0, 0); __builtin_amdgcn_s_setprio(0); } while (0)
#define PG8_WAIT_V(n) asm volatile("s_waitcnt vmcnt(" #n ")" ::: "memory")
#define PG8_WAIT_L(n) asm volatile("s_waitcnt lgkmcnt(" #n ")" ::: "memory")
#define PG8_BAR __builtin_amdgcn_s_barrier()
#define PG8_SCHED __builtin_amdgcn_sched_barrier(0)
    Unit cur, nxt; int ui = 0;
    if (!S.next(0, cur)) return;
    f32x4 acc[2][2][4][2];
#pragma unroll
    for (int a = 0; a < 2; ++a)
#pragma unroll
        for (int b = 0; b < 2; ++b)
#pragma unroll
            for (int m = 0; m < 4; ++m)
#pragma unroll
                for (int n = 0; n < 2; ++n) acc[a][b][m][n] = (f32x4){0.f, 0.f, 0.f, 0.f};
    bf16x8 At[4][2], B0[2][2], B1[2][2];
    unsigned cO[2][2], nO[2][2];
    PG8_MKOFF(cur, cO);
    const char* cA = cur.A; const char* cB = cur.B;
    PG8_STAGE_B(PG8_SB(0, 0), cB); PG8_STAGE_B(PG8_SB(0, 1), cB + hstep); PG8_STAGE_A(PG8_SA(0, 0), cA, cO, 0); PG8_STAGE_A(PG8_SA(0, 1), cA, cO, 1);
    if (wr == 1) PG8_BAR;
    PG8_WAIT_V(2); PG8_BAR;
    PG8_STAGE_B(PG8_SB(1, 0), cB + kstep); PG8_STAGE_A(PG8_SA(1, 0), cA + kstep, cO, 0); PG8_STAGE_B(PG8_SB(1, 1), cB + hstep + kstep);
    PG8_WAIT_V(6); PG8_BAR;
    for (;;) {
        const bool has_next = S.next(ui + 1, nxt);
        const char* nA = has_next ? nxt.A : cA; const char* nB = has_next ? nxt.B : cB;
        if (has_next) { PG8_MKOFF(nxt, nO); } else {
#pragma unroll
            for (int h = 0; h < 2; ++h)
#pragma unroll
                for (int i = 0; i < 2; ++i) nO[h][i] = cO[h][i]; }
        for (int t = 0; t < nt; t += 2) {
            const bool last = (t == nt - 2);
            const char* a1 = cA + (size_t)(t + 1) * kstep;
            const char* a2 = last ? nA : cA + (size_t)(t + 2) * kstep; const char* b2 = last ? nB : cB + (size_t)(t + 2) * kstep;
            const char* a3 = a2 + kstep; const char* b3 = b2 + kstep;
            unsigned o2[2][2];
#pragma unroll
            for (int h = 0; h < 2; ++h)
#pragma unroll
                for (int i = 0; i < 2; ++i) o2[h][i] = last ? nO[h][i] : cO[h][i];
            PG8_LDB(B0, 0, 0); PG8_LDB(B1, 0, 1); PG8_SCHED; PG8_LDA(At, 0, 0); PG8_STAGE_A(PG8_SA(1, 1), a1, cO, 1);
            PG8_WAIT_V(8); PG8_WAIT_L(0); PG8_BAR; PG8_MMA(0, 0, At, B0); PG8_MMA(0, 1, At, B1); PG8_BAR; PG8_SCHED;
            PG8_LDA(At, 0, 1); PG8_STAGE_B(PG8_SB(0, 0), b2); PG8_STAGE_B(PG8_SB(0, 1), b2 + hstep); PG8_STAGE_A(PG8_SA(0, 0), a2, o2, 0);
            PG8_WAIT_V(8); PG8_WAIT_L(0); PG8_BAR; PG8_MMA(1, 0, At, B0); PG8_MMA(1, 1, At, B1); PG8_BAR; PG8_SCHED;
            PG8_LDB(B0, 1, 0); PG8_LDB(B1, 1, 1); PG8_SCHED; PG8_LDA(At, 1, 0); PG8_STAGE_A(PG8_SA(0, 1), a2, o2, 1);
            PG8_WAIT_V(8); PG8_WAIT_L(0); PG8_BAR; PG8_MMA(0, 0, At, B0); PG8_MMA(0, 1, At, B1); PG8_BAR; PG8_SCHED;
            PG8_LDA(At, 1, 1); PG8_STAGE_B(PG8_SB(1, 0), b3); PG8_STAGE_B(PG8_SB(1, 1), b3 + hstep); PG8_STAGE_A(PG8_SA(1, 0), a3, o2, 0);
            PG8_WAIT_V(8); PG8_WAIT_L(0); PG8_BAR; PG8_MMA(1, 0, At, B0); PG8_MMA(1, 1, At, B1); PG8_BAR; PG8_SCHED;
        }
        if (wr == 0) PG8_BAR;
        E(acc, cur, wr, wc, fr, fq);
        if (!has_next) break;
#pragma unroll
        for (int a = 0; a < 2; ++a)
#pragma unroll
            for (int b = 0; b < 2; ++b)
#pragma unroll
                for (int m = 0; m < 4; ++m)
#pragma unroll
                    for (int n = 0; n < 2; ++n) acc[a][b][m][n] = (f32x4){0.f, 0.f, 0.f, 0.f};
        cur = nxt; cA = nA; cB = nB; ++ui;
#pragma unroll
        for (int h = 0; h < 2; ++h)
#pragma unroll
            for (int i = 0; i < 2; ++i) cO[h][i] = nO[h][i];
        if (wr == 1) PG8_BAR;
    }
    PG8_WAIT_V(0);
    PG8_BAR;
#undef PG8_SA
#undef PG8_SB
#undef PG8_STAGE_A
#undef PG8_STAGE_B
#undef PG8_MKOFF
#undef PG8_LDA
#undef PG8_LDB
#undef PG8_MMA
#undef PG8_WAIT_V
#undef PG8_WAIT_L
#undef PG8_BAR
#undef PG8_SCHED
}

template <int CTRL> __device__ __forceinline__ float dpp_mov0(float v) { return __builtin_bit_cast(float, __builtin_amdgcn_update_dpp(0, __builtin_bit_cast(int, v), CTRL, 0xf, 0xf, true)); }
__device__ __forceinline__ float row_scan16(float v) {
    v += dpp_mov0<0x111>(v); v += dpp_mov0<0x112>(v); v += dpp_mov0<0x114>(v); v += dpp_mov0<0x118>(v); return v;
}

struct EpiProj {
    static constexpr bool PERM = true;
    bf16_t *QI, *KI, *V, *G; float* DEC; const float *LB, *COS, *SIN;
    __device__ __forceinline__ void operator()(const f32x4 (&acc)[2][2][4][2], const Unit& u, int wr, int wc, int fr, int fq) const {
        const int typ = u.pn >> 2, h = u.pn & 3, lane = threadIdx.x & 63;
        const int cb = wc * 32 + 8 * fq;
        const int rowb = u.pm * BM + wr * 64 + fr;
        if (typ == 0) {
            const f32x4 lb0 = *(const f32x4*)(LB + h * 128 + cb), lb1 = *(const f32x4*)(LB + h * 128 + cb + 4);
#pragma unroll
            for (int ai = 0; ai < 2; ++ai) {
                unsigned oq[4][4], ok[4][4]; f32x4 dec[2];
#pragma unroll
                for (int n = 0; n < 2; ++n) {
                    float qv[4][4], kv[4][4];
#pragma unroll
                    for (int j = 0; j < 4; ++j) {
                        const float lb = n ? lb1[j] : lb0[j], oml = 1.f - lb;
                        float lf[4], kk[4];
#pragma unroll
                        for (int m = 0; m < 4; ++m) { const float z = fminf(fmaxf(acc[ai][1][m][n][j], -30.f), 30.f); const float e = __expf(-z), r = __builtin_amdgcn_rcpf(1.f + e);
                            lf[m] = __logf(lb + oml * r); kk[m] = oml * e * r; lf[m] = row_scan16(lf[m]); }
                        const float t0 = __shfl(lf[0], lane | 15), t1 = __shfl(lf[1], lane | 15), t2 = __shfl(lf[2], lane | 15);
                        lf[1] += t0; lf[2] += t0 + t1; lf[3] += (t0 + t1) + t2;
#pragma unroll
                        for (int m = 0; m < 4; ++m) { const float eb = __expf(lf[m]), x = acc[ai][0][m][n][j]; qv[m][j] = x * __builtin_amdgcn_rcpf(1.f + __expf(-x)) * eb; kv[m][j] = kk[m] * __expf(-lf[m]); if (m == 3) dec[n][j] = eb; }
                    }
#pragma unroll
                    for (int m = 0; m < 4; ++m) { oq[m][2 * n] = cvt_pk_bf16(qv[m][0], qv[m][1]); oq[m][2 * n + 1] = cvt_pk_bf16(qv[m][2], qv[m][3]); ok[m][2 * n] = cvt_pk_bf16(kv[m][0], kv[m][1]); ok[m][2 * n + 1] = cvt_pk_bf16(kv[m][2], kv[m][3]); }
                }
#pragma unroll
                for (int m = 0; m < 4; ++m) { const size_t o = (size_t)(rowb + ai * HALF + m * 16) * DM + h * 128 + cb;
                    *(u32x4*)(QI + o) = (u32x4){oq[m][0], oq[m][1], oq[m][2], oq[m][3]}; *(u32x4*)(KI + o) = (u32x4){ok[m][0], ok[m][1], ok[m][2], ok[m][3]}; }
                if (fr == 15) { float* d = DEC + (size_t)(u.pm * 4 + ai * 2 + wr) * 512 + h * 128 + cb; *(f32x4*)d = dec[0]; *(f32x4*)(d + 4) = dec[1]; }
            }
        } else if (typ == 2) {
            const bool isk = wc >= 2; const int i0 = (wc & 1) * 32 + 8 * fq;
            bf16_t* dst = isk ? KI : QI; const float l2g = log2gamma(h);
#pragma unroll
            for (int ai = 0; ai < 2; ++ai)
#pragma unroll
                for (int m = 0; m < 4; ++m) { const int row = rowb + ai * HALF + m * 16; const float e = (float)(m * 16 + fr + 1) * l2g;
                    const float sc = isk ? __builtin_amdgcn_exp2f(-e) : __builtin_amdgcn_exp2f(e) * 0.08838834764831845f;
                    const f32x4 c0 = *(const f32x4*)(COS + (size_t)row * 64 + i0), c1 = *(const f32x4*)(COS + (size_t)row * 64 + i0 + 4);
                    const f32x4 s0 = *(const f32x4*)(SIN + (size_t)row * 64 + i0), s1 = *(const f32x4*)(SIN + (size_t)row * 64 + i0 + 4);
                    const f32x4 a0 = acc[ai][0][m][0], a1 = acc[ai][0][m][1], b0 = acc[ai][1][m][0], b1 = acc[ai][1][m][1];
                    const f32x4 x0 = (a0 * c0 - b0 * s0) * sc, x1 = (a1 * c1 - b1 * s1) * sc, y0 = (a0 * s0 + b0 * c0) * sc, y1 = (a1 * s1 + b1 * c1) * sc;
                    const size_t o = (size_t)row * DM + 512 + h * 128 + i0;
                    *(u32x4*)(dst + o) = (u32x4){cvt_pk_bf16(x0[0], x0[1]), cvt_pk_bf16(x0[2], x0[3]), cvt_pk_bf16(x1[0], x1[1]), cvt_pk_bf16(x1[2], x1[3])};
                    *(u32x4*)(dst + o + 64) = (u32x4){cvt_pk_bf16(y0[0], y0[1]), cvt_pk_bf16(y0[2], y0[3]), cvt_pk_bf16(y1[0], y1[1]), cvt_pk_bf16(y1[2], y1[3])}; }
        } else {
            const int mh = (typ == 1 ? 0 : 4) + h;
#pragma unroll
            for (int ai = 0; ai < 2; ++ai)
#pragma unroll
                for (int m = 0; m < 4; ++m) { const size_t o = (size_t)(rowb + ai * HALF + m * 16) * DM + mh * 128 + cb;
                    const f32x4 v0 = acc[ai][0][m][0], v1 = acc[ai][0][m][1]; f32x4 g0 = acc[ai][1][m][0], g1 = acc[ai][1][m][1];
#pragma unroll
                    for (int j = 0; j < 4; ++j) { g0[j] = g0[j] * __builtin_amdgcn_rcpf(1.f + __expf(-g0[j])); g1[j] = g1[j] * __builtin_amdgcn_rcpf(1.f + __expf(-g1[j])); }
                    *(u32x4*)(V + o) = (u32x4){cvt_pk_bf16(v0[0], v0[1]), cvt_pk_bf16(v0[2], v0[3]), cvt_pk_bf16(v1[0], v1[1]), cvt_pk_bf16(v1[2], v1[3])};
                    *(u32x4*)(G + o) = (u32x4){cvt_pk_bf16(g0[0], g0[1]), cvt_pk_bf16(g0[2], g0[3]), cvt_pk_bf16(g1[0], g1[1]), cvt_pk_bf16(g1[2], g1[3])}; }
        }
    }
};

struct EpiResid {
    static constexpr bool PERM = false;
    const float* x; const float* mod; float* out;
    __device__ __forceinline__ void operator()(const f32x4 (&acc)[2][2][4][2], const Unit& u, int wr, int wc, int fr, int fq) const {
        const int row0 = u.pm * BM + wr * 64 + fr, col0 = u.pn * BM + wc * 32 + 4 * fq;
        const float* gm = mod + (size_t)((u.pm * BM) / NS) * 6144 + 2048 + col0;
        f32x4 gv[2][2];
#pragma unroll
        for (int bj = 0; bj < 2; ++bj)
#pragma unroll
            for (int n = 0; n < 2; ++n) gv[bj][n] = *(const f32x4*)(gm + bj * HALF + n * 16);
#pragma unroll
        for (int ai = 0; ai < 2; ++ai)
#pragma unroll
            for (int m = 0; m < 4; ++m) { const size_t off = (size_t)(row0 + ai * HALF + m * 16) * DM + col0;
#pragma unroll
                for (int bj = 0; bj < 2; ++bj)
#pragma unroll
                    for (int n = 0; n < 2; ++n) { const f32x4 xv = *(const f32x4*)(x + off + bj * HALF + n * 16); *(f32x4*)(out + off + bj * HALF + n * 16) = xv * DN_ALPHA + gv[bj][n] * acc[ai][bj][m][n]; } }
    }
};

struct EpiSwiglu {
    static constexpr bool PERM = true;
    bf16_t* ACT;
    __device__ __forceinline__ void operator()(const f32x4 (&acc)[2][2][4][2], const Unit& u, int wr, int wc, int fr, int fq) const {
        const int row0 = u.pm * BM + wr * 64 + fr, col0 = u.pn * HALF + wc * 32 + 8 * fq;
#pragma unroll
        for (int ai = 0; ai < 2; ++ai)
#pragma unroll
            for (int m = 0; m < 4; ++m) { f32x4 a0 = acc[ai][0][m][0], a1 = acc[ai][0][m][1]; const f32x4 u0 = acc[ai][1][m][0], u1 = acc[ai][1][m][1];
#pragma unroll
                for (int j = 0; j < 4; ++j) { a0[j] = a0[j] * __builtin_amdgcn_rcpf(1.f + __expf(-a0[j])) * u0[j]; a1[j] = a1[j] * __builtin_amdgcn_rcpf(1.f + __expf(-a1[j])) * u1[j]; }
                *(u32x4*)(ACT + (size_t)(row0 + ai * HALF + m * 16) * DEXP + col0) = (u32x4){cvt_pk_bf16(a0[0], a0[1]), cvt_pk_bf16(a0[2], a0[3]), cvt_pk_bf16(a1[0], a1[1]), cvt_pk_bf16(a1[2], a1[3])}; }
    }
};
struct EpiY {
    static constexpr bool PERM = true;
    bf16_t* Y;
    __device__ __forceinline__ void operator()(const f32x4 (&acc)[2][2][4][2], const Unit& u, int wr, int wc, int fr, int fq) const {
        const int row0 = u.pm * BM + wr * 64 + fr, col0 = u.pn * BM + wc * 32 + 8 * fq;
#pragma unroll
        for (int ai = 0; ai < 2; ++ai)
#pragma unroll
            for (int m = 0; m < 4; ++m)
#pragma unroll
                for (int bj = 0; bj < 2; ++bj) { const f32x4 v0 = acc[ai][bj][m][0], v1 = acc[ai][bj][m][1];
                    *(u32x4*)(Y + (size_t)(row0 + ai * HALF + m * 16) * DM + col0 + bj * HALF) = (u32x4){cvt_pk_bf16(v0[0], v0[1]), cvt_pk_bf16(v0[2], v0[3]), cvt_pk_bf16(v1[0], v1[1]), cvt_pk_bf16(v1[2], v1[3])}; }
    }
};
struct MoeOrder {
    const LAS int* tab; int nT; int G, c; bool up; const char* HBp; const char* ACTp; const char* W; const int* list;
    __device__ __forceinline__ bool next(int i, Unit& u) const {
        const long L = (long)i * G + c; if (L >= (long)nT * 4) return false;
        int mt, pn; tile_of((int)L, nT, 4, mt, pn);
        int e = 0;
#pragma unroll 1
        for (int k = 16; k > 0; k >>= 1) if (tab[e + k] <= mt) e += k;
        const int t = mt - tab[e], so = tab[40 + e], n = tab[80 + e];
        u.pm = (so >> 8) + t; u.pn = pn;
        if (up) { u.A = HBp; u.B = W + (size_t)e * (1024 * 1024 * 2) + (size_t)pn * (256 * 1024 * 2); u.rows = list + (size_t)e * MTOK + t * 256; u.nrows = n - t * 256; }
        else { u.A = ACTp + (size_t)u.pm * (256 * DEXP * 2); u.B = W + (size_t)e * (1024 * DEXP * 2) + (size_t)pn * (256 * DEXP * 2); u.rows = nullptr; u.nrows = 256; }
        return true;
    }
};
}

struct Frame { LAS unsigned char* lds; int tid, lane, wave, vcu, G; };
struct Args { Ptrs p; int ph_lo, ph_hi, li, pad; };

__device__ __forceinline__ int srcmap_in(int d) {
    const int pn = d >> 8, bj = (d >> 7) & 1, cc = d & 127, t = pn >> 2, h = pn & 3;
    if (t == 0) return (bj ? 512 : 0) + h * 128 + cc;
    if (t == 1) return (bj ? 1536 : 1024) + h * 128 + cc;
    if (t == 2) return (cc < 64 ? 2048 : 2560 - 64) + h * 128 + bj * 64 + cc;
    return (bj ? 3584 : 3072) + h * 128 + cc;
}
__device__ __forceinline__ void tr_item(const float* W, int ldw, int scol0, int k0, bf16_t* WT, int K, int drow0, LAS float* scr, int lane) {
#pragma unroll 8
    for (int i = 0; i < 32; ++i) { const int kk = 2 * i + (lane >> 5); scr[kk * 33 + (lane & 31)] = W[(size_t)(k0 + kk) * ldw + scol0 + (lane & 31)]; }
    LDS_WAIT(); asm volatile("" ::: "memory");
    const int c = lane & 7;
#pragma unroll
    for (int j = 0; j < 4; ++j) { const int n = (lane >> 3) + 8 * j; const LAS float* s = scr + (8 * c) * 33 + n;
        u32x4 o; o.x = cvt_pk_bf16(s[0 * 33], s[1 * 33]); o.y = cvt_pk_bf16(s[2 * 33], s[3 * 33]); o.z = cvt_pk_bf16(s[4 * 33], s[5 * 33]); o.w = cvt_pk_bf16(s[6 * 33], s[7 * 33]);
        *(u32x4*)(WT + (size_t)(drow0 + n) * K + k0 + 8 * c) = o; }
    LDS_WAIT(); asm volatile("" ::: "memory");
}
__device__ __forceinline__ void p0_prologue(const Ptrs& p, const Frame& F) {
    float* mod = (float*)(p.ws + WS_MOD);
    for (int item = F.vcu; item < 96; item += F.G) {
        LAS float* sc = (LAS float*)F.lds; LAS float* part = (LAS float*)(F.lds + 32768);
        for (int i = F.tid; i < 8192; i += 512) sc[i] = siluf_(p.c[i]);
        __syncthreads();
        const int j = 64 * item + F.lane; float acc[8];
#pragma unroll
        for (int b = 0; b < 8; ++b) acc[b] = 0.f;
#pragma unroll 8
        for (int k = F.wave * 128; k < F.wave * 128 + 128; ++k) { const float w = p.w_ada[(size_t)k * 6144 + j];
#pragma unroll
            for (int b = 0; b < 8; ++b) acc[b] += sc[b * 1024 + k] * w; }
#pragma unroll
        for (int b = 0; b < 8; ++b) part[(F.wave * 8 + b) * 64 + F.lane] = acc[b];
        __syncthreads();
        { const int b = F.wave; float s = p.b_ada[j];
#pragma unroll
            for (int w = 0; w < 8; ++w) s += part[(w * 8 + b) * 64 + F.lane];
            mod[b * 6144 + j] = s; }
        __syncthreads();
    }
    if (F.vcu == F.G - 1) { float* lb = (float*)(p.ws + WS_LB); const int i = F.tid; const float a = p.hgrn_lb[i], b = p.hgrn_lb[512 + i]; const float mx = fmaxf(a, b); const float ea = __expf(a - mx), eb = __expf(b - mx); lb[i] = ea / (ea + eb); }
    { float* cs = (float*)(p.ws + WS_COS); float* sn = (float*)(p.ws + WS_SIN);
      for (int i = F.vcu * 512 + F.tid; i < MTOK * 64; i += F.G * 512) { const int m = i >> 6, f = i & 63;
          const double inv = exp2(-(double)(2 * f) / 128.0 * 13.287712379549449); const double ang = (double)p.pos[m] * inv; double s, c; sincos(ang, &s, &c); cs[i] = (float)c; sn[i] = (float)s; } }
    LAS float* scr = (LAS float*)(F.lds + F.wave * 16384);
    const int gw = F.vcu * NWAVES + F.wave, NGW = F.G * NWAVES;
    constexpr int I_IN = 16 * 128, I_OUT = 16 * 32, I_GU = 32 * 16 * 32, I_DN = 32 * 8 * 32;
    bf16_t* WIN = (bf16_t*)(p.ws + WS_WIN); bf16_t* WOUT = (bf16_t*)(p.ws + WS_WOUT); bf16_t* WGU = (bf16_t*)(p.ws + WS_WGU); bf16_t* WDN = (bf16_t*)(p.ws + WS_WDN);
    for (int it = gw; it < I_IN + I_OUT + I_GU + I_DN; it += NGW) {
        int r = it;
        if (r < I_IN) { const int kb = r >> 7, nb = r & 127; tr_item(p.w_in, DPROJ, srcmap_in(32 * nb), 64 * kb, WIN, DM, 32 * nb, scr, F.lane); continue; } r -= I_IN;
        if (r < I_OUT) { const int kb = r >> 5, nb = r & 31; tr_item(p.w_out, DM, 32 * nb, 64 * kb, WOUT, DM, 32 * nb, scr, F.lane); continue; } r -= I_OUT;
        if (r < I_GU) { const int e = r >> 9, kb = (r >> 5) & 15, nb = r & 31, d0 = 32 * nb, pn = d0 >> 8, bj = (d0 >> 7) & 1, cc = d0 & 127;
            tr_item((bj ? p.w_up : p.w_gate) + (size_t)e * DM * DEXP, DEXP, 128 * pn + cc, 64 * kb, WGU + (size_t)e * 1024 * 1024, DM, d0, scr, F.lane); continue; } r -= I_GU;
        { const int e = r >> 8, kb = (r >> 5) & 7, nb = r & 31; tr_item(p.w_down + (size_t)e * DEXP * DM, DM, 32 * nb, 64 * kb, WDN + (size_t)e * 1024 * DEXP, DEXP, 32 * nb, scr, F.lane); }
    }
}

__device__ __forceinline__ void p1_h1(const Ptrs& p, const Frame& F) {
    const float* mod = (const float*)(p.ws + WS_MOD); bf16_t* hb = (bf16_t*)(p.ws + WS_HB);
    const int gw = F.vcu * NWAVES + F.wave, NGW = F.G * NWAVES;
    for (int m = gw; m < MTOK; m += NGW) {
        const int b = m / NS; const f32x4* xr = (const f32x4*)(p.x + (size_t)m * DM) + F.lane;
        f32x4 v[4]; float s = 0.f;
#pragma unroll
        for (int j = 0; j < 4; ++j) { v[j] = xr[64 * j]; s += (v[j].x + v[j].y) + (v[j].z + v[j].w); }
        const float mean = wave_sum(s) * (1.f / DM); float q = 0.f;
#pragma unroll
        for (int j = 0; j < 4; ++j) { v[j] = v[j] - mean; q += (v[j].x * v[j].x + v[j].y * v[j].y) + (v[j].z * v[j].z + v[j].w * v[j].w); }
        const float rstd = 1.f / sqrtf(wave_sum(q) * (1.f / DM) + LN_EPS);
        const f32x4* sh = (const f32x4*)(mod + b * 6144) + F.lane; const f32x4* scl = (const f32x4*)(mod + b * 6144 + 1024) + F.lane;
        u32x2* o8 = (u32x2*)(hb + (size_t)m * DM) + F.lane;
#pragma unroll
        for (int j = 0; j < 4; ++j) { const f32x4 r = v[j] * rstd * (scl[64 * j] + 1.f) + sh[64 * j]; o8[64 * j] = (u32x2){cvt_pk_bf16(r.x, r.y), cvt_pk_bf16(r.z, r.w)}; }
    }
}

__device__ __forceinline__ void p3_mixer_naive(const Ptrs& p, const Frame& F) {
    if (F.vcu >= 64) return;
    LAS float* qs = (LAS float*)F.lds; LAS float* ks = qs + 128; LAS float* part = ks + 128; LAS float* red = part + 512;
    const int b = F.vcu >> 3, mh = F.vcu & 7, tid = F.tid, j = tid & 127, g = tid >> 7;
    const bf16_t* QI = (const bf16_t*)(p.ws + WS_QI); const bf16_t* KI = (const bf16_t*)(p.ws + WS_KI); const bf16_t* V = (const bf16_t*)(p.ws + WS_V); const bf16_t* G = (const bf16_t*)(p.ws + WS_G);
    const float* DEC = (const float*)(p.ws + WS_DEC); bf16_t* O = (bf16_t*)(p.ws + WS_HB);
    float st[32];
#pragma unroll
    for (int i = 0; i < 32; ++i) st[i] = 0.f;
    const float nw = mh < 4 ? p.hgrn_nw[mh * 128 + j] : p.ret_nw[(mh - 4) * 128 + j];
    for (int s = 0; s < NS; ++s) {
        const size_t m = (size_t)b * NS + s;
        __syncthreads();
        if (tid < 128) qs[tid] = bf2f(QI[m * DM + mh * 128 + tid]); else if (tid < 256) ks[tid - 128] = bf2f(KI[m * DM + mh * 128 + tid - 128]);
        const float v = bf2f(V[m * DM + mh * 128 + j]);
        __syncthreads();
        float acc = 0.f;
#pragma unroll
        for (int i = 0; i < 32; ++i) { st[i] += ks[g * 32 + i] * v; acc += st[i] * qs[g * 32 + i]; }
        part[g * 128 + j] = acc;
        if ((s & 63) == 63) { const int ch = (int)(m >> 6);
#pragma unroll
            for (int i = 0; i < 32; ++i) { const float d = mh < 4 ? DEC[(size_t)ch * 512 + mh * 128 + g * 32 + i] : exp2f(64.f * log2gamma(mh - 4)); st[i] *= d; } }
        __syncthreads();
        float o = 0.f, s1 = 0.f, s2 = 0.f;
        if (tid < 128) { o = part[j] + part[128 + j] + part[256 + j] + part[384 + j]; s1 = wave_sum(o); s2 = wave_sum(o * o); if ((tid & 63) == 0) { red[(tid >> 6) * 2] = s1; red[(tid >> 6) * 2 + 1] = s2; } }
        __syncthreads();
        if (tid < 128) { const float t1 = red[0] + red[2], t2 = red[1] + red[3]; float r;
            if (mh < 4) r = o * (1.f / sqrtf(t2 * (1.f / 128.f) + LN_EPS));
            else { const float mu = t1 * (1.f / 128.f); const float var = fmaxf(t2 * (1.f / 128.f) - mu * mu, 0.f); r = (o - mu) * (1.f / sqrtf(var + LN_EPS)); }
            O[m * DM + mh * 128 + j] = f2bf(r * nw * bf2f(G[m * DM + mh * 128 + j])); }
    }
    __syncthreads();
}


namespace mix {
typedef short s16x4 __attribute__((ext_vector_type(4)));
typedef short s16x8 __attribute__((ext_vector_type(8)));
typedef float f32x16 __attribute__((ext_vector_type(16)));
typedef float f32x8 __attribute__((ext_vector_type(8)));
typedef __bf16 bf16v8 __attribute__((ext_vector_type(8)));
typedef __bf16 bf16v4 __attribute__((ext_vector_type(4)));
constexpr int Q_OFF = 0, K_OFF = 32768, V_OFF = 65536, ST_OFF = 98304, PART_OFF = 131072;
#define MFMA32(a, b, c) __builtin_amdgcn_mfma_f32_32x32x16_bf16((a), (b), (c), 0, 0, 0)
__device__ __forceinline__ unsigned img_off(unsigned row, unsigned ch) { return 256u * row + 16u * (ch ^ (((row & 3u) << 2) | ((row >> 2) & 3u))); }
__device__ __forceinline__ s16x8 rowrd(LAS unsigned char* base, unsigned row, unsigned ch) { return *(const LAS s16x8*)(base + img_off(row, ch)); }
__device__ __forceinline__ s16x4 trd(LAS unsigned char* base, unsigned R0, unsigned c32, unsigned lane) {
    const unsigned blk = (lane >> 4) & 1u, q = (lane & 15u) >> 2, p = lane & 3u;
    typedef short v4i16 __attribute__((ext_vector_type(4)));
    return __builtin_bit_cast(s16x4, __builtin_amdgcn_ds_read_tr16_b64_v4i16((LAS v4i16*)(base + img_off(R0 + q, 4u * c32 + 2u * blk + (p >> 1)) + 8u * (p & 1u))));
}
__device__ __forceinline__ s16x8 cat8(s16x4 a, s16x4 b) { return __builtin_shufflevector(a, b, 0, 1, 2, 3, 4, 5, 6, 7); }
__device__ __forceinline__ int crow(int reg, int h) { return (reg & 3) + 8 * (reg >> 2) + 4 * h; }

__device__ __forceinline__ void stage_chunk(const Ptrs& p, LAS unsigned char* lds, int buf, size_t m0, int mh, int tid, int wave) {
    const bf16_t* src[3] = {(const bf16_t*)(p.ws + WS_QI), (const bf16_t*)(p.ws + WS_KI), (const bf16_t*)(p.ws + WS_V)};
#pragma unroll
    for (int x = 0; x < 3; ++x)
#pragma unroll
        for (int i = 0; i < 2; ++i) { const unsigned pc = tid + 512 * i, row = pc >> 4, chp = pc & 15u, ch = chp ^ (((row & 3u) << 2) | ((row >> 2) & 3u));
            __builtin_amdgcn_global_load_lds((const unsigned*)(src[x] + (m0 + row) * DM + mh * 128 + ch * 8), (LAS unsigned*)(lds + x * 32768 + buf * 16384 + wave * 1024 + i * 8192), 16, 0, 0); }
}

__device__ __forceinline__ void mixer_item(const Ptrs& p, const Frame& F, int b, int mh, int c0, int c1) {
    LAS unsigned char* lds = F.lds;
    const int tid = F.tid, lane = F.lane, wave = F.wave, r = lane & 31, h = lane >> 5, rb = wave >> 2, cb = wave & 3;
    const bf16_t* Gp = (const bf16_t*)(p.ws + WS_G); bf16_t* Op = (bf16_t*)(p.ws + WS_HB); const float* DEC = (const float*)(p.ws + WS_DEC);
    const bool hg = mh < 4;
    const float* nwp = hg ? p.hgrn_nw + mh * 128 : p.ret_nw + (mh - 4) * 128;
    float nwv[16];
#pragma unroll
    for (int i = 0; i < 16; ++i) nwv[i] = nwp[32 * cb + crow(i, h)];
    const float dret = exp2f(64.f * log2gamma(mh & 3));
    f32x16 S[2];
#pragma unroll
    for (int ii = 0; ii < 2; ++ii)
#pragma unroll
        for (int i = 0; i < 16; ++i) S[ii][i] = 0.f;
    for (int i = tid; i < 32768 / 16; i += 512) *(LAS u32x4*)(lds + ST_OFF + 16 * i) = (u32x4){0u, 0u, 0u, 0u};
    stage_chunk(p, lds, 0, (size_t)b * NS + (size_t)c0 * 64, mh, tid, wave);
    __syncthreads();
    for (int n = c0; n < c1; ++n) {
        const int cur = (n - c0) & 1;
        const size_t m0 = (size_t)b * NS + (size_t)n * 64;
        if (n + 1 < c1) stage_chunk(p, lds, cur ^ 1, m0 + 64, mh, tid, wave);
        LAS unsigned char* Qb = lds + Q_OFF + cur * 16384; LAS unsigned char* Kb = lds + K_OFF + cur * 16384; LAS unsigned char* Vb = lds + V_OFF + cur * 16384; LAS unsigned char* STb = lds + ST_OFF;
        const size_t tok = m0 + 32 * rb + r;
        u32x2 gv[4];
#pragma unroll
        for (int g = 0; g < 4; ++g) gv[g] = *(const u32x2*)(Gp + tok * DM + mh * 128 + 32 * cb + 8 * g + 4 * h);
        f32x4 dv[2][4];
#pragma unroll
        for (int ii = 0; ii < 2; ++ii)
#pragma unroll
            for (int g = 0; g < 4; ++g) dv[ii][g] = hg ? *(const f32x4*)(DEC + ((size_t)b * 64 + n) * 512 + mh * 128 + 32 * (2 * rb + ii) + 8 * g + 4 * h) : (f32x4){dret, dret, dret, dret};
        s16x8 qf[8];
#pragma unroll
        for (int kk = 0; kk < 8; ++kk) qf[kk] = rowrd(Qb, 32 * rb + r, 2 * kk + h);
        f32x16 o;
#pragma unroll
        for (int i = 0; i < 16; ++i) o[i] = 0.f;
#pragma unroll
        for (int kk = 0; kk < 8; ++kk) o = MFMA32(rowrd(STb, 32 * cb + r, 2 * kk + h), qf[kk], o);
#pragma unroll
        for (int sb = 0; sb < 2; ++sb) {
            if (sb <= rb) {
                f32x16 x;
#pragma unroll
                for (int i = 0; i < 16; ++i) x[i] = 0.f;
#pragma unroll
                for (int kk = 0; kk < 8; ++kk) x = MFMA32(rowrd(Kb, 32 * sb + r, 2 * kk + h), qf[kk], x);
                if (sb == rb) {
#pragma unroll
                    for (int i = 0; i < 16; ++i) x[i] = (r >= crow(i, h)) ? x[i] : 0.f;
                }
#pragma unroll
                for (int s2 = 0; s2 < 2; ++s2) {
                    f32x8 xe;
#pragma unroll
                    for (int i = 0; i < 8; ++i) xe[i] = x[8 * s2 + i];
                    const s16x8 xs = __builtin_bit_cast(s16x8, __builtin_convertvector(xe, bf16v8));
                    const s16x8 va = cat8(trd(Vb, 32 * sb + 16 * s2 + 4 * h, cb, lane), trd(Vb, 32 * sb + 16 * s2 + 8 + 4 * h, cb, lane));
                    o = MFMA32(va, xs, o);
                }
            }
        }
#pragma unroll
        for (int kk = 0; kk < 4; ++kk) {
            const s16x8 vb = cat8(trd(Vb, 16 * kk + 8 * h, cb, lane), trd(Vb, 16 * kk + 8 * h + 4, cb, lane));
#pragma unroll
            for (int ii = 0; ii < 2; ++ii) { const s16x8 ka = cat8(trd(Kb, 16 * kk + 8 * h, 2 * rb + ii, lane), trd(Kb, 16 * kk + 8 * h + 4, 2 * rb + ii, lane)); S[ii] = MFMA32(ka, vb, S[ii]); }
        }
#pragma unroll
        for (int ii = 0; ii < 2; ++ii)
#pragma unroll
            for (int i = 0; i < 16; ++i) S[ii][i] *= dv[ii][i >> 2][i & 3];
        float s1 = 0.f, s2 = 0.f;
#pragma unroll
        for (int i = 0; i < 16; ++i) { s1 += o[i]; s2 += o[i] * o[i]; }
        s1 += __shfl_xor(s1, 32); s2 += __shfl_xor(s2, 32);
        LAS f32x2* PART = (LAS f32x2*)(lds + PART_OFF);
        if (h == 0) PART[(32 * rb + r) * 4 + cb] = (f32x2){s1, s2};
        __syncthreads();
#pragma unroll
        for (int ii = 0; ii < 2; ++ii)
#pragma unroll
            for (int g = 0; g < 4; ++g) { f32x4 sv;
#pragma unroll
                for (int j = 0; j < 4; ++j) sv[j] = S[ii][4 * g + j];
                *(LAS u32x2*)(STb + img_off(32 * cb + r, 4 * (2 * rb + ii) + g) + 8 * h) = __builtin_bit_cast(u32x2, __builtin_convertvector(sv, bf16v4)); }
        { const f32x2 p0 = PART[(32 * rb + r) * 4 + 0], p1 = PART[(32 * rb + r) * 4 + 1], p2 = PART[(32 * rb + r) * 4 + 2], p3 = PART[(32 * rb + r) * 4 + 3];
          const float t1 = (p0.x + p1.x) + (p2.x + p3.x), t2 = (p0.y + p1.y) + (p2.y + p3.y);
          float mu = 0.f, rstd;
          if (hg) rstd = 1.f / sqrtf(t2 * (1.f / 128.f) + LN_EPS);
          else { mu = t1 * (1.f / 128.f); rstd = 1.f / sqrtf(fmaxf(t2 * (1.f / 128.f) - mu * mu, 0.f) + LN_EPS); }
#pragma unroll
          for (int g = 0; g < 4; ++g) { f32x4 ov;
              const float g0 = __builtin_bit_cast(float, gv[g].x << 16), g1 = __builtin_bit_cast(float, gv[g].x & 0xffff0000u), g2 = __builtin_bit_cast(float, gv[g].y << 16), g3 = __builtin_bit_cast(float, gv[g].y & 0xffff0000u);
              ov[0] = (o[4 * g + 0] - mu) * rstd * nwv[4 * g + 0] * g0; ov[1] = (o[4 * g + 1] - mu) * rstd * nwv[4 * g + 1] * g1;
              ov[2] = (o[4 * g + 2] - mu) * rstd * nwv[4 * g + 2] * g2; ov[3] = (o[4 * g + 3] - mu) * rstd * nwv[4 * g + 3] * g3;
              *(u32x2*)(Op + tok * DM + mh * 128 + 32 * cb + 8 * g + 4 * h) = __builtin_bit_cast(u32x2, __builtin_convertvector(ov, bf16v4)); } }
        __syncthreads();
    }
}
#undef MFMA32
}
__device__ __forceinline__ void p3_mixer(const Ptrs& p, const Frame& F) {
    const int st = F.G >= 256 ? 4 : 1;
    if (F.vcu % st != 0 || F.vcu / st >= 64) return;
    const int item = F.vcu / st;
    mix::mixer_item(p, F, item >> 3, item & 7, 0, 64);
}

__device__ __forceinline__ void p5_route(const Ptrs& p, const Frame& F) {
    LAS float* WL = (LAS float*)F.lds;
    for (int i = F.tid; i < 1024 * 36; i += 512) { const int col = i / 36, e = i % 36; WL[i] = e < 4 ? p.w_rg[col * 4 + e] : p.w_re[col * 32 + e - 4]; }
    __syncthreads();
    const float* mod = (const float*)(p.ws + WS_MOD); bf16_t* hb = (bf16_t*)(p.ws + WS_HB);
    int* cnt = (int*)(p.ws + WS_CTL) + CW_CNT; int* list = (int*)(p.ws + WS_LIST);
    int* re = (int*)(p.ws + WS_ROUTE); int* rp = re + 2 * MTOK; float* rg = (float*)(rp + 2 * MTOK);
    const int lane = F.lane, gw = F.vcu * NWAVES + F.wave, NGW = F.G * NWAVES;
    const float bias = lane < 4 ? p.b_rg[lane] : (lane < 36 ? p.b_re[lane - 4] : 0.f);
    for (int m = gw; m < MTOK; m += NGW) {
        const int b = m / NS; const float* ur = p.out + (size_t)m * DM;
        float v[16]; float s = 0.f;
#pragma unroll
        for (int j = 0; j < 16; ++j) { v[j] = ur[lane + 64 * j]; s += v[j]; }
        float mean = wave_sum(s) * (1.f / DM); float q = 0.f;
#pragma unroll
        for (int j = 0; j < 16; ++j) { v[j] -= mean; q += v[j] * v[j]; }
        float rstd = 1.f / sqrtf(wave_sum(q) * (1.f / DM) + LN_EPS);
        s = 0.f;
#pragma unroll
        for (int j = 0; j < 16; ++j) { const int col = lane + 64 * j; v[j] = v[j] * rstd * p.ln1w[col] + p.ln1b[col]; s += v[j]; }
        mean = wave_sum(s) * (1.f / DM); q = 0.f;
#pragma unroll
        for (int j = 0; j < 16; ++j) { v[j] -= mean; q += v[j] * v[j]; }
        rstd = 1.f / sqrtf(wave_sum(q) * (1.f / DM) + LN_EPS);
        f32x4 lg[9];
#pragma unroll
        for (int e = 0; e < 9; ++e) lg[e] = (f32x4){0.f, 0.f, 0.f, 0.f};
#pragma unroll
        for (int j = 0; j < 16; ++j) { const int col = lane + 64 * j; const float hv = v[j] * rstd * (1.f + mod[b * 6144 + 4096 + col]) + mod[b * 6144 + 3072 + col];
            hb[(size_t)m * DM + col] = f2bf(hv);
            const LAS f32x4* wrow = (const LAS f32x4*)(WL + col * 36);
#pragma unroll
            for (int e = 0; e < 9; ++e) lg[e] += wrow[e] * hv;
            asm volatile("" ::: "memory"); }
        float tot = 0.f;
#pragma unroll
        for (int e = 0; e < 9; ++e)
#pragma unroll
            for (int c = 0; c < 4; ++c) { const float t = wave_sum(lg[e][c]); tot = (lane == e * 4 + c) ? t : tot; }
        tot += bias;
        const float g0 = __shfl(tot, 0), g1 = __shfl(tot, 1), g2 = __shfl(tot, 2), g3 = __shfl(tot, 3);
        int gs = 0; float gmax = g0;
        if (g1 > gmax) { gmax = g1; gs = 1; } if (g2 > gmax) { gmax = g2; gs = 2; } if (g3 > gmax) { gmax = g3; gs = 3; }
        const float pstar = 1.f / (__expf(g0 - gmax) + __expf(g1 - gmax) + __expf(g2 - gmax) + __expf(g3 - gmax));
        float el[8];
#pragma unroll
        for (int e = 0; e < 8; ++e) el[e] = __shfl(tot, 4 + gs * 8 + e);
        int i1 = 0; float v1 = el[0];
#pragma unroll
        for (int e = 1; e < 8; ++e) if (el[e] > v1) { v1 = el[e]; i1 = e; }
        int i2 = -1; float v2 = -3.0e38f;
#pragma unroll
        for (int e = 0; e < 8; ++e) if (e != i1 && el[e] > v2) { v2 = el[e]; i2 = e; }
        if (lane == 0) {
            const float w1 = 1.f / (1.f + __expf(v2 - v1));
            const int e1 = gs * 8 + i1, e2 = gs * 8 + i2;
            const int p1 = atomicAdd(&cnt[e1], 1), p2 = atomicAdd(&cnt[e2], 1);
            list[e1 * MTOK + p1] = m; list[e2 * MTOK + p2] = m;
            re[m] = e1; re[MTOK + m] = e2; rp[m] = p1; rp[MTOK + m] = p2; rg[m] = pstar * w1; rg[MTOK + m] = pstar * (1.f - w1);
        }
    }
    __syncthreads();
}

__device__ __forceinline__ int moe_tables(const Ptrs& p, const Frame& F) {
    LAS int* tab = (LAS int*)(F.lds + TAB_OFF);
    const int* cnt = (const int*)(p.ws + WS_CTL) + CW_CNT;
    if (F.tid == 0) { int t = 0;
        for (int e = 0; e < NEXP; ++e) { const int c = __hip_atomic_load(cnt + e, __ATOMIC_RELAXED, __HIP_MEMORY_SCOPE_AGENT); tab[e] = t; tab[40 + e] = t * 256; tab[80 + e] = c; t += (c + 255) >> 8; }
        tab[120] = t; }
    __syncthreads();
    return tab[120];
}

__device__ __forceinline__ void p8_final(const Ptrs& p, const Frame& F) {
    const LAS int* tab = (const LAS int*)(F.lds + TAB_OFF);
    const float* mod = (const float*)(p.ws + WS_MOD); const bf16_t* Y = (const bf16_t*)(p.ws + WS_Y);
    const int* re = (const int*)(p.ws + WS_ROUTE); const int* rp = re + 2 * MTOK; const float* rg = (const float*)(rp + 2 * MTOK);
    const int lane = F.lane, gw = F.vcu * NWAVES + F.wave, NGW = F.G * NWAVES;
    for (int m = gw; m < MTOK; m += NGW) {
        const int b = m / NS; f32x4* ur = (f32x4*)(p.out + (size_t)m * DM) + lane;
        const int e1 = re[m], e2 = re[MTOK + m];
        const size_t s1 = (size_t)(tab[40 + e1] + rp[m]), s2 = (size_t)(tab[40 + e2] + rp[MTOK + m]);
        const float g1 = rg[m], g2 = rg[MTOK + m];
        const u32x2* y1 = (const u32x2*)(Y + s1 * DM) + lane; const u32x2* y2 = (const u32x2*)(Y + s2 * DM) + lane;
        const f32x4* w1 = (const f32x4*)p.ln1w + lane; const f32x4* b1 = (const f32x4*)p.ln1b + lane;
        const f32x4* gm = (const f32x4*)(mod + b * 6144 + 5120) + lane;
        f32x4 v[4]; float s = 0.f;
#pragma unroll
        for (int j = 0; j < 4; ++j) { v[j] = ur[64 * j]; s += (v[j].x + v[j].y) + (v[j].z + v[j].w); }
        float mean = wave_sum(s) * (1.f / DM); float q = 0.f;
#pragma unroll
        for (int j = 0; j < 4; ++j) { v[j] = v[j] - mean; q += (v[j].x * v[j].x + v[j].y * v[j].y) + (v[j].z * v[j].z + v[j].w * v[j].w); }
        float rstd = 1.f / sqrtf(wave_sum(q) * (1.f / DM) + LN_EPS);
        s = 0.f;
#pragma unroll
        for (int j = 0; j < 4; ++j) { const f32x4 x1 = v[j] * rstd * w1[64 * j] + b1[64 * j]; const u32x2 a = y1[64 * j], c = y2[64 * j];
            f32x4 y; y.x = g1 * __builtin_bit_cast(float, a.x << 16) + g2 * __builtin_bit_cast(float, c.x << 16); y.y = g1 * __builtin_bit_cast(float, a.x & 0xffff0000u) + g2 * __builtin_bit_cast(float, c.x & 0xffff0000u);
            y.z = g1 * __builtin_bit_cast(float, a.y << 16) + g2 * __builtin_bit_cast(float, c.y << 16); y.w = g1 * __builtin_bit_cast(float, a.y & 0xffff0000u) + g2 * __builtin_bit_cast(float, c.y & 0xffff0000u);
            v[j] = x1 * DN_ALPHA + gm[64 * j] * y; s += (v[j].x + v[j].y) + (v[j].z + v[j].w); }
        mean = wave_sum(s) * (1.f / DM); q = 0.f;
#pragma unroll
        for (int j = 0; j < 4; ++j) { v[j] = v[j] - mean; q += (v[j].x * v[j].x + v[j].y * v[j].y) + (v[j].z * v[j].z + v[j].w * v[j].w); }
        rstd = 1.f / sqrtf(wave_sum(q) * (1.f / DM) + LN_EPS);
        const f32x4* w2 = (const f32x4*)p.ln2w + lane; const f32x4* b2 = (const f32x4*)p.ln2b + lane;
#pragma unroll
        for (int j = 0; j < 4; ++j) ur[64 * j] = v[j] * rstd * w2[64 * j] + b2[64 * j];
    }
}

__global__ void __launch_bounds__(NWAVES * 64, 2) mega_fwd(Args args) {
    extern __shared__ __attribute__((aligned(16))) unsigned char lds_raw[];
    Frame F; F.lds = (LAS unsigned char*)lds_raw;
    F.tid = threadIdx.x; F.lane = F.tid & 63; F.wave = __builtin_amdgcn_readfirstlane(F.tid >> 6);
    F.G = gridDim.x; { const int bx = blockIdx.x; F.vcu = (F.G % 8 == 0) ? (bx % 8) * (F.G / 8) + bx / 8 : bx; }
    const Ptrs& p = args.p;
    volatile LAS unsigned* MISC = (volatile LAS unsigned*)(F.lds + MISC_OFF);
    for (int u = F.tid; u < 256; u += NWAVES * 64) MISC[u] = 0u;
    __syncthreads();
    unsigned* ctl = (unsigned*)(p.ws + WS_CTL);
    XcdBarrier bar = xcd_barrier_post(ctl + CW_BAR + args.li * XCD_BAR_WORDS, MISC + 8);
    const int lo = args.ph_lo, hi = args.ph_hi;
#ifndef PHMASK
#define PHMASK 0x1ff
#endif
#define IN(k) (((PHMASK >> (k)) & 1) && lo <= (k) && (k) < hi)
#define SEAM(k) do { if (IN(k) && IN((k) + 1)) xcd_barrier(bar); } while (0)
    if (IN(0)) { p0_prologue(p, F); } SEAM(0);
    if (IN(1)) { p1_h1(p, F); } SEAM(1);
    if (IN(2)) {
        pg8::DenseOrder S{(const char*)(p.ws + WS_HB), (const char*)(p.ws + WS_WIN), MTOK / 256, DPROJ / 256, DM, F.G, (int)blockIdx.x};
        pg8::EpiProj E{(bf16_t*)(p.ws + WS_QI), (bf16_t*)(p.ws + WS_KI), (bf16_t*)(p.ws + WS_V), (bf16_t*)(p.ws + WS_G), (float*)(p.ws + WS_DEC), (const float*)(p.ws + WS_LB), (const float*)(p.ws + WS_COS), (const float*)(p.ws + WS_SIN)};
        pg8::gemm_phase<pg8::EpiProj, pg8::DenseOrder, false>(F.lds, DM, S, E);
    } SEAM(2);
    if (IN(3)) {
#ifdef NAIVE_MIXER
        p3_mixer_naive(p, F);
#else
        p3_mixer(p, F);
#endif
    } SEAM(3);
    if (IN(4)) {
        pg8::DenseOrder S{(const char*)(p.ws + WS_HB), (const char*)(p.ws + WS_WOUT), MTOK / 256, DM / 256, DM, F.G, (int)blockIdx.x};
        pg8::EpiResid E{p.x, (const float*)(p.ws + WS_MOD), p.out};
        pg8::gemm_phase<pg8::EpiResid, pg8::DenseOrder, false>(F.lds, DM, S, E);
    } SEAM(4);
    if (IN(5)) { p5_route(p, F); } SEAM(5);
    int nT = 0;
    if (IN(6) || IN(7) || IN(8)) nT = moe_tables(p, F);
    if (IN(6)) {
        pg8::MoeOrder S{(const LAS int*)(F.lds + TAB_OFF), nT, F.G, (int)blockIdx.x, true, (const char*)(p.ws + WS_HB), nullptr, (const char*)(p.ws + WS_WGU), (const int*)(p.ws + WS_LIST)};
        pg8::EpiSwiglu E{(bf16_t*)(p.ws + WS_ACT)};
        pg8::gemm_phase<pg8::EpiSwiglu, pg8::MoeOrder, true>(F.lds, DM, S, E);
    } SEAM(6);
    if (IN(7)) {
        pg8::MoeOrder S{(const LAS int*)(F.lds + TAB_OFF), nT, F.G, (int)blockIdx.x, false, nullptr, (const char*)(p.ws + WS_ACT), (const char*)(p.ws + WS_WDN), nullptr};
        pg8::EpiY E{(bf16_t*)(p.ws + WS_Y)};
        pg8::gemm_phase<pg8::EpiY, pg8::MoeOrder, false>(F.lds, DEXP, S, E);
    } SEAM(7);
    if (IN(8)) { p8_final(p, F); }
#undef IN
#undef SEAM
}

static int g_grid = 0;
static bool mega_setup() {
    if (g_grid != 0) return g_grid > 0;
    int dev = 0, cus = 0, per_cu = 0;
    if (hipGetDevice(&dev) != hipSuccess || hipDeviceGetAttribute(&cus, hipDeviceAttributeMultiprocessorCount, dev) != hipSuccess) { g_grid = -1; return false; }
    if (hipFuncSetAttribute((const void*)mega_fwd, hipFuncAttributeMaxDynamicSharedMemorySize, LDS_BYTES) != hipSuccess) { fprintf(stderr, "kernel_launch: hipFuncSetAttribute failed\n"); g_grid = -1; return false; }
    if (hipOccupancyMaxActiveBlocksPerMultiprocessor(&per_cu, (const void*)mega_fwd, NWAVES * 64, LDS_BYTES) != hipSuccess || per_cu < 1) { fprintf(stderr, "kernel_launch: occupancy query says %d blocks/CU; not launching\n", per_cu); (void)hipGetLastError(); g_grid = -1; return false; }
    g_grid = cus;
    return true;
}
static void mega_launch(const Ptrs& p, int lo, int hi, int li, hipStream_t stream) {
    Args a{}; a.p = p; a.ph_lo = lo; a.ph_hi = hi; a.li = li; a.pad = 0;
    hipLaunchKernelGGL(mega_fwd, dim3(g_grid), dim3(NWAVES * 64), LDS_BYTES, stream, a);
}

extern "C" void kernel_launch(void* const* d_in, const int* in_sizes, int n_in, void* d_out, int out_size, void* d_ws, size_t ws_size, hipStream_t stream) {
    if (n_in != 21 || out_size != MTOK * DM || ws_size < WS_END) { fprintf(stderr, "kernel_launch: unexpected shapes (n_in %d out %d ws %zu)\n", n_in, out_size, ws_size); return; }
    if (!mega_setup()) return;
    Ptrs p{};
    p.x = (const float*)d_in[0]; p.c = (const float*)d_in[1]; p.pos = (const int*)d_in[2]; p.w_ada = (const float*)d_in[3]; p.b_ada = (const float*)d_in[4];
    p.w_in = (const float*)d_in[5]; p.w_out = (const float*)d_in[6]; p.hgrn_lb = (const float*)d_in[7]; p.hgrn_nw = (const float*)d_in[8]; p.ret_nw = (const float*)d_in[9];
    p.ln1w = (const float*)d_in[10]; p.ln1b = (const float*)d_in[11]; p.w_rg = (const float*)d_in[12]; p.b_rg = (const float*)d_in[13]; p.w_re = (const float*)d_in[14]; p.b_re = (const float*)d_in[15];
    p.w_gate = (const float*)d_in[16]; p.w_up = (const float*)d_in[17]; p.w_down = (const float*)d_in[18]; p.ln2w = (const float*)d_in[19]; p.ln2b = (const float*)d_in[20];
    p.out = (float*)d_out; p.ws = (unsigned char*)d_ws;
    (void)hipMemsetAsync((char*)d_ws + WS_CTL, 0, MiB, stream);
    mega_launch(p, 0, 9, 0, stream);
}
```

```cpp
#define X1BF16 1
#include <hip/hip_runtime.h>
#include <stdint.h>
#include <cstdio>

constexpr int NB = 8, NS = 4096, DM = 1024, MTOK = NB * NS, DPROJ = 4096;
constexpr int NEXP = 32, DEXP = 512;
constexpr int NCHUNK = MTOK / 64;
constexpr float LN_EPS = 1e-5f;
constexpr float DN_ALPHA = 1.189207115002721f;
constexpr int NSLOT = 73728;

constexpr size_t MiB = 1u << 20;
constexpr size_t WS_CTL = 0;
constexpr size_t WS_MOD = 1 * MiB;
constexpr size_t WS_LB = 1 * MiB + 512 * 1024;
constexpr size_t WS_ROUTE = 2 * MiB;
constexpr size_t WS_LIST = 4 * MiB;
constexpr size_t WS_COS = 8 * MiB;
constexpr size_t WS_SIN = 16 * MiB;
constexpr size_t WS_DEC = 24 * MiB;
constexpr size_t WS_WIN = 26 * MiB;
constexpr size_t WS_WOUT = 34 * MiB;
constexpr size_t WS_WGU = 36 * MiB;
constexpr size_t WS_WDN = 100 * MiB;
constexpr size_t WS_HB = 132 * MiB;
constexpr size_t WS_QI = 196 * MiB;
constexpr size_t WS_KI = 260 * MiB;
constexpr size_t WS_V = 324 * MiB;
constexpr size_t WS_G = 388 * MiB;
constexpr size_t WS_Y1 = 196 * MiB;
constexpr size_t WS_ACT = 260 * MiB;
constexpr size_t WS_Y = 296 * MiB;
constexpr size_t WS_U = 412 * MiB;
constexpr size_t WS_END = 476 * MiB;
constexpr int CW_CNT = 64;

typedef unsigned short bf16_t;
__device__ __forceinline__ bf16_t f2bf(float f) { unsigned u = __builtin_bit_cast(unsigned, f); return (bf16_t)((u + 0x7fffu + ((u >> 16) & 1u)) >> 16); }
__device__ __forceinline__ float bf2f(bf16_t h) { return __builtin_bit_cast(float, (unsigned)h << 16); }
__device__ __forceinline__ float sigmoidf_(float x) { return 1.f / (1.f + __expf(-x)); }
__device__ __forceinline__ float siluf_(float x) { return x / (1.f + __expf(-x)); }
__device__ __forceinline__ float wave_sum(float v) {
#pragma unroll
    for (int o = 1; o < 64; o <<= 1) v += __shfl_xor(v, o);
    return v;
}
__device__ __forceinline__ float log2gamma(int h) {
    return h == 0 ? -0.04580368961312479f : h == 1 ? -0.02272007650008353f : h == 2 ? -0.011315313227834146f : -0.005646563141142063f;
}

struct Ptrs {
    const float *x, *c; const int* pos; const float *w_ada, *b_ada, *w_in, *w_out, *hgrn_lb, *hgrn_nw, *ret_nw, *ln1w, *ln1b, *w_rg, *b_rg, *w_re, *b_re, *w_gate, *w_up, *w_down, *ln2w, *ln2b;
    float* out; unsigned char* ws;
};


#define GAS __attribute__((address_space(1)))
#define LAS __attribute__((address_space(3)))
typedef short bf16x8 __attribute__((ext_vector_type(8)));
typedef float f32x4 __attribute__((ext_vector_type(4)));
typedef float f32x2 __attribute__((ext_vector_type(2)));
typedef unsigned u32x4 __attribute__((ext_vector_type(4)));
typedef unsigned u32x2 __attribute__((ext_vector_type(2)));
constexpr int NWAVES = 8;
constexpr int LDS_BYTES = 163840;
constexpr int RING_BYTES = 131072;
constexpr int MISC_OFF = 155648;
constexpr int TAB_OFF = 155648 + 1024;
constexpr int CW_BAR = 4096;

__device__ __forceinline__ unsigned cvt_pk_bf16(float lo, float hi) { unsigned r; asm volatile("v_cvt_pk_bf16_f32 %0, %1, %2" : "=v"(r) : "v"(lo), "v"(hi)); return r; }
#define LDS_WAIT() asm volatile("s_waitcnt lgkmcnt(0)" ::: "memory")
#define VM_WAIT() asm volatile("s_waitcnt vmcnt(0)" ::: "memory")

#define XB_TMO      128
#define XB_XCNT(j)  (256  + 64 * (j))
#define XB_XSUB(j)  (1280 + 64 * (j))
#define XB_XGEN(j)  (2304 + 64 * (j))
#define XB_TOP      3328
#define XB_TOPGEN   3392
#define XCD_BAR_WORDS 3456
constexpr int CW_XL = 3840;
constexpr int CW_XCC = 3584;
constexpr int CW_DONE = 2304;
#define XB_SPIN_CAP (1u << 18)
__device__ __forceinline__ unsigned xb_ld(unsigned* p)              { return __hip_atomic_load(p, __ATOMIC_RELAXED, __HIP_MEMORY_SCOPE_AGENT); }
__device__ __forceinline__ unsigned xb_add(unsigned* p, unsigned v) { return __hip_atomic_fetch_add(p, v, __ATOMIC_RELAXED, __HIP_MEMORY_SCOPE_AGENT); }
__device__ __forceinline__ unsigned xb_xcc_id() { return (unsigned)__builtin_amdgcn_s_getreg((3 << 11) | 20) & 0xFu; }
#define XB_SPIN(cond, bar) do { unsigned _sp = 0; while (cond) { __builtin_amdgcn_s_sleep(1); \
    if ((++_sp & 255u) == 0u) { if (xb_ld(&(bar)[XB_TMO])) break; if (_sp > XB_SPIN_CAP) { atomicAdd(&(bar)[XB_TMO], 1u); break; } } } } while (0)
struct XcdBarrier { unsigned* bar; unsigned x; volatile LAS unsigned* st; };
__device__ __forceinline__ XcdBarrier xcd_barrier_post(unsigned* bar, volatile LAS unsigned* st) {
    XcdBarrier b; b.bar = bar; b.x = xb_xcc_id(); b.st = st;
    if (threadIdx.x == 0) (void)xb_add(&bar[XB_XCNT(b.x)], 1u);
    return b;
}
__device__ __forceinline__ void xcd_barrier_complete(unsigned* bar, unsigned x, unsigned& nloc, unsigned& nx) {
    const unsigned G = gridDim.x * gridDim.y * gridDim.z;
    unsigned sum, cnt, mine, sp = 0u;
    for (;;) {
        sum = 0u; cnt = 0u; mine = 0u;
#pragma unroll
        for (unsigned j = 0; j < 16; ++j) { const unsigned c = xb_ld(&bar[XB_XCNT(j)]); sum += c; cnt += (c > 0u) ? 1u : 0u; mine = (j == x) ? c : mine; }
        if (sum == G) break;
        __builtin_amdgcn_s_sleep(1);
        if ((++sp & 255u) == 0u) { if (xb_ld(&bar[XB_TMO])) break; if (sp > XB_SPIN_CAP) { atomicAdd(&bar[XB_TMO], 1u); break; } }
    }
    nloc = mine > 0u ? mine : 1u; nx = cnt > 0u ? cnt : 1u;
}
template <bool INV = true, class PF>
__device__ __forceinline__ void xcd_local_barrier(unsigned* cnt, unsigned nloc, const int tid, PF&& pf) {
    asm volatile("s_waitcnt vmcnt(0)" ::: "memory");
    __syncthreads();
    if (tid >= 64) pf();
    if (tid == 0) {
        (void)xb_add(cnt, 1u);
        unsigned sp = 0u;
        while (xb_ld(cnt) < nloc) { __builtin_amdgcn_s_sleep(1); if (++sp > XB_SPIN_CAP) break; }
        if (INV) { __builtin_amdgcn_fence(__ATOMIC_ACQUIRE, "agent"); asm volatile("s_waitcnt vmcnt(0)" ::: "memory"); }
    }
    __syncthreads();
    if (tid < 64) pf();
}
template <bool INV = true>
__device__ __forceinline__ void xcd_local_barrier(unsigned* cnt, unsigned nloc, const int tid) { xcd_local_barrier<INV>(cnt, nloc, tid, []() {}); }
template <class PF>
__device__ __forceinline__ void xcd_barrier(const XcdBarrier& b, const int tid, PF&& pf) {
    asm volatile("s_waitcnt vmcnt(0)" ::: "memory");
    __syncthreads();
    if (tid >= 64) pf();
    if (tid == 0) {
        unsigned* bar = b.bar;
        __builtin_amdgcn_s_waitcnt(0);
        unsigned nloc = b.st[0], nx = b.st[1];
        if (nloc == 0u) { xcd_barrier_complete(bar, b.x, nloc, nx); b.st[0] = nloc; b.st[1] = nx; }
        const unsigned old = xb_add(&bar[XB_XSUB(b.x)], 1u);
        const unsigned gen = old / nloc;
        if (old + 1u == (gen + 1u) * nloc) {
            __builtin_amdgcn_fence(__ATOMIC_RELEASE, "agent");
            asm volatile("s_waitcnt vmcnt(0)" ::: "memory");
            const unsigned og = xb_add(&bar[XB_TOP], 1u);
            const unsigned tg = og / nx;
            if (og + 1u == (tg + 1u) * nx) xb_add(&bar[XB_TOPGEN], 1u);
            else XB_SPIN(xb_ld(&bar[XB_TOPGEN]) == tg, bar);
            __builtin_amdgcn_fence(__ATOMIC_ACQUIRE, "agent");
            xb_add(&bar[XB_XGEN(b.x)], 1u);
            asm volatile("s_waitcnt vmcnt(0)" ::: "memory");
        } else {
            XB_SPIN(xb_ld(&bar[XB_XGEN(b.x)]) == gen, bar);
            __builtin_amdgcn_fence(__ATOMIC_ACQUIRE, "agent");
            asm volatile("s_waitcnt vmcnt(0)" ::: "memory");
        }
    }
    __syncthreads();
    if (tid < 64) pf();
}
__device__ __forceinline__ void xcd_barrier(const XcdBarrier& b, const int tid) { xcd_barrier(b, tid, []() {}); }

namespace pg8 {
constexpr int BM = 256, BK = 64, HALF = 128, HTB = HALF * BK * 2, NXCD = 8, WGM = 8;
__device__ __forceinline__ int lds_byte(int r, int c) { const int st = (r >> 4) * 2 + (c >> 5), rr = r & 15, cc = c & 31, ob = rr * 64 + cc * 2; return st * 1024 + (ob ^ (((ob >> 9) & 1) << 5)); }
__device__ __forceinline__ void stage_rc(int b, int& R, int& C) { const int st = b / 1024, sb = b % 1024, swz = sb ^ (((sb >> 9) & 1) << 5); R = (st >> 1) * 16 + swz / 64; C = (st & 1) * 32 + (swz % 64) / 2; }
__device__ __forceinline__ int perm32(int rho) { const int n = rho >> 4, i = rho & 15; return 8 * (i >> 2) + 4 * n + (i & 3); }

struct Unit { int pm, pn; const char* A; const char* B; const int* rows; int nrows; };

__device__ __forceinline__ void tile_of(int L, int nM, int nN, int& pm, int& pn) {
    const int nwg = nM * nN; int wgid = L;
    { const int q = nwg / NXCD, r = nwg % NXCD, xcd = wgid % NXCD, off = wgid / NXCD; wgid = (xcd < r ? xcd * (q + 1) : r * (q + 1) + (xcd - r) * q) + off; }
    const int nig = WGM * nN, gid = wgid / nig, fm = gid * WGM, gsz = (nM - fm) < WGM ? (nM - fm) : WGM;
    pm = fm + ((wgid % nig) % gsz); pn = (wgid % nig) / gsz;
}
struct DenseOrder {
    const char* A; const char* Bt; int nM, nN, K, G, c;
    __device__ __forceinline__ bool next(int i, Unit& u) const {
        const long L = (long)i * G + c; if (L >= (long)nM * nN) return false;
        tile_of((int)L, nM, nN, u.pm, u.pn);
        const size_t tstep = (size_t)BM * K * 2; u.A = A + (size_t)u.pm * tstep; u.B = Bt + (size_t)u.pn * tstep; u.rows = nullptr; u.nrows = 256; return true;
    }
};

template <class Epi, class Sched, bool GATHER, bool FP8 = false>
__device__ __forceinline__ void gemm_phase(LAS unsigned char* lds, const int tid, const int K, const Sched& S, const Epi& E) {
    const int wid = __builtin_amdgcn_readfirstlane(tid >> 6), lane = tid & 63, wr = wid >> 2, wc = wid & 3, fr = lane & 15, fq = lane >> 4;
    const int nt = K / BK;
    int RA[2], CA[2]; unsigned voffB[2];
#pragma unroll
    for (int i = 0; i < 2; ++i) { int R, C; stage_rc(tid * 16 + i * 8192, R, C); const int Rb = Epi::PERM ? ((R & ~31) + perm32(R & 31)) : R; RA[i] = R; CA[i] = C; voffB[i] = (unsigned)(Rb * K + C) * 2u; }
    const size_t kstep = (size_t)(BK * 2);
    const size_t hstep = (size_t)HALF * K * 2;
    const unsigned ldsw = (unsigned)wid * 1024u;
    const int aoff = lds_byte(wr * 64 + fr, FP8 ? fq * 16 : fq * 8), boff = lds_byte(wc * 32 + fr, FP8 ? fq * 16 : fq * 8);
    typedef int v8i_t __attribute__((ext_vector_type(8)));
    const int scA = E.scale_a(), scB = E.scale_b();
#define PG8_SA(b, h) (((b) * 2 + (h)) * HTB)
#define PG8_SB(b, h) ((4 + (b) * 2 + (h)) * HTB)
#define PG8_STAGE_B(bufoff, gbase) do { _Pragma("unroll") for (int _i = 0; _i < 2; ++_i) \
        __builtin_amdgcn_global_load_lds((const unsigned*)((const char*)(gbase) + voffB[_i]), (LAS unsigned*)(lds + (bufoff) + ldsw + _i * 8192), 16, 0, 0); } while (0)
#define PG8_STAGE_A(bufoff, gbase, o, h) do { _Pragma("unroll") for (int _i = 0; _i < 2; ++_i) \
        __builtin_amdgcn_global_load_lds((const unsigned*)((const char*)(gbase) + (o)[h][_i]), (LAS unsigned*)(lds + (bufoff) + ldsw + _i * 8192), 16, 0, 0); } while (0)
#define PG8_MKOFF(u, o) do { _Pragma("unroll") for (int _h = 0; _h < 2; ++_h) _Pragma("unroll") for (int _i = 0; _i < 2; ++_i) { \
        if (GATHER) { const int _row = 128 * _h + RA[_i]; const int _tok = (_row < (u).nrows) ? (u).rows[_row] : 0; (o)[_h][_i] = (unsigned)_tok * (unsigned)(K * 2) + (unsigned)(CA[_i] * 2); } \
        else (o)[_h][_i] = (unsigned)((RA[_i] + 128 * _h) * K + CA[_i]) * 2u; } } while (0)
#define PG8_CAT8(x, y) __builtin_bit_cast(v8i_t, __builtin_shufflevector((x), (y), 0, 1, 2, 3, 4, 5, 6, 7, 8, 9, 10, 11, 12, 13, 14, 15))
#define PG8_LDA(dst, b, h) do { _Pragma("unroll") for (int m = 0; m < 4; ++m) { \
        if (FP8) dst##8[m] = PG8_CAT8(*(const LAS bf16x8*)(lds + PG8_SA(b, h) + aoff + m * 2048), *(const LAS bf16x8*)(lds + PG8_SA(b, h) + aoff + 16 + m * 2048)); \
        else { dst[m][0] = *(const LAS bf16x8*)(lds + PG8_SA(b, h) + aoff + m * 2048); dst[m][1] = *(const LAS bf16x8*)(lds + PG8_SA(b, h) + aoff + 1024 + m * 2048); } } } while (0)
#define PG8_LDB(dst, b, h) do { _Pragma("unroll") for (int n = 0; n < 2; ++n) { \
        if (FP8) dst##8[n] = PG8_CAT8(*(const LAS bf16x8*)(lds + PG8_SB(b, h) + boff + n * 2048), *(const LAS bf16x8*)(lds + PG8_SB(b, h) + boff + 16 + n * 2048)); \
        else { dst[n][0] = *(const LAS bf16x8*)(lds + PG8_SB(b, h) + boff + n * 2048); dst[n][1] = *(const LAS bf16x8*)(lds + PG8_SB(b, h) + boff + 1024 + n * 2048); } } } while (0)
#define PG8_MMA(ai, bj, At, Bt) do { if (FP8) __builtin_amdgcn_sched_barrier(0); __builtin_amdgcn_s_setprio(1); _Pragma("unroll") for (int m = 0; m < 4; ++m) _Pragma("unroll") for (int n = 0; n < 2; ++n) { \
        if (FP8) acc[ai][bj][m][n] = __builtin_amdgcn_mfma_scale_f32_16x16x128_f8f6f4(Bt##8[n], At##8[m], acc[ai][bj][m][n], 0, 0, 0, scB, 0, scA); \
        else { _Pragma("unroll") for (int k = 0; k < 2; ++k) acc[ai][bj][m][n] = __builtin_amdgcn_mfma_f32_16x16x32_bf16(Bt[n][k], At[m][k], acc[ai][bj][m][n], 0, 0, 0); } } \
        __builtin_amdgcn_s_setprio(0); if (FP8) { _Pragma("unroll") for (int m = 0; m < 4; ++m) _Pragma("unroll") for (int n = 0; n < 2; ++n) asm volatile("" : "+v"(acc[ai][bj][m][n])); __builtin_amdgcn_sched_barrier(0); } } while (0)
#define PG8_WAIT_V(n) asm volatile("s_waitcnt vmcnt(" #n ")" ::: "memory")
#define PG8_WAIT_L(n) asm volatile("s_waitcnt lgkmcnt(" #n ")" ::: "memory")
#define PG8_BAR __builtin_amdgcn_s_barrier()
#define PG8_SCHED __builtin_amdgcn_sched_barrier(0)
    Unit cur, nxt; int ui = 0;
    if (!S.next(0, cur)) return;
    f32x4 acc[2][2][4][2];
#pragma unroll
    for (int a = 0; a < 2; ++a)
#pragma unroll
        for (int b = 0; b < 2; ++b)
#pragma unroll
            for (int m = 0; m < 4; ++m)
#pragma unroll
                for (int n = 0; n < 2; ++n) acc[a][b][m][n] = (f32x4){0.f, 0.f, 0.f, 0.f};
    bf16x8 At[4][2], B0[2][2], B1[2][2]; v8i_t At8[4], B08[2], B18[2];
    unsigned cO[2][2], nO[2][2];
    PG8_MKOFF(cur, cO);
    bool has_next = S.next(1, nxt);
    if (has_next) { PG8_MKOFF(nxt, nO); } else {
#pragma unroll
        for (int h = 0; h < 2; ++h)
#pragma unroll
            for (int i = 0; i < 2; ++i) nO[h][i] = cO[h][i]; }
    const char* cA = cur.A; const char* cB = cur.B;
    PG8_STAGE_B(PG8_SB(0, 0), cB); PG8_STAGE_B(PG8_SB(0, 1), cB + hstep); PG8_STAGE_A(PG8_SA(0, 0), cA, cO, 0); PG8_STAGE_A(PG8_SA(0, 1), cA, cO, 1);
    if (wr == 1) PG8_BAR;
    PG8_WAIT_V(2); PG8_BAR;
    PG8_STAGE_B(PG8_SB(1, 0), cB + kstep); PG8_STAGE_A(PG8_SA(1, 0), cA + kstep, cO, 0); PG8_STAGE_B(PG8_SB(1, 1), cB + hstep + kstep);
    PG8_WAIT_V(6); PG8_BAR;
    for (;;) {
        const char* nA = has_next ? nxt.A : cA; const char* nB = has_next ? nxt.B : cB;
#pragma unroll 1
        for (int t = 0; t < nt; t += 2) {
            const bool last = (t == nt - 2);
            const char* a1 = cA + (size_t)(t + 1) * kstep;
            const char* a2 = last ? nA : cA + (size_t)(t + 2) * kstep; const char* b2 = last ? nB : cB + (size_t)(t + 2) * kstep;
            const char* a3 = a2 + kstep; const char* b3 = b2 + kstep;
            unsigned o2[2][2];
#pragma unroll
            for (int h = 0; h < 2; ++h)
#pragma unroll
                for (int i = 0; i < 2; ++i) o2[h][i] = last ? nO[h][i] : cO[h][i];
            PG8_LDB(B0, 0, 0); PG8_LDB(B1, 0, 1); PG8_SCHED; PG8_LDA(At, 0, 0); PG8_STAGE_A(PG8_SA(1, 1), a1, cO, 1);
            PG8_WAIT_V(8); PG8_WAIT_L(0); PG8_BAR; PG8_MMA(0, 0, At, B0); PG8_MMA(0, 1, At, B1); PG8_BAR; PG8_SCHED;
            PG8_LDA(At, 0, 1); PG8_STAGE_B(PG8_SB(0, 0), b2); PG8_STAGE_B(PG8_SB(0, 1), b2 + hstep); PG8_STAGE_A(PG8_SA(0, 0), a2, o2, 0);
            PG8_WAIT_V(8); PG8_WAIT_L(0); PG8_BAR; PG8_MMA(1, 0, At, B0); PG8_MMA(1, 1, At, B1); PG8_BAR; PG8_SCHED;
            PG8_LDB(B0, 1, 0); PG8_LDB(B1, 1, 1); PG8_SCHED; PG8_LDA(At, 1, 0); PG8_STAGE_A(PG8_SA(0, 1), a2, o2, 1);
            PG8_WAIT_V(8); PG8_WAIT_L(0); PG8_BAR; PG8_MMA(0, 0, At, B0); PG8_MMA(0, 1, At, B1); PG8_BAR; PG8_SCHED;
            PG8_LDA(At, 1, 1); PG8_STAGE_B(PG8_SB(1, 0), b3); PG8_STAGE_B(PG8_SB(1, 1), b3 + hstep); PG8_STAGE_A(PG8_SA(1, 0), a3, o2, 0);
            PG8_WAIT_V(8); PG8_WAIT_L(0); PG8_BAR; PG8_MMA(1, 0, At, B0); PG8_MMA(1, 1, At, B1); PG8_BAR; PG8_SCHED;
        }
        if (wr == 0) PG8_BAR;
        E(acc, cur, wr, wc, fr, fq);
        E.post(cur, lane);
        if (!has_next) break;
#pragma unroll
        for (int a = 0; a < 2; ++a)
#pragma unroll
            for (int b = 0; b < 2; ++b)
#pragma unroll
                for (int m = 0; m < 4; ++m)
#pragma unroll
                    for (int n = 0; n < 2; ++n) acc[a][b][m][n] = (f32x4){0.f, 0.f, 0.f, 0.f};
        cur = nxt; cA = nA; cB = nB; ++ui;
#pragma unroll
        for (int h = 0; h < 2; ++h)
#pragma unroll
            for (int i = 0; i < 2; ++i) cO[h][i] = nO[h][i];
        has_next = S.next(ui + 1, nxt);
        if (has_next) { PG8_MKOFF(nxt, nO); }
        if (wr == 1) PG8_BAR;
    }
    PG8_WAIT_V(0);
    PG8_BAR;
#undef PG8_SA
#undef PG8_SB
#undef PG8_STAGE_A
#undef PG8_STAGE_B
#undef PG8_MKOFF
#undef PG8_LDA
#undef PG8_LDB
#undef PG8_MMA
#undef PG8_CAT8
#undef PG8_WAIT_V
#undef PG8_WAIT_L
#undef PG8_BAR
#undef PG8_SCHED
}

template <int CTRL> __device__ __forceinline__ float dpp_mov0(float v) { return __builtin_bit_cast(float, __builtin_amdgcn_update_dpp(0, __builtin_bit_cast(int, v), CTRL, 0xf, 0xf, true)); }
__device__ __forceinline__ float row_scan16(float v) {
    v += dpp_mov0<0x111>(v); v += dpp_mov0<0x112>(v); v += dpp_mov0<0x114>(v); v += dpp_mov0<0x118>(v); return v;
}
template <int CTRL> __device__ __forceinline__ float dpp_mov1(float v) { return __builtin_bit_cast(float, __builtin_amdgcn_update_dpp(0x3f800000, __builtin_bit_cast(int, v), CTRL, 0xf, 0xf, false)); }
__device__ __forceinline__ float row_scanmul16(float v) {
    v *= dpp_mov1<0x111>(v); v *= dpp_mov1<0x112>(v); v *= dpp_mov1<0x114>(v); v *= dpp_mov1<0x118>(v); return v;
}

struct EpiProj {
    static constexpr bool PERM = true;
    __device__ __forceinline__ int scale_a() const { return 0; } __device__ __forceinline__ int scale_b() const { return 0; }
    __device__ __forceinline__ void post(const Unit&, int) const {}
    bf16_t *QI, *KI, *V, *G; float* DEC; const float *LB, *COS, *SIN;
    __device__ __forceinline__ void operator()(const f32x4 (&acc)[2][2][4][2], const Unit& u, int wr, int wc, int fr, int fq) const {
        const int typ = u.pn >> 2, h = u.pn & 3, lane = fq * 16 + fr;
        const int cb = wc * 32 + 8 * fq;
        const int rowb = u.pm * BM + wr * 64 + fr;
        if (typ == 0) {
            const f32x4 lb0 = *(const f32x4*)(LB + h * 128 + cb), lb1 = *(const f32x4*)(LB + h * 128 + cb + 4);
#pragma unroll
            for (int ai = 0; ai < 2; ++ai) {
                unsigned oq[4][4], ok[4][4]; f32x4 dec[2];
#pragma unroll
                for (int n = 0; n < 2; ++n) {
                    float qv[4][4], kv[4][4];
#pragma unroll
                    for (int j = 0; j < 4; ++j) {
                        const float lb = n ? lb1[j] : lb0[j], oml = 1.f - lb;
                        float lf[4], kk[4];
#pragma unroll
                        for (int m = 0; m < 4; ++m) { const float z = fminf(fmaxf(acc[ai][1][m][n][j], -30.f), 30.f); const float e = __expf(-z), r = __builtin_amdgcn_rcpf(1.f + e);
                            lf[m] = lb + oml * r; kk[m] = oml * e * r; lf[m] = row_scanmul16(lf[m]); }
                        const float t0 = dpp_mov0<0x15F>(lf[0]), t1 = dpp_mov0<0x15F>(lf[1]), t2 = dpp_mov0<0x15F>(lf[2]);
                        lf[1] *= t0; lf[2] *= t0 * t1; lf[3] *= (t0 * t1) * t2;
#pragma unroll
                        for (int m = 0; m < 4; ++m) { const float eb = lf[m], x = acc[ai][0][m][n][j]; qv[m][j] = x * __builtin_amdgcn_rcpf(1.f + __expf(-x)) * eb; kv[m][j] = kk[m] * __builtin_amdgcn_rcpf(eb); if (m == 3) dec[n][j] = eb; }
                    }
#pragma unroll
                    for (int m = 0; m < 4; ++m) { oq[m][2 * n] = cvt_pk_bf16(qv[m][0], qv[m][1]); oq[m][2 * n + 1] = cvt_pk_bf16(qv[m][2], qv[m][3]); ok[m][2 * n] = cvt_pk_bf16(kv[m][0], kv[m][1]); ok[m][2 * n + 1] = cvt_pk_bf16(kv[m][2], kv[m][3]); }
                }
#pragma unroll
                for (int m = 0; m < 4; ++m) { const size_t o = (size_t)(rowb + ai * HALF + m * 16) * DM + h * 128 + cb;
                    __builtin_nontemporal_store((u32x4){oq[m][0], oq[m][1], oq[m][2], oq[m][3]}, (u32x4*)(QI + o)); __builtin_nontemporal_store((u32x4){ok[m][0], ok[m][1], ok[m][2], ok[m][3]}, (u32x4*)(KI + o)); }
                if (fr == 15) { float* d = DEC + (size_t)(u.pm * 4 + ai * 2 + wr) * 1024 + h * 128 + cb; *(f32x4*)d = dec[0]; *(f32x4*)(d + 4) = dec[1]; }
            }
        } else if (typ == 2) {
            const bool isk = wc >= 2; const int i0 = (wc & 1) * 32 + 8 * fq;
            bf16_t* dst = isk ? KI : QI; const float l2g = log2gamma(h);
#pragma unroll
            for (int ai = 0; ai < 2; ++ai)
#pragma unroll
                for (int m = 0; m < 4; ++m) { const int row = rowb + ai * HALF + m * 16; const float e = (float)(m * 16 + fr + 1) * l2g;
                    const float sc = isk ? __builtin_amdgcn_exp2f(-e) : __builtin_amdgcn_exp2f(e) * 0.08838834764831845f;
                    const f32x4 c0 = *(const f32x4*)(COS + (size_t)row * 64 + i0), c1 = *(const f32x4*)(COS + (size_t)row * 64 + i0 + 4);
                    const f32x4 s0 = *(const f32x4*)(SIN + (size_t)row * 64 + i0), s1 = *(const f32x4*)(SIN + (size_t)row * 64 + i0 + 4);
                    const f32x4 a0 = acc[ai][0][m][0], a1 = acc[ai][0][m][1], b0 = acc[ai][1][m][0], b1 = acc[ai][1][m][1];
                    const f32x4 x0 = (a0 * c0 - b0 * s0) * sc, x1 = (a1 * c1 - b1 * s1) * sc, y0 = (a0 * s0 + b0 * c0) * sc, y1 = (a1 * s1 + b1 * c1) * sc;
                    const size_t o = (size_t)row * DM + 512 + h * 128 + i0;
                    __builtin_nontemporal_store((u32x4){cvt_pk_bf16(x0[0], x0[1]), cvt_pk_bf16(x0[2], x0[3]), cvt_pk_bf16(x1[0], x1[1]), cvt_pk_bf16(x1[2], x1[3])}, (u32x4*)(dst + o));
                    __builtin_nontemporal_store((u32x4){cvt_pk_bf16(y0[0], y0[1]), cvt_pk_bf16(y0[2], y0[3]), cvt_pk_bf16(y1[0], y1[1]), cvt_pk_bf16(y1[2], y1[3])}, (u32x4*)(dst + o + 64)); }
        } else {
            const int mh = (typ == 1 ? 0 : 4) + h;
#pragma unroll
            for (int ai = 0; ai < 2; ++ai)
#pragma unroll
                for (int m = 0; m < 4; ++m) { const size_t o = (size_t)(rowb + ai * HALF + m * 16) * DM + mh * 128 + cb;
                    const f32x4 v0 = acc[ai][0][m][0], v1 = acc[ai][0][m][1]; f32x4 g0 = acc[ai][1][m][0], g1 = acc[ai][1][m][1];
#pragma unroll
                    for (int j = 0; j < 4; ++j) { g0[j] = g0[j] * __builtin_amdgcn_rcpf(1.f + __expf(-g0[j])); g1[j] = g1[j] * __builtin_amdgcn_rcpf(1.f + __expf(-g1[j])); }
                    __builtin_nontemporal_store((u32x4){cvt_pk_bf16(v0[0], v0[1]), cvt_pk_bf16(v0[2], v0[3]), cvt_pk_bf16(v1[0], v1[1]), cvt_pk_bf16(v1[2], v1[3])}, (u32x4*)(V + o));
                    __builtin_nontemporal_store((u32x4){cvt_pk_bf16(g0[0], g0[1]), cvt_pk_bf16(g0[2], g0[3]), cvt_pk_bf16(g1[0], g1[1]), cvt_pk_bf16(g1[2], g1[3])}, (u32x4*)(G + o)); }
        }
    }
};

struct EpiResid {
    static constexpr bool PERM = true;
    __device__ __forceinline__ int scale_a() const { return 0; } __device__ __forceinline__ int scale_b() const { return 0; }
    __device__ __forceinline__ void post(const Unit&, int) const {}
    bf16_t* Y1;
    __device__ __forceinline__ void operator()(const f32x4 (&acc)[2][2][4][2], const Unit& u, int wr, int wc, int fr, int fq) const {
        const int row0 = u.pm * BM + wr * 64 + fr, col0 = u.pn * BM + wc * 32 + 8 * fq;
#pragma unroll
        for (int ai = 0; ai < 2; ++ai)
#pragma unroll
            for (int m = 0; m < 4; ++m)
#pragma unroll
                for (int bj = 0; bj < 2; ++bj) { const f32x4 v0 = acc[ai][bj][m][0], v1 = acc[ai][bj][m][1];
                    *(u32x4*)(Y1 + (size_t)(row0 + ai * HALF + m * 16) * DM + col0 + bj * HALF) = (u32x4){cvt_pk_bf16(v0[0], v0[1]), cvt_pk_bf16(v0[2], v0[3]), cvt_pk_bf16(v1[0], v1[1]), cvt_pk_bf16(v1[2], v1[3])}; }
    }
};

struct EpiSwiglu {
    static constexpr bool PERM = true;
    __device__ __forceinline__ int scale_a() const { return 0x7F7F7F7F; } __device__ __forceinline__ int scale_b() const { return 0x79797979; }
    unsigned char* ACT; unsigned* done;
    __device__ __forceinline__ void post(const Unit& u, int lane) const { asm volatile("s_waitcnt vmcnt(0)" ::: "memory"); if (lane == 0) (void)xb_add(done + 4 * u.pm, 1u); }
    __device__ __forceinline__ void operator()(const f32x4 (&acc)[2][2][4][2], const Unit& u, int wr, int wc, int fr, int fq) const {
        const int row0 = u.pm * BM + wr * 64 + fr, col0 = u.pn * HALF + wc * 32 + 8 * fq;
#pragma unroll
        for (int ai = 0; ai < 2; ++ai)
#pragma unroll
            for (int m = 0; m < 4; ++m) { f32x4 a0 = acc[ai][0][m][0], a1 = acc[ai][0][m][1]; const f32x4 u0 = acc[ai][1][m][0], u1 = acc[ai][1][m][1];
#pragma unroll
                for (int j = 0; j < 4; ++j) { a0[j] = 4.f * a0[j] * __builtin_amdgcn_rcpf(1.f + __expf(-a0[j])) * u0[j]; a1[j] = 4.f * a1[j] * __builtin_amdgcn_rcpf(1.f + __expf(-a1[j])) * u1[j]; }
                int w0 = 0, w1 = 0;
                w0 = __builtin_amdgcn_cvt_pk_fp8_f32(a0[0], a0[1], w0, false); w0 = __builtin_amdgcn_cvt_pk_fp8_f32(a0[2], a0[3], w0, true);
                w1 = __builtin_amdgcn_cvt_pk_fp8_f32(a1[0], a1[1], w1, false); w1 = __builtin_amdgcn_cvt_pk_fp8_f32(a1[2], a1[3], w1, true);
                *(u32x2*)(ACT + (size_t)(row0 + ai * HALF + m * 16) * DEXP + col0) = (u32x2){(unsigned)w0, (unsigned)w1}; }
    }
};
struct EpiY {
    static constexpr bool PERM = true;
    __device__ __forceinline__ int scale_a() const { return 0x7D7D7D7D; } __device__ __forceinline__ int scale_b() const { return 0x79797979; }
    unsigned char* Y;
    __device__ __forceinline__ void post(const Unit&, int) const {}
    __device__ __forceinline__ void operator()(const f32x4 (&acc)[2][2][4][2], const Unit& u, int wr, int wc, int fr, int fq) const {
        const int row0 = u.pm * BM + wr * 64 + fr, col0 = u.pn * BM + wc * 32 + 8 * fq;
#pragma unroll
        for (int ai = 0; ai < 2; ++ai)
#pragma unroll
            for (int m = 0; m < 4; ++m)
#pragma unroll
                for (int bj = 0; bj < 2; ++bj) { const f32x4 v0 = acc[ai][bj][m][0] * 16.f, v1 = acc[ai][bj][m][1] * 16.f;
                    int w0 = 0, w1 = 0;
                    w0 = __builtin_amdgcn_cvt_pk_fp8_f32(v0[0], v0[1], w0, false); w0 = __builtin_amdgcn_cvt_pk_fp8_f32(v0[2], v0[3], w0, true);
                    w1 = __builtin_amdgcn_cvt_pk_fp8_f32(v1[0], v1[1], w1, false); w1 = __builtin_amdgcn_cvt_pk_fp8_f32(v1[2], v1[3], w1, true);
                    *(u32x2*)(Y + (size_t)(row0 + ai * HALF + m * 16) * DM + col0 + bj * HALF) = (u32x2){(unsigned)w0, (unsigned)w1}; }
    }
};
struct MoeOrder {
    const LAS int* tab; bool up; const char* HBp; const char* ACTp; const char* W; const int* list; unsigned* done;
    __device__ __forceinline__ bool next(int i, Unit& u) const {
        const int lo = tab[121], hi = tab[122], r6 = tab[123], n7lo = tab[124], NWX = tab[125], w = tab[126], nloc = 4 * (hi - lo);
        int l;
        if (up || r6 == 0 || i < n7lo) l = w + NWX * i;
        else { if (w < r6) return false; l = NWX * n7lo + (NWX - r6) * (i - n7lo) + (w - r6); }
        if (l >= nloc) return false;
        const int g = l >> 5, within = l & 31, fm = lo + 8 * g, gsz = (hi - fm) < 8 ? (hi - fm) : 8;
        const int pn = (within >= gsz ? 1 : 0) + (within >= 2 * gsz ? 1 : 0) + (within >= 3 * gsz ? 1 : 0), mt = fm + within - pn * gsz;
        int e = 0;
#pragma unroll 1
        for (int k = 16; k > 0; k >>= 1) if (tab[e + k] <= mt) e += k;
        const int t = mt - tab[e], so = tab[40 + e], n = tab[80 + e];
        u.pm = (so >> 8) + t; u.pn = pn;
        if (up) { u.A = HBp; u.B = W + (size_t)e * (1024 * 1024) + (size_t)pn * (256 * 1024); u.rows = list + (size_t)e * MTOK + t * 256; u.nrows = n - t * 256; }
        else { u.A = ACTp + (size_t)u.pm * (256 * DEXP); u.B = W + (size_t)e * (1024 * DEXP) + (size_t)pn * (256 * DEXP); u.rows = nullptr; u.nrows = 256;
            unsigned sp = 0u; while (xb_ld(done + 4 * u.pm) < 32u) { __builtin_amdgcn_s_sleep(2); if (++sp > (1u << 16)) break; }
            asm volatile("s_waitcnt vmcnt(0)" ::: "memory"); }
        return true;
    }
};
}

struct Frame { LAS unsigned char* lds; int tid, lane, wave, vcu, G; };
struct Args { Ptrs p; int ph_lo, ph_hi, li, pad; };

__device__ __forceinline__ int srcmap_in(int d) {
    const int pn = d >> 8, bj = (d >> 7) & 1, cc = d & 127, t = pn >> 2, h = pn & 3;
    if (t == 0) return (bj ? 512 : 0) + h * 128 + cc;
    if (t == 1) return (bj ? 1536 : 1024) + h * 128 + cc;
    if (t == 2) return (cc < 64 ? 2048 : 2560 - 64) + h * 128 + bj * 64 + cc;
    return (bj ? 3584 : 3072) + h * 128 + cc;
}
__device__ __forceinline__ void tr_item(const float* W, int ldw, int scol0, int k0, bf16_t* WT, int K, int drow0, LAS float* scr, int lane) {
    float tv[32];
#pragma unroll
    for (int i = 0; i < 32; ++i) { const int kk = 2 * i + (lane >> 5); tv[i] = W[(size_t)(k0 + kk) * ldw + scol0 + (lane & 31)]; }
#pragma unroll
    for (int i = 0; i < 32; ++i) { const int kk = 2 * i + (lane >> 5); scr[kk * 33 + (lane & 31)] = tv[i]; }
    LDS_WAIT(); asm volatile("" ::: "memory");
    const int c = lane & 7;
#pragma unroll
    for (int j = 0; j < 4; ++j) { const int n = (lane >> 3) + 8 * j; const LAS float* s = scr + (8 * c) * 33 + n;
        u32x4 o; o.x = cvt_pk_bf16(s[0 * 33], s[1 * 33]); o.y = cvt_pk_bf16(s[2 * 33], s[3 * 33]); o.z = cvt_pk_bf16(s[4 * 33], s[5 * 33]); o.w = cvt_pk_bf16(s[6 * 33], s[7 * 33]);
        *(u32x4*)(WT + (size_t)(drow0 + n) * K + k0 + 8 * c) = o; }
    LDS_WAIT(); asm volatile("" ::: "memory");
}
__device__ __forceinline__ void tr_item8(const float* W, int ldw, int scol0, int k0, unsigned char* WT, int K, int drow0, LAS float* scr, int lane) {
    float tv[32];
#pragma unroll
    for (int i = 0; i < 32; ++i) { const int kk = 2 * i + (lane >> 5); tv[i] = W[(size_t)(k0 + kk) * ldw + scol0 + (lane & 31)]; }
#pragma unroll
    for (int i = 0; i < 32; ++i) { const int kk = 2 * i + (lane >> 5); scr[kk * 33 + (lane & 31)] = tv[i]; }
    LDS_WAIT(); asm volatile("" ::: "memory");
    const int c = lane & 3;
#pragma unroll
    for (int j = 0; j < 2; ++j) { const int n = (lane >> 2) + 16 * j; const LAS float* s = scr + (16 * c) * 33 + n;
        u32x4 o;
#pragma unroll
        for (int q = 0; q < 4; ++q) { int w = 0; w = __builtin_amdgcn_cvt_pk_fp8_f32(64.f * s[(4 * q + 0) * 33], 64.f * s[(4 * q + 1) * 33], w, false); w = __builtin_amdgcn_cvt_pk_fp8_f32(64.f * s[(4 * q + 2) * 33], 64.f * s[(4 * q + 3) * 33], w, true); o[q] = (unsigned)w; }
        *(u32x4*)(WT + (size_t)(drow0 + n) * K + k0 + 16 * c) = o; }
    LDS_WAIT(); asm volatile("" ::: "memory");
}
template <bool F8>
__device__ __forceinline__ void tr_item64(const float* W, int ldw, int scol0, int k0, void* WTv, int K, int drow0, LAS float* scr, int lane) {
    float tv[64];
#pragma unroll
    for (int i = 0; i < 64; ++i) tv[i] = __builtin_nontemporal_load(W + (size_t)(k0 + i) * ldw + scol0 + lane);
#pragma unroll
    for (int i = 0; i < 64; ++i) scr[i * 65 + lane] = tv[i];
    LDS_WAIT(); asm volatile("" ::: "memory");
    if (F8) {
        unsigned char* WT = (unsigned char*)WTv; const int c = lane & 3;
#pragma unroll
        for (int j = 0; j < 4; ++j) { const int n = (lane >> 2) + 16 * j; const LAS float* s = scr + (16 * c) * 65 + n;
            u32x4 o;
#pragma unroll
            for (int q = 0; q < 4; ++q) { int w = 0; w = __builtin_amdgcn_cvt_pk_fp8_f32(64.f * s[(4 * q + 0) * 65], 64.f * s[(4 * q + 1) * 65], w, false); w = __builtin_amdgcn_cvt_pk_fp8_f32(64.f * s[(4 * q + 2) * 65], 64.f * s[(4 * q + 3) * 65], w, true); o[q] = (unsigned)w; }
            __builtin_nontemporal_store(o, (u32x4*)(WT + (size_t)(drow0 + n) * K + k0 + 16 * c)); }
    } else {
        bf16_t* WT = (bf16_t*)WTv; const int c = lane & 7;
#pragma unroll
        for (int j = 0; j < 8; ++j) { const int n = (lane >> 3) + 8 * j; const LAS float* s = scr + (8 * c) * 65 + n;
            u32x4 o; o.x = cvt_pk_bf16(s[0 * 65], s[1 * 65]); o.y = cvt_pk_bf16(s[2 * 65], s[3 * 65]); o.z = cvt_pk_bf16(s[4 * 65], s[5 * 65]); o.w = cvt_pk_bf16(s[6 * 65], s[7 * 65]);
            *(u32x4*)(WT + (size_t)(drow0 + n) * K + k0 + 8 * c) = o; }
    }
    LDS_WAIT(); asm volatile("" ::: "memory");
}
__device__ __forceinline__ void p0_prologue(const Ptrs& p, const Frame& F) {
    float* mod = (float*)(p.ws + WS_MOD);
    for (int item = F.vcu; item < 96; item += F.G) {
        LAS float* sc = (LAS float*)F.lds; LAS float* part = (LAS float*)(F.lds + 32768);
        for (int i = F.tid; i < 8192; i += 512) sc[i] = siluf_(p.c[i]);
        __syncthreads();
        const int j = 64 * item + F.lane; float acc[8];
#pragma unroll
        for (int b = 0; b < 8; ++b) acc[b] = 0.f;
#pragma unroll 8
        for (int k = F.wave * 128; k < F.wave * 128 + 128; ++k) { const float w = __builtin_nontemporal_load(p.w_ada + (size_t)k * 6144 + j);
#pragma unroll
            for (int b = 0; b < 8; ++b) acc[b] += sc[b * 1024 + k] * w; }
#pragma unroll
        for (int b = 0; b < 8; ++b) part[(F.wave * 8 + b) * 64 + F.lane] = acc[b];
        __syncthreads();
        { const int b = F.wave; float s = p.b_ada[j];
#pragma unroll
            for (int w = 0; w < 8; ++w) s += part[(w * 8 + b) * 64 + F.lane];
            mod[b * 6144 + j] = s; }
        __syncthreads();
    }
    if (F.vcu == F.G - 1) { float* lb = (float*)(p.ws + WS_LB); const int i = F.tid; const float a = p.hgrn_lb[i], b = p.hgrn_lb[512 + i]; const float mx = fmaxf(a, b); const float ea = __expf(a - mx), eb = __expf(b - mx); lb[i] = ea / (ea + eb); }
    { float* dec = (float*)(p.ws + WS_DEC);
      for (int i = F.vcu * 512 + F.tid; i < NCHUNK * 512; i += F.G * 512) dec[(size_t)(i >> 9) * 1024 + 512 + (i & 511)] = exp2f(64.f * log2gamma((i >> 7) & 3)); }
    { float* cs = (float*)(p.ws + WS_COS); float* sn = (float*)(p.ws + WS_SIN);
      for (int i = F.vcu * 512 + F.tid; i < MTOK * 64; i += F.G * 512) { const int m = i >> 6, f = i & 63;
          const float inv = exp2f(-(float)(2 * f) * (13.287712379549449f / 128.0f)); const float ang = (float)p.pos[m] * inv; float s, c; sincosf(ang, &s, &c); cs[i] = c; sn[i] = s; } }
    __syncthreads();
    LAS float* scr = (LAS float*)(F.lds + F.wave * 16640);
    const int gw = F.vcu * NWAVES + F.wave, NGW = F.G * NWAVES;
    constexpr int I_IN = 16 * 64, I_OUT = 16 * 16, I_GU = 32 * 16 * 16, I_DN = 32 * 8 * 16;
    bf16_t* WIN = (bf16_t*)(p.ws + WS_WIN); bf16_t* WOUT = (bf16_t*)(p.ws + WS_WOUT); unsigned char* WGU = (unsigned char*)(p.ws + WS_WGU); unsigned char* WDN = (unsigned char*)(p.ws + WS_WDN);
    for (int it = NGW - 1 - gw; it < I_IN + I_OUT + I_GU + I_DN; it += NGW) {
        int r = it;
        if (r < I_IN) { const int kb = r >> 6, nb = r & 63; tr_item64<false>(p.w_in, DPROJ, srcmap_in(64 * nb), 64 * kb, WIN, DM, 64 * nb, scr, F.lane); continue; } r -= I_IN;
        if (r < I_OUT) { const int kb = r >> 4, nb = r & 15; tr_item64<false>(p.w_out, DM, 64 * nb, 64 * kb, WOUT, DM, 64 * nb, scr, F.lane); continue; } r -= I_OUT;
        if (r < I_GU) { const int e = r >> 8, kb = (r >> 4) & 15, nb = r & 15, d0 = 64 * nb, pn = d0 >> 8, bj = (d0 >> 7) & 1, cc = d0 & 127;
            tr_item64<true>((bj ? p.w_up : p.w_gate) + (size_t)e * DM * DEXP, DEXP, 128 * pn + cc, 64 * kb, WGU + (size_t)e * 1024 * 1024, DM, d0, scr, F.lane); continue; } r -= I_GU;
        { const int e = r >> 7, kb = (r >> 4) & 7, nb = r & 15; tr_item64<true>(p.w_down + (size_t)e * DEXP * DM, DM, 64 * nb, 64 * kb, WDN + (size_t)e * 1024 * DEXP, DEXP, 64 * nb, scr, F.lane); }
    }
}

template <int CTRL, int RM, int BMK, bool BC> __device__ __forceinline__ float dppf(float v) { return __builtin_bit_cast(float, __builtin_amdgcn_update_dpp(0, __builtin_bit_cast(int, v), CTRL, RM, BMK, BC)); }
__device__ __forceinline__ float lane63_sum(float v) {
    v += dppf<0x111, 0xf, 0xf, true>(v); v += dppf<0x112, 0xf, 0xf, true>(v); v += dppf<0x114, 0xf, 0xf, true>(v); v += dppf<0x118, 0xf, 0xf, true>(v);
    v += dppf<0x142, 0xa, 0xf, false>(v); v += dppf<0x143, 0xc, 0xf, false>(v); return v;
}
__device__ __forceinline__ float rdlane(float v, int l) { return __builtin_bit_cast(float, __builtin_amdgcn_readlane(__builtin_bit_cast(int, v), l)); }
__device__ __forceinline__ float wsum(float v) { return rdlane(lane63_sum(v), 63); }
__device__ __forceinline__ float hsum4(f32x4 v) { return (v.x + v.y) + (v.z + v.w); }
__device__ __forceinline__ void p1_h1(const Ptrs& p, const Frame& F, const bool xl) {
    const float* mod = (const float*)(p.ws + WS_MOD); bf16_t* hb = (bf16_t*)(p.ws + WS_HB);
    const int gw = xl ? (F.vcu >> 5) * NS + (F.vcu & 31) * NWAVES + F.wave : F.vcu * NWAVES + F.wave, NGW = xl ? 32 * NWAVES : F.G * NWAVES, mlim = xl ? ((F.vcu >> 5) + 1) * NS : MTOK;
    const int m0 = xl ? gw + 14 * NGW : gw, ms = xl ? -2 * NGW : 2 * NGW;
    f32x4 vn[2][4], shr[4], sclr[4]; int curb = -1;
#pragma unroll
    for (int r = 0; r < 2; ++r) { const int mm = m0 + r * NGW; if (mm < mlim) {
#pragma unroll
        for (int j = 0; j < 4; ++j) vn[r][j] = __builtin_nontemporal_load((const f32x4*)(p.x + (size_t)mm * DM) + F.lane + 64 * j); } }
    for (int m = m0; m >= gw && m < mlim; m += ms) {
        f32x4 v[2][4];
#pragma unroll
        for (int r = 0; r < 2; ++r)
#pragma unroll
            for (int j = 0; j < 4; ++j) v[r][j] = vn[r][j];
#pragma unroll
        for (int r = 0; r < 2; ++r) { const int mm = m + ms + r * NGW; if (mm >= gw && mm < mlim) {
#pragma unroll
            for (int j = 0; j < 4; ++j) vn[r][j] = __builtin_nontemporal_load((const f32x4*)(p.x + (size_t)mm * DM) + F.lane + 64 * j); } }
#pragma unroll
        for (int r = 0; r < 2; ++r) { const int mm = m + r * NGW; if (mm < mlim) {
            const int b = mm / NS; float s = 0.f;
#pragma unroll
            for (int j = 0; j < 4; ++j) s += (v[r][j].x + v[r][j].y) + (v[r][j].z + v[r][j].w);
            const float mean = wsum(s) * (1.f / DM); float q = 0.f;
#pragma unroll
            for (int j = 0; j < 4; ++j) { v[r][j] = v[r][j] - mean; q += (v[r][j].x * v[r][j].x + v[r][j].y * v[r][j].y) + (v[r][j].z * v[r][j].z + v[r][j].w * v[r][j].w); }
            const float rstd = 1.f / sqrtf(wsum(q) * (1.f / DM) + LN_EPS);
            if (b != curb) { curb = b;
#pragma unroll
                for (int j = 0; j < 4; ++j) { shr[j] = ((const f32x4*)(mod + b * 6144))[F.lane + 64 * j]; sclr[j] = ((const f32x4*)(mod + b * 6144 + 1024))[F.lane + 64 * j] + 1.f; } }
            u32x2* o8 = (u32x2*)(hb + (size_t)mm * DM) + F.lane;
#pragma unroll
            for (int j = 0; j < 4; ++j) { const f32x4 t = v[r][j] * rstd * sclr[j] + shr[j]; o8[64 * j] = (u32x2){cvt_pk_bf16(t.x, t.y), cvt_pk_bf16(t.z, t.w)}; } } }
    }
}

__device__ __forceinline__ void p3_mixer_naive(const Ptrs& p, const Frame& F) {
    if (F.vcu >= 64) return;
    LAS float* qs = (LAS float*)F.lds; LAS float* ks = qs + 128; LAS float* part = ks + 128; LAS float* red = part + 512;
    const int b = F.vcu >> 3, mh = F.vcu & 7, tid = F.tid, j = tid & 127, g = tid >> 7;
    const bf16_t* QI = (const bf16_t*)(p.ws + WS_QI); const bf16_t* KI = (const bf16_t*)(p.ws + WS_KI); const bf16_t* V = (const bf16_t*)(p.ws + WS_V); const bf16_t* G = (const bf16_t*)(p.ws + WS_G);
    const float* DEC = (const float*)(p.ws + WS_DEC); bf16_t* O = (bf16_t*)(p.ws + WS_HB);
    float st[32];
#pragma unroll
    for (int i = 0; i < 32; ++i) st[i] = 0.f;
    const float nw = mh < 4 ? p.hgrn_nw[mh * 128 + j] : p.ret_nw[(mh - 4) * 128 + j];
    for (int s = 0; s < NS; ++s) {
        const size_t m = (size_t)b * NS + s;
        __syncthreads();
        if (tid < 128) qs[tid] = bf2f(QI[m * DM + mh * 128 + tid]); else if (tid < 256) ks[tid - 128] = bf2f(KI[m * DM + mh * 128 + tid - 128]);
        const float v = bf2f(V[m * DM + mh * 128 + j]);
        __syncthreads();
        float acc = 0.f;
#pragma unroll
        for (int i = 0; i < 32; ++i) { st[i] += ks[g * 32 + i] * v; acc += st[i] * qs[g * 32 + i]; }
        part[g * 128 + j] = acc;
        if ((s & 63) == 63) { const int ch = (int)(m >> 6);
#pragma unroll
            for (int i = 0; i < 32; ++i) { const float d = DEC[(size_t)ch * 1024 + mh * 128 + g * 32 + i]; st[i] *= d; } }
        __syncthreads();
        float o = 0.f, s1 = 0.f, s2 = 0.f;
        if (tid < 128) { o = part[j] + part[128 + j] + part[256 + j] + part[384 + j]; s1 = wave_sum(o); s2 = wave_sum(o * o); if ((tid & 63) == 0) { red[(tid >> 6) * 2] = s1; red[(tid >> 6) * 2 + 1] = s2; } }
        __syncthreads();
        if (tid < 128) { const float t1 = red[0] + red[2], t2 = red[1] + red[3]; float r;
            if (mh < 4) r = o * (1.f / sqrtf(t2 * (1.f / 128.f) + LN_EPS));
            else { const float mu = t1 * (1.f / 128.f); const float var = fmaxf(t2 * (1.f / 128.f) - mu * mu, 0.f); r = (o - mu) * (1.f / sqrtf(var + LN_EPS)); }
            O[m * DM + mh * 128 + j] = f2bf(r * nw * bf2f(G[m * DM + mh * 128 + j])); }
    }
    __syncthreads();
}


namespace mix {
typedef short s16x4 __attribute__((ext_vector_type(4)));
typedef short s16x8 __attribute__((ext_vector_type(8)));
typedef float f32x16 __attribute__((ext_vector_type(16)));
typedef float f32x8 __attribute__((ext_vector_type(8)));
typedef __bf16 bf16v8 __attribute__((ext_vector_type(8)));
typedef __bf16 bf16v4 __attribute__((ext_vector_type(4)));
constexpr int NSEG = 4, SEGC = 16;
constexpr int PART_OFF = 131072, DECB_OFF = 135168, DECA_OFF = 131072, NW_OFF = 151552;
constexpr size_t WS_LST = 8 * MiB, WS_DPR = 452 * MiB;
#define MFMA32(a, b, c) __builtin_amdgcn_mfma_f32_32x32x16_bf16((a), (b), (c), 0, 0, 0)
__device__ __forceinline__ unsigned img_off(unsigned row, unsigned ch) { return 256u * row + 16u * (ch ^ (((row & 3u) << 2) | ((row >> 2) & 3u))); }
__device__ __forceinline__ s16x4 trd(LAS unsigned char* base, unsigned R0, unsigned c32, unsigned lane) {
    const unsigned blk = (lane >> 4) & 1u, q = (lane & 15u) >> 2, p = lane & 3u;
    typedef short v4i16 __attribute__((ext_vector_type(4)));
    return __builtin_bit_cast(s16x4, __builtin_amdgcn_ds_read_tr16_b64_v4i16((LAS v4i16*)(base + img_off(R0 + q, 4u * c32 + 2u * blk + (p >> 1)) + 8u * (p & 1u))));
}
__device__ __forceinline__ s16x8 cat8(s16x4 a, s16x4 b) { return __builtin_shufflevector(a, b, 0, 1, 2, 3, 4, 5, 6, 7); }
__device__ __forceinline__ unsigned tra(LAS unsigned char* base, unsigned R0, unsigned c32, unsigned lane) {
    const unsigned blk = (lane >> 4) & 1u, q = (lane & 15u) >> 2, p = lane & 3u;
    return (unsigned)(size_t)base + img_off(R0 + q, 4u * c32 + 2u * blk + (p >> 1)) + 8u * (p & 1u);
}
__device__ __forceinline__ void tr_read4(const unsigned (&a)[4], s16x4 (&r)[4]) {
    asm volatile("ds_read_b64_tr_b16 %0, %4\n\tds_read_b64_tr_b16 %1, %5\n\tds_read_b64_tr_b16 %2, %6\n\tds_read_b64_tr_b16 %3, %7\n\ts_waitcnt lgkmcnt(0)"
                 : "=&v"(r[0]), "=&v"(r[1]), "=&v"(r[2]), "=&v"(r[3]) : "v"(a[0]), "v"(a[1]), "v"(a[2]), "v"(a[3]) : "memory");
}
__device__ __forceinline__ void tr_read10(const unsigned (&a)[10], s16x4 (&r)[10]) {
    asm volatile("ds_read_b64_tr_b16 %0, %10\n\tds_read_b64_tr_b16 %1, %11\n\tds_read_b64_tr_b16 %2, %12\n\tds_read_b64_tr_b16 %3, %13\n\tds_read_b64_tr_b16 %4, %14\n\t"
                 "ds_read_b64_tr_b16 %5, %15\n\tds_read_b64_tr_b16 %6, %16\n\tds_read_b64_tr_b16 %7, %17\n\tds_read_b64_tr_b16 %8, %18\n\tds_read_b64_tr_b16 %9, %19\n\ts_waitcnt lgkmcnt(0)"
                 : "=&v"(r[0]), "=&v"(r[1]), "=&v"(r[2]), "=&v"(r[3]), "=&v"(r[4]), "=&v"(r[5]), "=&v"(r[6]), "=&v"(r[7]), "=&v"(r[8]), "=&v"(r[9])
                 : "v"(a[0]), "v"(a[1]), "v"(a[2]), "v"(a[3]), "v"(a[4]), "v"(a[5]), "v"(a[6]), "v"(a[7]), "v"(a[8]), "v"(a[9]) : "memory");
}
__device__ __forceinline__ int crow(int reg, int h) { return (reg & 3) + 8 * (reg >> 2) + 4 * h; }
__device__ __forceinline__ s16x8 permrd(LAS unsigned char* base, unsigned row, int i, int s2, int h) {
    const s16x4 a = *(const LAS s16x4*)(base + img_off(row, 4 * i + 2 * s2) + 8 * h), b = *(const LAS s16x4*)(base + img_off(row, 4 * i + 2 * s2 + 1) + 8 * h);
    return cat8(a, b);
}
__device__ __forceinline__ s16x8 packacc(const f32x16& x, int s2) {
    f32x8 e;
#pragma unroll
    for (int i = 0; i < 8; ++i) e[i] = x[8 * s2 + i];
    return __builtin_bit_cast(s16x8, __builtin_convertvector(e, bf16v8));
}
#define GLDS16(src, dst) __builtin_amdgcn_global_load_lds((const unsigned*)(src), (LAS unsigned*)(dst), 16, 0, 0)
#define GLDS16NT(src, dst) __builtin_amdgcn_global_load_lds((const unsigned*)(src), (LAS unsigned*)(dst), 16, 0, 2)
template <bool NT = false>
__device__ __forceinline__ void stage_tile(const bf16_t* X, size_t m0, int mh, LAS unsigned char* dst, int tid, int wave) {
#pragma unroll
    for (int i = 0; i < 2; ++i) { const unsigned pc = tid + 512 * i, row = pc >> 4, chp = pc & 15u, ch = chp ^ (((row & 3u) << 2) | ((row >> 2) & 3u));
        if (NT) GLDS16NT(X + (m0 + row) * DM + mh * 128 + ch * 8, dst + wave * 1024 + i * 8192); else GLDS16(X + (m0 + row) * DM + mh * 128 + ch * 8, dst + wave * 1024 + i * 8192); }
}
__device__ __forceinline__ void state_update(f32x16 (&S)[4], LAS unsigned char* Kb, LAS unsigned char* Vb, const LAS float* dec, int cb, int h, int lane) {
#pragma unroll
    for (int kk = 0; kk < 4; ++kk) {
        unsigned ad[10]; s16x4 rr[10];
        ad[0] = tra(Vb, 16 * kk + 8 * h, cb, lane); ad[1] = tra(Vb, 16 * kk + 8 * h + 4, cb, lane);
#pragma unroll
        for (int i = 0; i < 4; ++i) { ad[2 + 2 * i] = tra(Kb, 16 * kk + 8 * h, i, lane); ad[3 + 2 * i] = tra(Kb, 16 * kk + 8 * h + 4, i, lane); }
        tr_read10(ad, rr);
        const s16x8 vb = cat8(rr[0], rr[1]);
#pragma unroll
        for (int i = 0; i < 4; ++i) S[i] = MFMA32(cat8(rr[2 + 2 * i], rr[3 + 2 * i]), vb, S[i]);
    }
#pragma unroll
    for (int i = 0; i < 4; ++i)
#pragma unroll
        for (int g = 0; g < 4; ++g) { const f32x4 d = *(const LAS f32x4*)(dec + 32 * i + 8 * g + 4 * h);
#pragma unroll
            for (int j = 0; j < 4; ++j) S[i][4 * g + j] *= d[j]; }
}

__device__ __forceinline__ void pass_a(const Ptrs& p, const Frame& F, int item, int b, int mh, int seg) {
    LAS unsigned char* lds = F.lds;
    const int tid = F.tid, lane = F.lane, wave = F.wave, h = lane >> 5, rb = wave >> 2, cb = wave & 3;
    const bf16_t* KI = (const bf16_t*)(p.ws + WS_KI); const bf16_t* V = (const bf16_t*)(p.ws + WS_V); const float* DEC = (const float*)(p.ws + WS_DEC);
    const int dcol = mh * 128;
    const int c0 = seg * SEGC;
    f32x16 S[4];
#pragma unroll
    for (int i = 0; i < 4; ++i)
#pragma unroll
        for (int k = 0; k < 16; ++k) S[i][k] = 0.f;
#define STAGE_A(n, slot) do { const size_t m0_ = (size_t)b * NS + (size_t)(n) * 64; stage_tile<true>(KI, m0_, mh, lds + (slot) * 32768, tid, wave); stage_tile<true>(V, m0_, mh, lds + (slot) * 32768 + 16384, tid, wave); \
        if (lane < 32) GLDS16(DEC + ((size_t)b * 64 + (n)) * 1024 + dcol + lane * 4, lds + DECA_OFF + ((slot) * 8 + wave) * 512); } while (0)
    STAGE_A(c0, 0); STAGE_A(c0 + 1, 1); STAGE_A(c0 + 2, 2);
    float dprod = 1.f;
    for (int it = 0; it < SEGC; ++it) {
        const int slot = it & 3;
        asm volatile("s_waitcnt vmcnt(10)" ::: "memory");
        __builtin_amdgcn_s_barrier(); asm volatile("" ::: "memory");
        { const int n2 = it + 3 < SEGC ? it + 3 : SEGC - 1; STAGE_A(c0 + n2, (it + 3) & 3); }
        state_update(S, lds + slot * 32768, lds + slot * 32768 + 16384, (const LAS float*)(lds + DECA_OFF + (slot * 8 + wave) * 512), cb, h, lane);
        if (tid < 128) dprod *= ((const LAS float*)(lds + DECA_OFF + (slot * 8 + wave) * 512))[tid];
        asm volatile("s_waitcnt lgkmcnt(0)" ::: "memory");
    }
#undef STAGE_A
    asm volatile("s_waitcnt vmcnt(0)" ::: "memory");
    __syncthreads();
    if (tid < 128) ((float*)(p.ws + WS_DPR))[(size_t)item * 128 + tid] = dprod;
    if (rb == 0) { float* dst = (float*)(p.ws + WS_LST) + ((size_t)item * 4 + cb) * 4096 + lane;
#pragma unroll
        for (int i = 0; i < 4; ++i)
#pragma unroll
            for (int k = 0; k < 16; ++k) dst[(i * 16 + k) * 64] = S[i][k]; }
}

__device__ __forceinline__ void pass_b(const Ptrs& p, const Frame& F, int item, int b, int mh, int seg) {
    LAS unsigned char* lds = F.lds;
    const int tid = F.tid, lane = F.lane, wave = F.wave, r = lane & 31, h = lane >> 5, rb = wave >> 2, cb = wave & 3;
    const bf16_t* QI = (const bf16_t*)(p.ws + WS_QI); const bf16_t* KI = (const bf16_t*)(p.ws + WS_KI); const bf16_t* V = (const bf16_t*)(p.ws + WS_V); const bf16_t* Gp = (const bf16_t*)(p.ws + WS_G);
    bf16_t* Op = (bf16_t*)(p.ws + WS_HB); const float* DEC = (const float*)(p.ws + WS_DEC);
    const bool hg = mh < 4; const int dcol = mh * 128;
    const float* nwp = hg ? p.hgrn_nw + mh * 128 : p.ret_nw + (mh - 4) * 128;
    const int c0 = seg * SEGC;
#define STAGE_B(n, buf) do { const size_t m0_ = (size_t)b * NS + (size_t)(n) * 64; LAS unsigned char* d_ = lds + (buf) * 65536; \
        stage_tile<true>(QI, m0_, mh, d_, tid, wave); stage_tile<true>(KI, m0_, mh, d_ + 16384, tid, wave); stage_tile<true>(V, m0_, mh, d_ + 32768, tid, wave); stage_tile<true>(Gp, m0_, mh, d_ + 49152, tid, wave); \
        GLDS16(DEC + ((size_t)b * 64 + (n)) * 1024 + dcol + (lane & 31) * 4, lds + DECB_OFF + ((buf) * 8 + wave) * 1024); } while (0)
    STAGE_B(c0, 0);
    f32x16 S[4];
#pragma unroll
    for (int i = 0; i < 4; ++i)
#pragma unroll
        for (int k = 0; k < 16; ++k) S[i][k] = 0.f;
    for (int j = 0; j < seg; ++j) {
        const int itj = item - seg + j; const float* L = (const float*)(p.ws + WS_LST) + ((size_t)itj * 4 + cb) * 4096 + lane; const float* dp = (const float*)(p.ws + WS_DPR) + (size_t)itj * 128;
#pragma unroll
        for (int i = 0; i < 4; ++i)
#pragma unroll
            for (int g = 0; g < 4; ++g) { const f32x4 d = *(const f32x4*)(dp + 32 * i + 8 * g + 4 * h);
#pragma unroll
                for (int k = 0; k < 4; ++k) S[i][4 * g + k] = d[k] * S[i][4 * g + k] + L[(i * 16 + 4 * g + k) * 64]; }
    }
    LAS float* NW = (LAS float*)(lds + NW_OFF);
    if (tid < 128) NW[tid] = nwp[tid];
    __syncthreads();
    for (int it = 0; it < SEGC; ++it) {
        const int n = c0 + it, cur = it & 1;
        const size_t m0 = (size_t)b * NS + (size_t)n * 64;
        { const int nn = it + 1 < SEGC ? n + 1 : n; STAGE_B(nn, cur ^ 1); }
        LAS unsigned char* Qb = lds + cur * 65536; LAS unsigned char* Kb = Qb + 16384; LAS unsigned char* Vb = Qb + 32768; LAS unsigned char* Gb = Qb + 49152;
        f32x16 o;
#pragma unroll
        for (int k = 0; k < 16; ++k) o[k] = 0.f;
#pragma unroll
        for (int i = 0; i < 4; ++i)
#pragma unroll
            for (int s2 = 0; s2 < 2; ++s2) o = MFMA32(packacc(S[i], s2), permrd(Qb, 32 * rb + r, i, s2, h), o);
#pragma unroll
        for (int sb = 0; sb < 2; ++sb) {
            if (sb <= rb) {
                asm volatile("" ::: "memory");
                f32x16 x;
#pragma unroll
                for (int k = 0; k < 16; ++k) x[k] = 0.f;
#pragma unroll
                for (int i = 0; i < 4; ++i)
#pragma unroll
                    for (int s2 = 0; s2 < 2; ++s2) x = MFMA32(permrd(Kb, 32 * sb + r, i, s2, h), permrd(Qb, 32 * rb + r, i, s2, h), x);
                if (sb == rb) {
#pragma unroll
                    for (int k = 0; k < 16; ++k) x[k] = (r >= crow(k, h)) ? x[k] : 0.f;
                }
                { unsigned ad[4]; s16x4 rr[4];
#pragma unroll
                  for (int s2 = 0; s2 < 2; ++s2) { ad[2 * s2] = tra(Vb, 32 * sb + 16 * s2 + 4 * h, cb, lane); ad[2 * s2 + 1] = tra(Vb, 32 * sb + 16 * s2 + 8 + 4 * h, cb, lane); }
                  tr_read4(ad, rr);
#pragma unroll
                  for (int s2 = 0; s2 < 2; ++s2) o = MFMA32(cat8(rr[2 * s2], rr[2 * s2 + 1]), packacc(x, s2), o); }
            }
        }
        u32x2 gv[4];
#pragma unroll
        for (int g = 0; g < 4; ++g) gv[g] = *(const LAS u32x2*)(Gb + img_off(32 * rb + r, 4 * cb + g) + 8 * h);
        state_update(S, Kb, Vb, (const LAS float*)(lds + DECB_OFF + (cur * 8 + wave) * 1024), cb, h, lane);
        float s1 = 0.f, s2v = 0.f;
#pragma unroll
        for (int k = 0; k < 16; ++k) { s1 += o[k]; s2v += o[k] * o[k]; }
        s1 += __shfl_xor(s1, 32); s2v += __shfl_xor(s2v, 32);
        LAS f32x2* PART = (LAS f32x2*)(lds + PART_OFF + cur * 2048);
        if (h == 0) PART[(32 * rb + r) * 4 + cb] = (f32x2){s1, s2v};
        __syncthreads();
        { const f32x2 p0 = PART[(32 * rb + r) * 4 + 0], p1 = PART[(32 * rb + r) * 4 + 1], p2 = PART[(32 * rb + r) * 4 + 2], p3 = PART[(32 * rb + r) * 4 + 3];
          const float t1 = (p0.x + p1.x) + (p2.x + p3.x), t2 = (p0.y + p1.y) + (p2.y + p3.y);
          float mu = 0.f, rstd;
          if (hg) rstd = 1.f / sqrtf(t2 * (1.f / 128.f) + LN_EPS);
          else { mu = t1 * (1.f / 128.f); rstd = 1.f / sqrtf(fmaxf(t2 * (1.f / 128.f) - mu * mu, 0.f) + LN_EPS); }
          const size_t tok = m0 + 32 * rb + r;
#pragma unroll
          for (int g = 0; g < 4; ++g) { f32x4 ov; const f32x4 nwv = *(const LAS f32x4*)(NW + 32 * cb + 8 * g + 4 * h);
              const float g0 = __builtin_bit_cast(float, gv[g].x << 16), g1 = __builtin_bit_cast(float, gv[g].x & 0xffff0000u), g2 = __builtin_bit_cast(float, gv[g].y << 16), g3 = __builtin_bit_cast(float, gv[g].y & 0xffff0000u);
              ov[0] = (o[4 * g + 0] - mu) * rstd * nwv[0] * g0; ov[1] = (o[4 * g + 1] - mu) * rstd * nwv[1] * g1;
              ov[2] = (o[4 * g + 2] - mu) * rstd * nwv[2] * g2; ov[3] = (o[4 * g + 3] - mu) * rstd * nwv[3] * g3;
              *(u32x2*)(Op + tok * DM + mh * 128 + 32 * cb + 8 * g + 4 * h) = __builtin_bit_cast(u32x2, __builtin_convertvector(ov, bf16v4)); } }
    }
#undef STAGE_B
    __syncthreads();
}
#undef MFMA32
#undef GLDS16
#undef GLDS16NT
}

struct RowRaw { f32x4 x[4]; u32x2 y[4]; };
template <bool LASTUSE = false>
__device__ __forceinline__ void row_load(const Ptrs& p, int m, int lane, RowRaw& r) {
    const f32x4* xr = (const f32x4*)(p.x + (size_t)m * DM) + lane; const u32x2* yr = (const u32x2*)((const bf16_t*)(p.ws + WS_Y1) + (size_t)m * DM) + lane;
#pragma unroll
    for (int j = 0; j < 4; ++j) { r.x[j] = __builtin_nontemporal_load(xr + 64 * j); r.y[j] = LASTUSE ? __builtin_nontemporal_load(yr + 64 * j) : yr[64 * j]; }
}
__device__ __forceinline__ void row_u(const RowRaw& r, const float* mod, int b, int lane, f32x4 (&v)[4]) {
    const f32x4* g1 = (const f32x4*)(mod + b * 6144 + 2048) + lane;
#pragma unroll
    for (int j = 0; j < 4; ++j) { const f32x4 y = (f32x4){__builtin_bit_cast(float, r.y[j].x << 16), __builtin_bit_cast(float, r.y[j].x & 0xffff0000u), __builtin_bit_cast(float, r.y[j].y << 16), __builtin_bit_cast(float, r.y[j].y & 0xffff0000u)};
        v[j] = r.x[j] * DN_ALPHA + g1[64 * j] * y; }
}
template <class SEAM_T>
__device__ __forceinline__ void p5_route(const Ptrs& p, const Frame& F, const bool xl, SEAM_T&& seam) {
    LAS float* WL = (LAS float*)F.lds;
    const int lane = F.lane, gw = xl ? (F.vcu >> 5) * NS + (F.vcu & 31) * NWAVES + F.wave : F.vcu * NWAVES + F.wave, NGW = xl ? 32 * NWAVES : F.G * NWAVES, mlim = xl ? ((F.vcu >> 5) + 1) * NS : MTOK;
    LAS f32x4* PL = (LAS f32x4*)(F.lds + 147456);
    f32x4 t[18], plv; float brev = 0.f; RowRaw rn[2]; int t_ = F.tid; asm volatile("" : "+v"(t_));
    seam([&]() {
        plv = t_ < 256 ? ((const f32x4*)p.ln1w)[t_] : ((const f32x4*)p.ln1b)[t_ - 256];
        if (t_ < NEXP) brev = p.b_re[t_];
#pragma unroll
        for (int r = 0; r < 2; ++r) { const int mm = gw + ((xl ? 14 : 0) + r) * NGW; if (mm < mlim) {
#pragma unroll
            for (int j = 0; j < 4; ++j) rn[r].x[j] = __builtin_nontemporal_load((const f32x4*)(p.x + (size_t)mm * DM) + lane + 64 * j); } }
    });
#pragma unroll
    for (int k = 0; k < 18; ++k) { const int i = t_ + 512 * k, col = i / 9, q = i - col * 9; t[k] = q == 0 ? *(const f32x4*)(p.w_rg + col * 4) : *(const f32x4*)(p.w_re + col * 32 + 4 * (q - 1)); }
#pragma unroll
    for (int k = 0; k < 18; ++k) { const int i = t_ + 512 * k, col = i / 9, q = i - col * 9; const int pos = ((col >> 2) & 63) + 64 * (4 * (col >> 8) + (col & 3)); *(LAS f32x4*)(WL + pos * 36 + 4 * q) = t[k]; }
    PL[t_] = plv;
    const float* mod = (const float*)(p.ws + WS_MOD); bf16_t* hb = (bf16_t*)(p.ws + WS_HB);
    f32x4 g1r[4], sclr[4]; int curb = -1;
    int* cnt = (int*)(p.ws + WS_CTL) + CW_CNT; int* list = (int*)(p.ws + WS_LIST);
    int* re = (int*)(p.ws + WS_ROUTE); int* rp = re + 2 * MTOK; float* rg = (float*)(rp + 2 * MTOK);
    const float brg[4] = {p.b_rg[0], p.b_rg[1], p.b_rg[2], p.b_rg[3]};
    LAS int* lcnt = (LAS int*)(F.lds + TAB_OFF + 512); LAS int* lbase = lcnt + 32; LAS int* recm = lbase + 32;
    LAS float* lbre = (LAS float*)(recm + 512);
    if (t_ < NEXP) lbre[t_] = brev;
#define RED_ALL2(arr, N) do { \
        _Pragma("unroll") for (int r_ = 0; r_ < 2; ++r_) _Pragma("unroll") for (int i_ = 0; i_ < N; ++i_) arr[r_][i_] += dppf<0x111, 0xf, 0xf, true>(arr[r_][i_]); \
        _Pragma("unroll") for (int r_ = 0; r_ < 2; ++r_) _Pragma("unroll") for (int i_ = 0; i_ < N; ++i_) arr[r_][i_] += dppf<0x112, 0xf, 0xf, true>(arr[r_][i_]); \
        _Pragma("unroll") for (int r_ = 0; r_ < 2; ++r_) _Pragma("unroll") for (int i_ = 0; i_ < N; ++i_) arr[r_][i_] += dppf<0x114, 0xf, 0xf, true>(arr[r_][i_]); \
        _Pragma("unroll") for (int r_ = 0; r_ < 2; ++r_) _Pragma("unroll") for (int i_ = 0; i_ < N; ++i_) arr[r_][i_] += dppf<0x118, 0xf, 0xf, true>(arr[r_][i_]); \
        _Pragma("unroll") for (int r_ = 0; r_ < 2; ++r_) _Pragma("unroll") for (int i_ = 0; i_ < N; ++i_) arr[r_][i_] += dppf<0x142, 0xa, 0xf, false>(arr[r_][i_]); \
        _Pragma("unroll") for (int r_ = 0; r_ < 2; ++r_) _Pragma("unroll") for (int i_ = 0; i_ < N; ++i_) arr[r_][i_] += dppf<0x143, 0xc, 0xf, false>(arr[r_][i_]); } while (0)
    for (int mb = 0; mb < (xl ? NS : MTOK); mb += NGW * 16) {
    for (int i = F.tid; i < 64 + 128 * 4; i += 512) lcnt[i] = i < 64 ? 0 : -1;
    __syncthreads();
#pragma unroll
    for (int r = 0; r < 2; ++r) { const int mm = mb + gw + ((xl ? 14 : 0) + r) * NGW; if (mm < mlim) { if (mb == 0) { const u32x2* yr = (const u32x2*)((const bf16_t*)(p.ws + WS_Y1) + (size_t)mm * DM) + lane;
#pragma unroll
            for (int j = 0; j < 4; ++j) rn[r].y[j] = __builtin_nontemporal_load(yr + 64 * j); } else row_load<true>(p, mm, lane, rn[r]); } }
    for (int it = 0; it < 8; ++it) {
        const int m = mb + gw + 2 * (xl ? 7 - it : it) * NGW;
        if (m >= mlim) break;
        int mmr[2]; bool ok[2];
#pragma unroll
        for (int r = 0; r < 2; ++r) { mmr[r] = m + r * NGW; ok[r] = mmr[r] < mlim; if (!ok[r]) mmr[r] = m; }
        f32x4 v[2][4];
        { const int b = mmr[0] / NS;
          if (b != curb) { curb = b;
#pragma unroll
              for (int j = 0; j < 4; ++j) { g1r[j] = ((const f32x4*)(mod + b * 6144 + 2048))[lane + 64 * j]; sclr[j] = ((const f32x4*)(mod + b * 6144 + 4096))[lane + 64 * j] + 1.f; } } }
#pragma unroll
        for (int r = 0; r < 2; ++r)
#pragma unroll
            for (int j = 0; j < 4; ++j) { const u32x2 yy = rn[r].y[j]; const f32x4 y = (f32x4){__builtin_bit_cast(float, yy.x << 16), __builtin_bit_cast(float, yy.x & 0xffff0000u), __builtin_bit_cast(float, yy.y << 16), __builtin_bit_cast(float, yy.y & 0xffff0000u)};
                v[r][j] = rn[r].x[j] * DN_ALPHA + g1r[j] * y; }
        if (it < 7) {
#pragma unroll
            for (int r = 0; r < 2; ++r) { const int mn = xl ? m + (r - 2) * NGW : m + (2 + r) * NGW; if (mn < mlim) row_load<true>(p, mn, lane, rn[r]); } }
        float mean[2], rstd[2], sq[2];
#pragma unroll
        for (int r = 0; r < 2; ++r) sq[r] = (hsum4(v[r][0]) + hsum4(v[r][1])) + (hsum4(v[r][2]) + hsum4(v[r][3]));
#pragma unroll
        for (int r = 0; r < 2; ++r) mean[r] = wsum(sq[r]) * (1.f / DM);
#pragma unroll
        for (int r = 0; r < 2; ++r) { sq[r] = 0.f;
#pragma unroll
            for (int j = 0; j < 4; ++j) { v[r][j] = v[r][j] - mean[r]; sq[r] += hsum4(v[r][j] * v[r][j]); } }
#pragma unroll
        for (int r = 0; r < 2; ++r) rstd[r] = 1.f / sqrtf(wsum(sq[r]) * (1.f / DM) + LN_EPS);
#pragma unroll
        for (int r = 0; r < 2; ++r) { sq[r] = 0.f;
#pragma unroll
            for (int j = 0; j < 4; ++j) { v[r][j] = v[r][j] * rstd[r] * PL[lane + 64 * j] + PL[256 + lane + 64 * j]; sq[r] += hsum4(v[r][j]);
#ifdef X1BF16
                if (ok[r]) __builtin_nontemporal_store((u32x2){cvt_pk_bf16(v[r][j].x, v[r][j].y), cvt_pk_bf16(v[r][j].z, v[r][j].w)}, (u32x2*)((bf16_t*)(p.ws + WS_U) + (size_t)mmr[r] * DM) + lane + 64 * j);
#endif
            } }
#pragma unroll
        for (int r = 0; r < 2; ++r) mean[r] = wsum(sq[r]) * (1.f / DM);
#pragma unroll
        for (int r = 0; r < 2; ++r) { sq[r] = 0.f;
#pragma unroll
            for (int j = 0; j < 4; ++j) { v[r][j] = v[r][j] - mean[r]; sq[r] += hsum4(v[r][j] * v[r][j]); } }
#pragma unroll
        for (int r = 0; r < 2; ++r) rstd[r] = 1.f / sqrtf(wsum(sq[r]) * (1.f / DM) + LN_EPS);
#pragma unroll
        for (int r = 0; r < 2; ++r) { const int b = mmr[r] / NS;
            const f32x4* sh = (const f32x4*)(mod + b * 6144 + 3072) + lane;
            unsigned* o8 = (unsigned*)((unsigned char*)hb + (size_t)mmr[r] * DM) + lane;
#pragma unroll
            for (int j = 0; j < 4; ++j) { const f32x4 hv = v[r][j] * rstd[r] * sclr[j] + sh[64 * j]; v[r][j] = hv;
                int w = 0; w = __builtin_amdgcn_cvt_pk_fp8_f32(hv.x, hv.y, w, false); w = __builtin_amdgcn_cvt_pk_fp8_f32(hv.z, hv.w, w, true); if (ok[r]) o8[64 * j] = (unsigned)w; } }
        f32x4 gacc[2] = {(f32x4){0.f, 0.f, 0.f, 0.f}, (f32x4){0.f, 0.f, 0.f, 0.f}};
#pragma unroll
        for (int j = 0; j < 4; ++j)
#pragma unroll
            for (int c = 0; c < 4; ++c) { const f32x4 w = *(const LAS f32x4*)(WL + (lane + 64 * (4 * j + c)) * 36); gacc[0] += w * v[0][j][c]; gacc[1] += w * v[1][j][c]; }
        float gp[2][4];
#pragma unroll
        for (int r = 0; r < 2; ++r)
#pragma unroll
            for (int c = 0; c < 4; ++c) gp[r][c] = gacc[r][c];
        RED_ALL2(gp, 4);
        int gs[2]; float pstar[2];
#pragma unroll
        for (int r = 0; r < 2; ++r) { const float g0 = rdlane(gp[r][0], 63) + brg[0], g1 = rdlane(gp[r][1], 63) + brg[1], g2 = rdlane(gp[r][2], 63) + brg[2], g3 = rdlane(gp[r][3], 63) + brg[3];
            int g = 0; float gmax = g0;
            if (g1 > gmax) { gmax = g1; g = 1; } if (g2 > gmax) { gmax = g2; g = 2; } if (g3 > gmax) { gmax = g3; g = 3; }
            gs[r] = g; pstar[r] = 1.f / (__expf(g0 - gmax) + __expf(g1 - gmax) + __expf(g2 - gmax) + __expf(g3 - gmax)); }
        float ev[2][8];
#pragma unroll
        for (int r = 0; r < 2; ++r) { f32x4 e0 = (f32x4){0.f, 0.f, 0.f, 0.f}, e1 = e0; const LAS float* wg = WL + 4 + 8 * gs[r];
#pragma unroll
            for (int j = 0; j < 4; ++j)
#pragma unroll
                for (int c = 0; c < 4; ++c) { const LAS f32x4* wr = (const LAS f32x4*)(wg + (lane + 64 * (4 * j + c)) * 36); e0 += wr[0] * v[r][j][c]; e1 += wr[1] * v[r][j][c]; }
#pragma unroll
            for (int c = 0; c < 4; ++c) { ev[r][c] = e0[c]; ev[r][4 + c] = e1[c]; } }
        RED_ALL2(ev, 8);
#pragma unroll
        for (int r = 0; r < 2; ++r) {
            float el[8];
#pragma unroll
            for (int e = 0; e < 8; ++e) el[e] = rdlane(ev[r][e], 63) + lbre[gs[r] * 8 + e];
            int i1 = 0; float v1 = el[0];
#pragma unroll
            for (int e = 1; e < 8; ++e) if (el[e] > v1) { v1 = el[e]; i1 = e; }
            int i2 = -1; float v2 = -3.0e38f;
#pragma unroll
            for (int e = 0; e < 8; ++e) if (e != i1 && el[e] > v2) { v2 = el[e]; i2 = e; }
            if (lane == 0 && ok[r]) {
                const int mm = mmr[r], ri = (2 * it + r) * 8 + F.wave;
                const float w1 = 1.f / (1.f + __expf(v2 - v1));
                const int e1 = gs[r] * 8 + i1, e2 = gs[r] * 8 + i2;
                const int l1 = __hip_atomic_fetch_add(lcnt + e1, 1, __ATOMIC_RELAXED, __HIP_MEMORY_SCOPE_WORKGROUP), l2 = __hip_atomic_fetch_add(lcnt + e2, 1, __ATOMIC_RELAXED, __HIP_MEMORY_SCOPE_WORKGROUP);
                recm[ri * 4 + 0] = mm; recm[ri * 4 + 1] = (e1 << 16) | e2; recm[ri * 4 + 2] = l1; recm[ri * 4 + 3] = l2;
                re[mm] = e1; re[MTOK + mm] = e2; rg[mm] = pstar[r] * w1; rg[MTOK + mm] = pstar[r] * (1.f - w1);
            }
        }
    }
    __syncthreads();
    if (F.tid < NEXP) { const int c = lcnt[F.tid]; lbase[F.tid] = c ? atomicAdd(&cnt[64 * F.tid], c) : 0; }
    __syncthreads();
    for (int i = F.tid; i < 128; i += 512) { const int mm = recm[i * 4 + 0], ee = recm[i * 4 + 1], e1 = ee >> 16, e2 = ee & 0xffff;
        if (mm >= 0) { const int p1 = lbase[e1] + recm[i * 4 + 2], p2 = lbase[e2] + recm[i * 4 + 3];
            list[e1 * MTOK + p1] = mm; list[e2 * MTOK + p2] = mm; rp[mm] = p1; rp[MTOK + mm] = p2; } }
    __syncthreads();
    }
#undef RED_ALL2
}

__device__ __forceinline__ int moe_tables(const Ptrs& p, const Frame& F) {
    LAS int* tab = (LAS int*)(F.lds + TAB_OFF);
    const int* cnt = (const int*)(p.ws + WS_CTL) + CW_CNT;
    if (F.tid < 64) {
        const int e = F.tid & 31; const int c = __hip_atomic_load(cnt + 64 * e, __ATOMIC_RELAXED, __HIP_MEMORY_SCOPE_AGENT); const int tiles = (c + 255) >> 8;
        int incl = tiles;
#pragma unroll
        for (int o = 1; o < 32; o <<= 1) { const int t = __shfl_up(incl, o, 32); if (e >= o) incl += t; }
        if (F.tid < 32) { tab[e] = incl - tiles; tab[40 + e] = (incl - tiles) * 256; tab[80 + e] = c; if (e == 31) tab[120] = incl; } }
    __syncthreads();
    return tab[120];
}


#ifdef MXTEST
typedef int v8i_t __attribute__((ext_vector_type(8)));
__device__ __forceinline__ int mx_a(int i, int k) { return ((i * 3 + k * 5 + (k >> 5)) % 5) - 2; }
__device__ __forceinline__ int mx_b(int k, int j) { return ((k * 7 + j * 2 + (k >> 4)) % 5) - 2; }
__device__ __forceinline__ int mx_kmap(int hyp, int g, int v, int byte) {
    if (hyp == 0) return 32 * g + 4 * v + byte;
    if (hyp == 1) return 64 * (v >> 2) + 16 * g + 4 * (v & 3) + byte;
    return 32 * (v >> 1) + 8 * g + 4 * (v & 1) + byte;
}
__device__ __forceinline__ bool mx_try(int hyp, int lane, int sa, int sb, float mult) {
    const int i = lane & 15, g = lane >> 4;
    v8i_t a, b;
#pragma unroll
    for (int v = 0; v < 8; ++v) {
        int pa = 0, pb = 0;
        pa = __builtin_amdgcn_cvt_pk_fp8_f32((float)mx_a(i, mx_kmap(hyp, g, v, 0)), (float)mx_a(i, mx_kmap(hyp, g, v, 1)), pa, false);
        pa = __builtin_amdgcn_cvt_pk_fp8_f32((float)mx_a(i, mx_kmap(hyp, g, v, 2)), (float)mx_a(i, mx_kmap(hyp, g, v, 3)), pa, true);
        pb = __builtin_amdgcn_cvt_pk_fp8_f32((float)mx_b(mx_kmap(hyp, g, v, 0), i), (float)mx_b(mx_kmap(hyp, g, v, 1), i), pb, false);
        pb = __builtin_amdgcn_cvt_pk_fp8_f32((float)mx_b(mx_kmap(hyp, g, v, 2), i), (float)mx_b(mx_kmap(hyp, g, v, 3), i), pb, true);
        a[v] = pa; b[v] = pb;
    }
    f32x4 c = {0.f, 0.f, 0.f, 0.f};
    c = __builtin_amdgcn_mfma_scale_f32_16x16x128_f8f6f4(a, b, c, 0, 0, 0, sa, 0, sb);
    bool ok = true;
#pragma unroll
    for (int rgi = 0; rgi < 4; ++rgi) { const int row = g * 4 + rgi; int acc = 0;
        for (int k = 0; k < 128; ++k) acc += mx_a(row, k) * mx_b(k, i);
        ok = ok && (c[rgi] == mult * (float)acc); }
    return __all(ok);
}
__device__ __forceinline__ float mx_selftest(int lane) {
    const int one = 0x7F7F7F7F;
    for (int hyp = 0; hyp < 3; ++hyp) {
        if (mx_try(hyp, lane, one, one, 1.f)) {
            const bool sc = mx_try(hyp, lane, 0x81818181, 0x7E7E7E7E, 2.f);
            return (hyp == 0 ? 1.f : hyp == 1 ? 1.25f : 1.5f) + (sc ? 0.f : 0.125f);
        }
    }
    return 2.f;
}
#endif
struct RowMoe { int ya[4], yc[4]; float g1s, g2s; };
template <class SEAM_T>
__device__ __forceinline__ void p8_final(const Ptrs& p, const Frame& F, float* dst, SEAM_T&& seam) {
    const LAS int* tab = (const LAS int*)(F.lds + TAB_OFF);
    const float* mod = (const float*)(p.ws + WS_MOD); const unsigned char* Y = (const unsigned char*)(p.ws + WS_Y);
    const int* re = (const int*)(p.ws + WS_ROUTE); const int* rp = re + 2 * MTOK; const float* rg = (const float*)(rp + 2 * MTOK);
#ifdef HALFCU
    if (F.vcu & 1) return;
    const int lane = F.lane, gw = (F.vcu >> 1) * NWAVES + F.wave, NGW = (F.G >> 1) * NWAVES;
#else
    const int lane = F.lane, gw = F.vcu * NWAVES + F.wave, NGW = F.G * NWAVES;
#endif
#if defined(MXTEST)
    const float tscale = mx_selftest(lane);
#else
    const float tscale = 1.f;
#endif
    RowRaw rn[2]; RowMoe mn[2]; size_t s1n[2], s2n[2]; float g1n[2], g2n[2];
#ifdef X1BF16
#define P8_ROWLOAD(mm_, r) do { const u32x2* xr_ = (const u32x2*)((const bf16_t*)(p.ws + WS_U) + (size_t)(mm_) * DM) + lane; _Pragma("unroll") for (int j = 0; j < 4; ++j) rn[r].y[j] = __builtin_nontemporal_load(xr_ + 64 * j); } while (0)
#else
#define P8_ROWLOAD(mm_, r) row_load<true>(p, mm_, lane, rn[r])
#endif
#define P8_ROUTE(mmv, r) do { const int mm_ = (mmv); if (mm_ < MTOK) { const int e1_ = re[mm_], e2_ = re[MTOK + mm_]; s1n[r] = (size_t)(tab[40 + e1_] + rp[mm_]); s2n[r] = (size_t)(tab[40 + e2_] + rp[MTOK + mm_]); \
        g1n[r] = rg[mm_] * (1.f / 16.f); g2n[r] = rg[MTOK + mm_] * (1.f / 16.f); } } while (0)
#define P8_LOAD(mmv, r) do { const int mm_ = (mmv); if (mm_ < MTOK) { P8_ROWLOAD(mm_, r); const unsigned* y1_ = (const unsigned*)(Y + s1n[r] * DM) + lane; const unsigned* y2_ = (const unsigned*)(Y + s2n[r] * DM) + lane; \
        _Pragma("unroll") for (int j = 0; j < 4; ++j) { mn[r].ya[j] = (int)__builtin_nontemporal_load(y1_ + 64 * j); mn[r].yc[j] = (int)__builtin_nontemporal_load(y2_ + 64 * j); } mn[r].g1s = g1n[r]; mn[r].g2s = g2n[r]; } } while (0)
    f32x4 pfv[5]; int t0_ = F.tid; asm volatile("" : "+v"(t0_));
    seam([&]() {
#pragma unroll
        for (int k = 0; k < 5; ++k) { const int i = t0_ + k * (NWAVES * 64); pfv[k] = i < 256 ? ((const f32x4*)p.ln2w)[i] : i < 512 ? ((const f32x4*)p.ln2b)[i - 256] : *(const f32x4*)(mod + ((i - 512) >> 8) * 6144 + 5120 + 4 * ((i - 512) & 255)); }
#pragma unroll
        for (int r = 0; r < 2; ++r) P8_ROUTE(gw + r * NGW, r);
#pragma unroll
        for (int r = 0; r < 2; ++r) { const int mm_ = gw + r * NGW; if (mm_ < MTOK) P8_ROWLOAD(mm_, r); }
    });
    { LAS f32x4* pl = (LAS f32x4*)F.lds;
#pragma unroll
      for (int k = 0; k < 5; ++k) pl[t0_ + k * (NWAVES * 64)] = pfv[k];
      __syncthreads(); }
#pragma unroll
    for (int r = 0; r < 2; ++r) { const int mm_ = gw + r * NGW; if (mm_ < MTOK) { const unsigned* y1_ = (const unsigned*)(Y + s1n[r] * DM) + lane; const unsigned* y2_ = (const unsigned*)(Y + s2n[r] * DM) + lane;
#pragma unroll
        for (int j = 0; j < 4; ++j) { mn[r].ya[j] = (int)__builtin_nontemporal_load(y1_ + 64 * j); mn[r].yc[j] = (int)__builtin_nontemporal_load(y2_ + 64 * j); } mn[r].g1s = g1n[r]; mn[r].g2s = g2n[r]; } }
#pragma unroll
    for (int r = 0; r < 2; ++r) P8_ROUTE(gw + (2 + r) * NGW, r);
    for (int m = gw; m < MTOK; m += 2 * NGW) {
        f32x4 v[2][4]; RowMoe mc[2];
#pragma unroll
        for (int r = 0; r < 2; ++r) { const int mm = m + r * NGW; if (mm < MTOK) {
#ifdef X1BF16
#pragma unroll
            for (int j = 0; j < 4; ++j) v[r][j] = (f32x4){__builtin_bit_cast(float, rn[r].y[j].x << 16), __builtin_bit_cast(float, rn[r].y[j].x & 0xffff0000u), __builtin_bit_cast(float, rn[r].y[j].y << 16), __builtin_bit_cast(float, rn[r].y[j].y & 0xffff0000u)};
#else
            row_u(rn[r], mod, mm / NS, lane, v[r]);
#endif
            mc[r] = mn[r]; } }
#pragma unroll
        for (int r = 0; r < 2; ++r) P8_LOAD(m + (2 + r) * NGW, r);
#pragma unroll
        for (int r = 0; r < 2; ++r) P8_ROUTE(m + (4 + r) * NGW, r);
#pragma unroll
        for (int r = 0; r < 2; ++r) { const int mm = m + r * NGW; if (mm < MTOK) {
            const int b = mm / NS;
            const f32x4* w1 = (const f32x4*)p.ln1w + lane; const f32x4* b1 = (const f32x4*)p.ln1b + lane;
            const LAS f32x4* gm = (const LAS f32x4*)F.lds + 512 + b * 256 + lane;
            float s = 0.f, mean, q, rstd;
#ifndef X1BF16
#pragma unroll
            for (int j = 0; j < 4; ++j) s += (v[r][j].x + v[r][j].y) + (v[r][j].z + v[r][j].w);
            mean = wsum(s) * (1.f / DM); q = 0.f;
#pragma unroll
            for (int j = 0; j < 4; ++j) { v[r][j] = v[r][j] - mean; q += (v[r][j].x * v[r][j].x + v[r][j].y * v[r][j].y) + (v[r][j].z * v[r][j].z + v[r][j].w * v[r][j].w); }
            rstd = 1.f / sqrtf(wsum(q) * (1.f / DM) + LN_EPS);
            s = 0.f;
#endif
#pragma unroll
            for (int j = 0; j < 4; ++j) {
#ifdef X1BF16
                const f32x4 x1 = v[r][j];
#else
                const f32x4 x1 = v[r][j] * rstd * w1[64 * j] + b1[64 * j];
#endif
                const int a = mc[r].ya[j], c = mc[r].yc[j];
                const f32x2 a01 = __builtin_amdgcn_cvt_pk_f32_fp8(a, false), a23 = __builtin_amdgcn_cvt_pk_f32_fp8(a, true), c01 = __builtin_amdgcn_cvt_pk_f32_fp8(c, false), c23 = __builtin_amdgcn_cvt_pk_f32_fp8(c, true);
                const float g1s = mc[r].g1s, g2s = mc[r].g2s;
                f32x4 y; y.x = g1s * a01.x + g2s * c01.x; y.y = g1s * a01.y + g2s * c01.y; y.z = g1s * a23.x + g2s * c23.x; y.w = g1s * a23.y + g2s * c23.y;
                v[r][j] = x1 * DN_ALPHA + gm[64 * j] * y; s += (v[r][j].x + v[r][j].y) + (v[r][j].z + v[r][j].w); }
            mean = wsum(s) * (1.f / DM); q = 0.f;
#pragma unroll
            for (int j = 0; j < 4; ++j) { v[r][j] = v[r][j] - mean; q += (v[r][j].x * v[r][j].x + v[r][j].y * v[r][j].y) + (v[r][j].z * v[r][j].z + v[r][j].w * v[r][j].w); }
            rstd = 1.f / sqrtf(wsum(q) * (1.f / DM) + LN_EPS);
            const LAS f32x4* w2 = (const LAS f32x4*)F.lds + lane; const LAS f32x4* b2 = w2 + 256;
            f32x4* dr = (f32x4*)(dst + (size_t)mm * DM) + lane;
#pragma unroll
            for (int j = 0; j < 4; ++j) __builtin_nontemporal_store((v[r][j] * rstd * w2[64 * j] + b2[64 * j]) * tscale, dr + 64 * j); } }
    }
#undef P8_ROUTE
#undef P8_LOAD
#undef P8_ROWLOAD
}
__device__ __forceinline__ Ptrs reload_ptrs() {
#if defined(__HIP_DEVICE_COMPILE__)
    typedef const void* cvp_t; typedef __attribute__((address_space(4))) cvp_t kp_t;
    const kp_t* q = (const kp_t*)__builtin_amdgcn_kernarg_segment_ptr();
    asm volatile("" : "+s"(q));
    Ptrs r; cvp_t* d = (cvp_t*)&r;
#pragma unroll
    for (int i = 0; i < (int)(sizeof(Ptrs) / sizeof(void*)); ++i) d[i] = q[i];
    return r;
#else
    return Ptrs{};
#endif
}
__global__ void __launch_bounds__(NWAVES * 64, 2) mega_fwd(Args args) {
    extern __shared__ __attribute__((aligned(16))) unsigned char lds_raw[];
    Frame F; F.lds = (LAS unsigned char*)lds_raw;
    F.tid = threadIdx.x; F.lane = F.tid & 63; F.wave = __builtin_amdgcn_readfirstlane(F.tid >> 6);
    F.G = gridDim.x; { const int bx = blockIdx.x; F.vcu = (F.G % 8 == 0) ? (bx % 8) * (F.G / 8) + bx / 8 : bx; }
    const Ptrs& p = args.p;
    volatile LAS unsigned* MISC = (volatile LAS unsigned*)(F.lds + MISC_OFF);
    for (int u = F.tid; u < 256; u += NWAVES * 64) MISC[u] = 0u;
    __syncthreads();
    unsigned* ctl = (unsigned*)(p.ws + WS_CTL);
    XcdBarrier bar = xcd_barrier_post(ctl + CW_BAR + args.li * XCD_BAR_WORDS, MISC + 8);
    if (F.tid == 0) ctl[CW_XCC + blockIdx.x] = xb_xcc_id() + 1u;
    const int lo = args.ph_lo, hi = args.ph_hi;
#ifdef XBAR
#pragma unroll 1
    for (int xb_ = 0; xb_ < XBAR; ++xb_) xcd_barrier(bar, F.tid);
#endif
#ifndef PHMASK
#define PHMASK 0x1ff
#endif
#define IN(k) (((PHMASK >> (k)) & 1) && lo <= (k) && (k) < hi)
#define SEAM(k) do { if (IN(k) && IN((k) + 1)) xcd_barrier(bar, F.tid); } while (0)
#ifndef DUP
#define DUP -1
#endif
#define REPS(k) _Pragma("unroll") for (int rep_ = 0; rep_ < ((DUP) == (k) ? 2 : 1); ++rep_)
#define REPBAR() do { if (rep_) xcd_barrier(bar, F.tid); } while (0)
#ifdef TSA
#define STAMP(k) do { if (blockIdx.x == 0 && F.tid == 0) ((unsigned long long*)(p.ws + WS_CTL + 65536))[k] = __builtin_amdgcn_s_memrealtime(); } while (0)
#else
#define STAMP(k) do {} while (0)
#endif
    STAMP(0);
#ifdef NPASS
#pragma unroll 1
    for (int pass_ = 0; pass_ < NPASS; ++pass_) {
    if (pass_) { xcd_barrier(bar, F.tid); if (blockIdx.x == 0 && F.tid < 32) __hip_atomic_store((int*)(p.ws + WS_CTL) + CW_CNT + 64 * F.tid, 0, __ATOMIC_RELAXED, __HIP_MEMORY_SCOPE_AGENT); xcd_barrier(bar, F.tid); }
#endif
    if (IN(0)) REPS(0) { REPBAR(); const Ptrs p = reload_ptrs(); p0_prologue(p, F); } SEAM(0); STAMP(1);
    { bool okx = lo == 0 && hi == 9 && F.G == 256;
#ifdef NO_XL
      okx = false;
#endif
      for (int t = F.tid; t < F.G; t += NWAVES * 64) { const unsigned a = xb_ld(ctl + CW_XCC + t), b = xb_ld(ctl + CW_XCC + (t & 7)); okx = okx && a != 0u && a == b; }
      if (F.tid == 0) MISC[16] = 1u;
      __syncthreads();
      if (!okx) MISC[16] = 0u;
      __syncthreads(); }
#define XL() (__builtin_amdgcn_readfirstlane((int)MISC[16]) != 0)
#define LSEAM(k) do { if (IN(k) && IN((k) + 1)) { if (XL()) xcd_local_barrier<((k) >= 3)>(ctl + CW_XL + 16 * ((int)blockIdx.x & 7) + (k), 32u, F.tid); else xcd_barrier(bar, F.tid); } } while (0)
    if (IN(1)) REPS(1) { REPBAR(); const Ptrs p = reload_ptrs(); p1_h1(p, F, XL()); } LSEAM(1); STAMP(2);

    if (IN(2)) REPS(2) { REPBAR(); const Ptrs p = reload_ptrs();
        pg8::DenseOrder S{(const char*)(p.ws + WS_HB), (const char*)(p.ws + WS_WIN), MTOK / 256, DPROJ / 256, DM, F.G, (int)blockIdx.x};
        pg8::EpiProj E{(bf16_t*)(p.ws + WS_QI), (bf16_t*)(p.ws + WS_KI), (bf16_t*)(p.ws + WS_V), (bf16_t*)(p.ws + WS_G), (float*)(p.ws + WS_DEC), (const float*)(p.ws + WS_LB), (const float*)(p.ws + WS_COS), (const float*)(p.ws + WS_SIN)};
        pg8::gemm_phase<pg8::EpiProj, pg8::DenseOrder, false>(F.lds, F.tid, DM, S, E);
    } LSEAM(2); STAMP(3);
    if (IN(3)) REPS(3) { REPBAR(); const Ptrs p = reload_ptrs();
#ifdef NAIVE_MIXER
        p3_mixer_naive(p, F);
#else
        const int item = F.vcu, seg = item & 3, bm = item >> 2, mb = bm >> 3, mmh = bm & 7;
#ifndef MIX_NO_A
        if (item < 256 && seg < mix::NSEG - 1) mix::pass_a(p, F, item, mb, mmh, seg);
#endif
        if (XL()) xcd_local_barrier<false>(ctl + CW_XL + 16 * ((int)blockIdx.x & 7) + 8, 32u, F.tid); else xcd_barrier(bar, F.tid);
#ifndef MIX_NO_B
        if (item < 256) mix::pass_b(p, F, item, mb, mmh, seg);
#endif
#endif
        { int l_ = (int)__builtin_amdgcn_mbcnt_hi(~0u, __builtin_amdgcn_mbcnt_lo(~0u, 0u)); asm volatile("" : "+v"(l_)); F.lane = l_; F.tid = F.wave * 64 + l_; }
    } LSEAM(3); STAMP(4);
    if (IN(4)) REPS(4) { REPBAR(); const Ptrs p = reload_ptrs();
        pg8::DenseOrder S{(const char*)(p.ws + WS_HB), (const char*)(p.ws + WS_WOUT), MTOK / 256, DM / 256, DM, F.G, (int)blockIdx.x};
        pg8::EpiResid E{(bf16_t*)(p.ws + WS_Y1)};
        pg8::gemm_phase<pg8::EpiResid, pg8::DenseOrder, false>(F.lds, F.tid, DM, S, E);
    } STAMP(5);
    if (IN(5)) { const Ptrs p = reload_ptrs();
        p5_route(p, F, XL(), [&](auto&& pre) { if (!IN(4)) pre(); else if (XL()) xcd_local_barrier<true>(ctl + CW_XL + 16 * ((int)blockIdx.x & 7) + 4, 32u, F.tid, pre); else xcd_barrier(bar, F.tid, pre); }); }
    else LSEAM(4);
    SEAM(5); STAMP(6);
    int nT = 0;
    if (IN(6) || IN(7) || IN(8)) { const Ptrs p = reload_ptrs(); nT = moe_tables(p, F); }
    (void)nT;
    { LAS int* tab = (LAS int*)(F.lds + TAB_OFF); const int NX = (F.G % 8 == 0) ? 8 : 1;
      if (F.tid == 0) {
          const int nTt = tab[120], NWX = F.G / NX, x = (int)blockIdx.x % NX, w = (int)blockIdx.x / NX, lo_ = (x * nTt) / NX, hi_ = ((x + 1) * nTt) / NX, nloc = 4 * (hi_ - lo_);
          const int base6 = nloc / NWX, r6 = nloc % NWX, T = (3 * nloc + NWX - 1) / NWX; int n7lo = T - 2 * (base6 + 1); n7lo = n7lo < 0 ? 0 : n7lo;
          tab[121] = lo_; tab[122] = hi_; tab[123] = r6; tab[124] = n7lo; tab[125] = NWX; tab[126] = w; }
      __syncthreads(); }
    if (IN(6)) REPS(6) { REPBAR(); const Ptrs p = reload_ptrs();
        pg8::MoeOrder S{(const LAS int*)(F.lds + TAB_OFF), true, (const char*)(p.ws + WS_HB), nullptr, (const char*)(p.ws + WS_WGU), (const int*)(p.ws + WS_LIST), nullptr};
        pg8::EpiSwiglu E{(unsigned char*)(p.ws + WS_ACT), (unsigned*)(p.ws + WS_CTL) + CW_DONE};
        pg8::gemm_phase<pg8::EpiSwiglu, pg8::MoeOrder, true, true>(F.lds, F.tid, DM / 2, S, E);
    } if (!XL()) SEAM(6); STAMP(7);

    if (IN(7)) REPS(7) { REPBAR(); const Ptrs p = reload_ptrs();
        pg8::MoeOrder S{(const LAS int*)(F.lds + TAB_OFF), false, nullptr, (const char*)(p.ws + WS_ACT), (const char*)(p.ws + WS_WDN), nullptr, (unsigned*)(p.ws + WS_CTL) + CW_DONE};
        pg8::EpiY E{(unsigned char*)(p.ws + WS_Y)};
        pg8::gemm_phase<pg8::EpiY, pg8::MoeOrder, false, true>(F.lds, F.tid, DEXP / 2, S, E);
    } STAMP(8);
    if (IN(8)) { const Ptrs p = reload_ptrs();
        p8_final(p, F, p.out, [&](auto&& pre) { if (IN(7)) xcd_barrier(bar, F.tid, pre); else pre(); }); }
    else SEAM(7);
#ifdef NPASS
    }
#endif
#undef IN
#undef SEAM
#undef LSEAM
#undef XL
}

static int g_grid = 0;
static bool mega_setup() {
    if (g_grid != 0) return g_grid > 0;
    int dev = 0, cus = 0, per_cu = 0;
    if (hipGetDevice(&dev) != hipSuccess || hipDeviceGetAttribute(&cus, hipDeviceAttributeMultiprocessorCount, dev) != hipSuccess) { g_grid = -1; return false; }
    if (hipFuncSetAttribute((const void*)mega_fwd, hipFuncAttributeMaxDynamicSharedMemorySize, LDS_BYTES) != hipSuccess) { fprintf(stderr, "kernel_launch: hipFuncSetAttribute failed\n"); g_grid = -1; return false; }
    if (hipOccupancyMaxActiveBlocksPerMultiprocessor(&per_cu, (const void*)mega_fwd, NWAVES * 64, LDS_BYTES) != hipSuccess || per_cu < 1) { fprintf(stderr, "kernel_launch: occupancy query says %d blocks/CU; not launching\n", per_cu); (void)hipGetLastError(); g_grid = -1; return false; }
    g_grid = cus;
    return true;
}
static void mega_launch(const Ptrs& p, int lo, int hi, int li, hipStream_t stream) {
    Args a{}; a.p = p; a.ph_lo = lo; a.ph_hi = hi; a.li = li; a.pad = 0;
    hipLaunchKernelGGL(mega_fwd, dim3(g_grid), dim3(NWAVES * 64), LDS_BYTES, stream, a);
}

extern "C" void kernel_launch(void* const* d_in, const int* in_sizes, int n_in, void* d_out, int out_size, void* d_ws, size_t ws_size, hipStream_t stream) {
    if (n_in != 21 || out_size != MTOK * DM || ws_size < WS_END) { fprintf(stderr, "kernel_launch: unexpected shapes (n_in %d out %d ws %zu)\n", n_in, out_size, ws_size); return; }
    if (!mega_setup()) return;
    Ptrs p{};
    p.x = (const float*)d_in[0]; p.c = (const float*)d_in[1]; p.pos = (const int*)d_in[2]; p.w_ada = (const float*)d_in[3]; p.b_ada = (const float*)d_in[4];
    p.w_in = (const float*)d_in[5]; p.w_out = (const float*)d_in[6]; p.hgrn_lb = (const float*)d_in[7]; p.hgrn_nw = (const float*)d_in[8]; p.ret_nw = (const float*)d_in[9];
    p.ln1w = (const float*)d_in[10]; p.ln1b = (const float*)d_in[11]; p.w_rg = (const float*)d_in[12]; p.b_rg = (const float*)d_in[13]; p.w_re = (const float*)d_in[14]; p.b_re = (const float*)d_in[15];
    p.w_gate = (const float*)d_in[16]; p.w_up = (const float*)d_in[17]; p.w_down = (const float*)d_in[18]; p.ln2w = (const float*)d_in[19]; p.ln2b = (const float*)d_in[20];
    p.out = (float*)d_out; p.ws = (unsigned char*)d_ws;
    (void)hipMemsetAsync((char*)d_ws + WS_CTL, 0, 32768, stream);
    mega_launch(p, 0, 9, 0, stream);
}
```

```cpp
#define X1BF16 1
#include <hip/hip_runtime.h>
#include <stdint.h>
#include <cstdio>

constexpr int NB = 8, NS = 4096, DM = 1024, MTOK = NB * NS, DPROJ = 4096;
constexpr int NEXP = 32, DEXP = 512;
constexpr int NCHUNK = MTOK / 64;
constexpr float LN_EPS = 1e-5f;
constexpr float DN_ALPHA = 1.189207115002721f;
constexpr int NSLOT = 73728;

constexpr size_t MiB = 1u << 20;
constexpr size_t WS_CTL = 0;
constexpr size_t WS_MOD = 1 * MiB;
constexpr size_t WS_LB = 1 * MiB + 512 * 1024;
constexpr size_t WS_ROUTE = 2 * MiB;
constexpr size_t WS_LIST = 4 * MiB;
constexpr size_t WS_COS = 8 * MiB;
constexpr size_t WS_SIN = 16 * MiB;
constexpr size_t WS_DEC = 24 * MiB;
constexpr size_t WS_WIN = 26 * MiB;
constexpr size_t WS_WOUT = 34 * MiB;
constexpr size_t WS_WGU = 36 * MiB;
constexpr size_t WS_WDN = 100 * MiB;
constexpr size_t WS_HB = 132 * MiB;
constexpr size_t WS_QI = 196 * MiB;
constexpr size_t WS_KI = 260 * MiB;
constexpr size_t WS_V = 324 * MiB;
constexpr size_t WS_G = 388 * MiB;
constexpr size_t WS_Y1 = 196 * MiB;
constexpr size_t WS_ACT = 260 * MiB;
constexpr size_t WS_Y = 296 * MiB;
constexpr size_t WS_U = 196 * MiB;
constexpr size_t WS_H2 = 476 * MiB;
constexpr size_t WS_END = 508 * MiB;
constexpr int CW_CNT = 64;

typedef unsigned short bf16_t;
__device__ __forceinline__ bf16_t f2bf(float f) { unsigned u = __builtin_bit_cast(unsigned, f); return (bf16_t)((u + 0x7fffu + ((u >> 16) & 1u)) >> 16); }
__device__ __forceinline__ float bf2f(bf16_t h) { return __builtin_bit_cast(float, (unsigned)h << 16); }
__device__ __forceinline__ float sigmoidf_(float x) { return 1.f / (1.f + __expf(-x)); }
__device__ __forceinline__ float siluf_(float x) { return x / (1.f + __expf(-x)); }
__device__ __forceinline__ float wave_sum(float v) {
#pragma unroll
    for (int o = 1; o < 64; o <<= 1) v += __shfl_xor(v, o);
    return v;
}
__device__ __forceinline__ float log2gamma(int h) {
    return h == 0 ? -0.04580368961312479f : h == 1 ? -0.02272007650008353f : h == 2 ? -0.011315313227834146f : -0.005646563141142063f;
}

struct Ptrs {
    const float *x, *c; const int* pos; const float *w_ada, *b_ada, *w_in, *w_out, *hgrn_lb, *hgrn_nw, *ret_nw, *ln1w, *ln1b, *w_rg, *b_rg, *w_re, *b_re, *w_gate, *w_up, *w_down, *ln2w, *ln2b;
    float* out; unsigned char* ws;
};


#define GAS __attribute__((address_space(1)))
#define LAS __attribute__((address_space(3)))
typedef short bf16x8 __attribute__((ext_vector_type(8)));
typedef float f32x4 __attribute__((ext_vector_type(4)));
typedef float f32x2 __attribute__((ext_vector_type(2)));
typedef unsigned u32x4 __attribute__((ext_vector_type(4)));
typedef unsigned u32x2 __attribute__((ext_vector_type(2)));
constexpr int NWAVES = 8;
constexpr int LDS_BYTES = 163840;
constexpr int RING_BYTES = 131072;
constexpr int MISC_OFF = 155648;
constexpr int TAB_OFF = 155648 + 1024;
constexpr int CW_BAR = 4096;

__device__ __forceinline__ unsigned cvt_pk_bf16(float lo, float hi) { unsigned r; asm volatile("v_cvt_pk_bf16_f32 %0, %1, %2" : "=v"(r) : "v"(lo), "v"(hi)); return r; }
#define LDS_WAIT() asm volatile("s_waitcnt lgkmcnt(0)" ::: "memory")
#define VM_WAIT() asm volatile("s_waitcnt vmcnt(0)" ::: "memory")

#define XB_TMO      128
#define XB_XCNT(j)  (256  + 64 * (j))
#define XB_XSUB(j)  (1280 + 64 * (j))
#define XB_XGEN(j)  (2304 + 64 * (j))
#define XB_TOP      3328
#define XB_TOPGEN   3392
#define XCD_BAR_WORDS 3456
constexpr int CW_XL = 3840;
constexpr int CW_XCC = 3584;
constexpr int CW_DONE = 2304;
#define XB_SPIN_CAP (1u << 18)
__device__ __forceinline__ unsigned xb_ld(unsigned* p)              { return __hip_atomic_load(p, __ATOMIC_RELAXED, __HIP_MEMORY_SCOPE_AGENT); }
__device__ __forceinline__ unsigned xb_add(unsigned* p, unsigned v) { return __hip_atomic_fetch_add(p, v, __ATOMIC_RELAXED, __HIP_MEMORY_SCOPE_AGENT); }
__device__ __forceinline__ unsigned xb_xcc_id() { return (unsigned)__builtin_amdgcn_s_getreg((3 << 11) | 20) & 0xFu; }
#define XB_SPIN(cond, bar) do { unsigned _sp = 0; while (cond) { __builtin_amdgcn_s_sleep(1); \
    if ((++_sp & 255u) == 0u) { if (xb_ld(&(bar)[XB_TMO])) break; if (_sp > XB_SPIN_CAP) { atomicAdd(&(bar)[XB_TMO], 1u); break; } } } } while (0)
struct XcdBarrier { unsigned* bar; unsigned x; volatile LAS unsigned* st; };
__device__ __forceinline__ XcdBarrier xcd_barrier_post(unsigned* bar, volatile LAS unsigned* st) {
    XcdBarrier b; b.bar = bar; b.x = xb_xcc_id(); b.st = st;
    if (threadIdx.x == 0) (void)xb_add(&bar[XB_XCNT(b.x)], 1u);
    return b;
}
__device__ __forceinline__ void xcd_barrier_complete(unsigned* bar, unsigned x, unsigned& nloc, unsigned& nx) {
    const unsigned G = gridDim.x * gridDim.y * gridDim.z;
    unsigned sum, cnt, mine, sp = 0u;
    for (;;) {
        sum = 0u; cnt = 0u; mine = 0u;
#pragma unroll
        for (unsigned j = 0; j < 16; ++j) { const unsigned c = xb_ld(&bar[XB_XCNT(j)]); sum += c; cnt += (c > 0u) ? 1u : 0u; mine = (j == x) ? c : mine; }
        if (sum == G) break;
        __builtin_amdgcn_s_sleep(1);
        if ((++sp & 255u) == 0u) { if (xb_ld(&bar[XB_TMO])) break; if (sp > XB_SPIN_CAP) { atomicAdd(&bar[XB_TMO], 1u); break; } }
    }
    nloc = mine > 0u ? mine : 1u; nx = cnt > 0u ? cnt : 1u;
}
template <bool INV = true>
__device__ __forceinline__ void xcd_local_barrier(unsigned* cnt, unsigned nloc) {
    asm volatile("s_waitcnt vmcnt(0)" ::: "memory");
    __syncthreads();
    if (threadIdx.x == 0) {
        (void)xb_add(cnt, 1u);
        unsigned sp = 0u;
        while (xb_ld(cnt) < nloc) { __builtin_amdgcn_s_sleep(1); if (++sp > XB_SPIN_CAP) break; }
        if (INV) { __builtin_amdgcn_fence(__ATOMIC_ACQUIRE, "agent"); asm volatile("s_waitcnt vmcnt(0)" ::: "memory"); }
    }
    __syncthreads();
}
template <class PF>
__device__ __forceinline__ void xcd_barrier(const XcdBarrier& b, PF&& pf) {
    asm volatile("s_waitcnt vmcnt(0)" ::: "memory");
    __syncthreads();
    if (threadIdx.x >= 64) pf();
    if (threadIdx.x == 0) {
        unsigned* bar = b.bar;
        __builtin_amdgcn_s_waitcnt(0);
        unsigned nloc = b.st[0], nx = b.st[1];
        if (nloc == 0u) { xcd_barrier_complete(bar, b.x, nloc, nx); b.st[0] = nloc; b.st[1] = nx; }
        const unsigned old = xb_add(&bar[XB_XSUB(b.x)], 1u);
        const unsigned gen = old / nloc;
        if (old + 1u == (gen + 1u) * nloc) {
            __builtin_amdgcn_fence(__ATOMIC_RELEASE, "agent");
            asm volatile("s_waitcnt vmcnt(0)" ::: "memory");
            const unsigned og = xb_add(&bar[XB_TOP], 1u);
            const unsigned tg = og / nx;
            if (og + 1u == (tg + 1u) * nx) xb_add(&bar[XB_TOPGEN], 1u);
            else XB_SPIN(xb_ld(&bar[XB_TOPGEN]) == tg, bar);
            __builtin_amdgcn_fence(__ATOMIC_ACQUIRE, "agent");
            xb_add(&bar[XB_XGEN(b.x)], 1u);
            asm volatile("s_waitcnt vmcnt(0)" ::: "memory");
        } else {
            XB_SPIN(xb_ld(&bar[XB_XGEN(b.x)]) == gen, bar);
            __builtin_amdgcn_fence(__ATOMIC_ACQUIRE, "agent");
            asm volatile("s_waitcnt vmcnt(0)" ::: "memory");
        }
    }
    __syncthreads();
    if (threadIdx.x < 64) pf();
}
__device__ __forceinline__ void xcd_barrier(const XcdBarrier& b) { xcd_barrier(b, []() {}); }

namespace pg8 {
constexpr int BM = 256, BK = 64, HALF = 128, HTB = HALF * BK * 2, NXCD = 8, WGM = 8;
__device__ __forceinline__ int lds_byte(int r, int c) { const int st = (r >> 4) * 2 + (c >> 5), rr = r & 15, cc = c & 31, ob = rr * 64 + cc * 2; return st * 1024 + (ob ^ (((ob >> 9) & 1) << 5)); }
__device__ __forceinline__ void stage_rc(int b, int& R, int& C) { const int st = b / 1024, sb = b % 1024, swz = sb ^ (((sb >> 9) & 1) << 5); R = (st >> 1) * 16 + swz / 64; C = (st & 1) * 32 + (swz % 64) / 2; }
__device__ __forceinline__ int perm32(int rho) { const int n = rho >> 4, i = rho & 15; return 8 * (i >> 2) + 4 * n + (i & 3); }

struct Unit { int pm, pn; const char* A; const char* B; const int* rows; int nrows; };

__device__ __forceinline__ void tile_of(int L, int nM, int nN, int& pm, int& pn) {
    const int nwg = nM * nN; int wgid = L;
    { const int q = nwg / NXCD, r = nwg % NXCD, xcd = wgid % NXCD, off = wgid / NXCD; wgid = (xcd < r ? xcd * (q + 1) : r * (q + 1) + (xcd - r) * q) + off; }
    const int nig = WGM * nN, gid = wgid / nig, fm = gid * WGM, gsz = (nM - fm) < WGM ? (nM - fm) : WGM;
    pm = fm + ((wgid % nig) % gsz); pn = (wgid % nig) / gsz;
}
struct DenseOrder {
    const char* A; const char* Bt; int nM, nN, K, G, c;
    __device__ __forceinline__ bool next(int i, Unit& u) const {
        const long L = (long)i * G + c; if (L >= (long)nM * nN) return false;
        tile_of((int)L, nM, nN, u.pm, u.pn);
        const size_t tstep = (size_t)BM * K * 2; u.A = A + (size_t)u.pm * tstep; u.B = Bt + (size_t)u.pn * tstep; u.rows = nullptr; u.nrows = 256; return true;
    }
};

template <class Epi, class Sched, bool GATHER, bool FP8 = false>
__device__ __forceinline__ void gemm_phase(LAS unsigned char* lds, const int K, const Sched& S, const Epi& E) {
    const int tid = threadIdx.x, wid = __builtin_amdgcn_readfirstlane(tid >> 6), lane = tid & 63, wr = wid >> 2, wc = wid & 3, fr = lane & 15, fq = lane >> 4;
    const int nt = K / BK;
    int RA[2], CA[2]; unsigned voffB[2];
#pragma unroll
    for (int i = 0; i < 2; ++i) { int R, C; stage_rc(tid * 16 + i * 8192, R, C); const int Rb = Epi::PERM ? ((R & ~31) + perm32(R & 31)) : R; RA[i] = R; CA[i] = C; voffB[i] = (unsigned)(Rb * K + C) * 2u; }
    const size_t kstep = (size_t)(BK * 2);
    const size_t hstep = (size_t)HALF * K * 2;
    const unsigned ldsw = (unsigned)wid * 1024u;
    const int aoff = lds_byte(wr * 64 + fr, FP8 ? fq * 16 : fq * 8), boff = lds_byte(wc * 32 + fr, FP8 ? fq * 16 : fq * 8);
    typedef int v8i_t __attribute__((ext_vector_type(8)));
    const int scA = E.scale_a(), scB = E.scale_b();
#define PG8_SA(b, h) (((b) * 2 + (h)) * HTB)
#define PG8_SB(b, h) ((4 + (b) * 2 + (h)) * HTB)
#define PG8_STAGE_B(bufoff, gbase) do { _Pragma("unroll") for (int _i = 0; _i < 2; ++_i) \
        __builtin_amdgcn_global_load_lds((const unsigned*)((const char*)(gbase) + voffB[_i]), (LAS unsigned*)(lds + (bufoff) + ldsw + _i * 8192), 16, 0, 0); } while (0)
#define PG8_STAGE_A(bufoff, gbase, o, h) do { _Pragma("unroll") for (int _i = 0; _i < 2; ++_i) \
        __builtin_amdgcn_global_load_lds((const unsigned*)((const char*)(gbase) + (o)[h][_i]), (LAS unsigned*)(lds + (bufoff) + ldsw + _i * 8192), 16, 0, 0); } while (0)
#define PG8_MKOFF(u, o) do { _Pragma("unroll") for (int _h = 0; _h < 2; ++_h) _Pragma("unroll") for (int _i = 0; _i < 2; ++_i) { \
        if (GATHER) { const int _row = 128 * _h + RA[_i]; const int _tok = (_row < (u).nrows) ? (u).rows[_row] : 0; (o)[_h][_i] = (unsigned)_tok * (unsigned)(K * 2) + (unsigned)(CA[_i] * 2); } \
        else (o)[_h][_i] = (unsigned)((RA[_i] + 128 * _h) * K + CA[_i]) * 2u; } } while (0)
#define PG8_CAT8(x, y) __builtin_bit_cast(v8i_t, __builtin_shufflevector((x), (y), 0, 1, 2, 3, 4, 5, 6, 7, 8, 9, 10, 11, 12, 13, 14, 15))
#define PG8_LDA(dst, b, h) do { _Pragma("unroll") for (int m = 0; m < 4; ++m) { \
        if (FP8) dst##8[m] = PG8_CAT8(*(const LAS bf16x8*)(lds + PG8_SA(b, h) + aoff + m * 2048), *(const LAS bf16x8*)(lds + PG8_SA(b, h) + aoff + 16 + m * 2048)); \
        else { dst[m][0] = *(const LAS bf16x8*)(lds + PG8_SA(b, h) + aoff + m * 2048); dst[m][1] = *(const LAS bf16x8*)(lds + PG8_SA(b, h) + aoff + 1024 + m * 2048); } } } while (0)
#define PG8_LDB(dst, b, h) do { _Pragma("unroll") for (int n = 0; n < 2; ++n) { \
        if (FP8) dst##8[n] = PG8_CAT8(*(const LAS bf16x8*)(lds + PG8_SB(b, h) + boff + n * 2048), *(const LAS bf16x8*)(lds + PG8_SB(b, h) + boff + 16 + n * 2048)); \
        else { dst[n][0] = *(const LAS bf16x8*)(lds + PG8_SB(b, h) + boff + n * 2048); dst[n][1] = *(const LAS bf16x8*)(lds + PG8_SB(b, h) + boff + 1024 + n * 2048); } } } while (0)
#define PG8_MMA(ai, bj, At, Bt) do { if (FP8) __builtin_amdgcn_sched_barrier(0); __builtin_amdgcn_s_setprio(1); _Pragma("unroll") for (int m = 0; m < 4; ++m) _Pragma("unroll") for (int n = 0; n < 2; ++n) { \
        if (FP8) acc[ai][bj][m][n] = __builtin_amdgcn_mfma_scale_f32_16x16x128_f8f6f4(Bt##8[n], At##8[m], acc[ai][bj][m][n], 0, 0, 0, scB, 0, scA); \
        else { _Pragma("unroll") for (int k = 0; k < 2; ++k) acc[ai][bj][m][n] = __builtin_amdgcn_mfma_f32_16x16x32_bf16(Bt[n][k], At[m][k], acc[ai][bj][m][n], 0, 0, 0); } } \
        __builtin_amdgcn_s_setprio(0); if (FP8) { _Pragma("unroll") for (int m = 0; m < 4; ++m) _Pragma("unroll") for (int n = 0; n < 2; ++n) asm volatile("" : "+v"(acc[ai][bj][m][n])); __builtin_amdgcn_sched_barrier(0); } } while (0)
#define PG8_WAIT_V(n) asm volatile("s_waitcnt vmcnt(" #n ")" ::: "memory")
#define PG8_WAIT_L(n) asm volatile("s_waitcnt lgkmcnt(" #n ")" ::: "memory")
#define PG8_BAR __builtin_amdgcn_s_barrier()
#define PG8_SCHED __builtin_amdgcn_sched_barrier(0)
    Unit cur, nxt; int ui = 0;
    if (!S.next(0, cur)) return;
    f32x4 acc[2][2][4][2];
#pragma unroll
    for (int a = 0; a < 2; ++a)
#pragma unroll
        for (int b = 0; b < 2; ++b)
#pragma unroll
            for (int m = 0; m < 4; ++m)
#pragma unroll
                for (int n = 0; n < 2; ++n) acc[a][b][m][n] = (f32x4){0.f, 0.f, 0.f, 0.f};
    bf16x8 At[4][2], B0[2][2], B1[2][2]; v8i_t At8[4], B08[2], B18[2];
    unsigned cO[2][2], nO[2][2];
    PG8_MKOFF(cur, cO);
    bool has_next = S.next(1, nxt);
    if (has_next) { PG8_MKOFF(nxt, nO); } else {
#pragma unroll
        for (int h = 0; h < 2; ++h)
#pragma unroll
            for (int i = 0; i < 2; ++i) nO[h][i] = cO[h][i]; }
    const char* cA = cur.A; const char* cB = cur.B;
    PG8_STAGE_B(PG8_SB(0, 0), cB); PG8_STAGE_B(PG8_SB(0, 1), cB + hstep); PG8_STAGE_A(PG8_SA(0, 0), cA, cO, 0); PG8_STAGE_A(PG8_SA(0, 1), cA, cO, 1);
    if (wr == 1) PG8_BAR;
    PG8_WAIT_V(2); PG8_BAR;
    PG8_STAGE_B(PG8_SB(1, 0), cB + kstep); PG8_STAGE_A(PG8_SA(1, 0), cA + kstep, cO, 0); PG8_STAGE_B(PG8_SB(1, 1), cB + hstep + kstep);
    PG8_WAIT_V(6); PG8_BAR;
    for (;;) {
        const char* nA = has_next ? nxt.A : cA; const char* nB = has_next ? nxt.B : cB;
#pragma unroll 1
        for (int t = 0; t < nt; t += 2) {
            const bool last = (t == nt - 2);
            const char* a1 = cA + (size_t)(t + 1) * kstep;
            const char* a2 = last ? nA : cA + (size_t)(t + 2) * kstep; const char* b2 = last ? nB : cB + (size_t)(t + 2) * kstep;
            const char* a3 = a2 + kstep; const char* b3 = b2 + kstep;
            unsigned o2[2][2];
#pragma unroll
            for (int h = 0; h < 2; ++h)
#pragma unroll
                for (int i = 0; i < 2; ++i) o2[h][i] = last ? nO[h][i] : cO[h][i];
            PG8_LDB(B0, 0, 0); PG8_LDB(B1, 0, 1); PG8_SCHED; PG8_LDA(At, 0, 0); PG8_STAGE_A(PG8_SA(1, 1), a1, cO, 1);
            PG8_WAIT_V(8); PG8_WAIT_L(0); PG8_BAR; PG8_MMA(0, 0, At, B0); PG8_MMA(0, 1, At, B1); PG8_BAR; PG8_SCHED;
            PG8_LDA(At, 0, 1); PG8_STAGE_B(PG8_SB(0, 0), b2); PG8_STAGE_B(PG8_SB(0, 1), b2 + hstep); PG8_STAGE_A(PG8_SA(0, 0), a2, o2, 0);
            PG8_WAIT_V(8); PG8_WAIT_L(0); PG8_BAR; PG8_MMA(1, 0, At, B0); PG8_MMA(1, 1, At, B1); PG8_BAR; PG8_SCHED;
            PG8_LDB(B0, 1, 0); PG8_LDB(B1, 1, 1); PG8_SCHED; PG8_LDA(At, 1, 0); PG8_STAGE_A(PG8_SA(0, 1), a2, o2, 1);
            PG8_WAIT_V(8); PG8_WAIT_L(0); PG8_BAR; PG8_MMA(0, 0, At, B0); PG8_MMA(0, 1, At, B1); PG8_BAR; PG8_SCHED;
            PG8_LDA(At, 1, 1); PG8_STAGE_B(PG8_SB(1, 0), b3); PG8_STAGE_B(PG8_SB(1, 1), b3 + hstep); PG8_STAGE_A(PG8_SA(1, 0), a3, o2, 0);
            PG8_WAIT_V(8); PG8_WAIT_L(0); PG8_BAR; PG8_MMA(1, 0, At, B0); PG8_MMA(1, 1, At, B1); PG8_BAR; PG8_SCHED;
        }
        if (wr == 0) PG8_BAR;
        Unit nn = cur; bool has_nn = false; unsigned tk[2][2] = {{0u, 0u}, {0u, 0u}};
        if (GATHER) { has_nn = has_next && S.next(ui + 2, nn);
            if (has_nn) {
#pragma unroll
                for (int _h = 0; _h < 2; ++_h)
#pragma unroll
                    for (int _i = 0; _i < 2; ++_i) { const int _row = 128 * _h + RA[_i]; tk[_h][_i] = (_row < nn.nrows) ? (unsigned)nn.rows[_row] : 0u; } } }
        E(acc, cur, wr, wc, fr, fq);
        E.post(cur, lane);
        if (!has_next) break;
#pragma unroll
        for (int a = 0; a < 2; ++a)
#pragma unroll
            for (int b = 0; b < 2; ++b)
#pragma unroll
                for (int m = 0; m < 4; ++m)
#pragma unroll
                    for (int n = 0; n < 2; ++n) acc[a][b][m][n] = (f32x4){0.f, 0.f, 0.f, 0.f};
        cur = nxt; cA = nA; cB = nB; ++ui;
#pragma unroll
        for (int h = 0; h < 2; ++h)
#pragma unroll
            for (int i = 0; i < 2; ++i) cO[h][i] = nO[h][i];
        if (GATHER) { has_next = has_nn;
            if (has_next) { nxt = nn;
#pragma unroll
                for (int _h = 0; _h < 2; ++_h)
#pragma unroll
                    for (int _i = 0; _i < 2; ++_i) nO[_h][_i] = tk[_h][_i] * (unsigned)(K * 2) + (unsigned)(CA[_i] * 2); } }
        else { has_next = S.next(ui + 1, nxt); if (has_next) { PG8_MKOFF(nxt, nO); } }
        if (wr == 1) PG8_BAR;
    }
    PG8_WAIT_V(0);
    PG8_BAR;
#undef PG8_SA
#undef PG8_SB
#undef PG8_STAGE_A
#undef PG8_STAGE_B
#undef PG8_MKOFF
#undef PG8_LDA
#undef PG8_LDB
#undef PG8_MMA
#undef PG8_CAT8
#undef PG8_WAIT_V
#undef PG8_WAIT_L
#undef PG8_BAR
#undef PG8_SCHED
}

template <int CTRL> __device__ __forceinline__ float dpp_mov0(float v) { return __builtin_bit_cast(float, __builtin_amdgcn_update_dpp(0, __builtin_bit_cast(int, v), CTRL, 0xf, 0xf, true)); }
__device__ __forceinline__ float row_scan16(float v) {
    v += dpp_mov0<0x111>(v); v += dpp_mov0<0x112>(v); v += dpp_mov0<0x114>(v); v += dpp_mov0<0x118>(v); return v;
}
template <int CTRL> __device__ __forceinline__ float dpp_mov1(float v) { return __builtin_bit_cast(float, __builtin_amdgcn_update_dpp(0x3f800000, __builtin_bit_cast(int, v), CTRL, 0xf, 0xf, false)); }
__device__ __forceinline__ float row_scanmul16(float v) {
    v *= dpp_mov1<0x111>(v); v *= dpp_mov1<0x112>(v); v *= dpp_mov1<0x114>(v); v *= dpp_mov1<0x118>(v); return v;
}
__device__ __forceinline__ void row_scanmul16x4(float& a, float& b, float& c, float& d) {
#define SM4_STEP(n) "v_mul_f32_dpp %0, %0, %0 row_shr:" #n " row_mask:0xf bank_mask:0xf\n\tv_mul_f32_dpp %1, %1, %1 row_shr:" #n " row_mask:0xf bank_mask:0xf\n\t" \
                    "v_mul_f32_dpp %2, %2, %2 row_shr:" #n " row_mask:0xf bank_mask:0xf\n\tv_mul_f32_dpp %3, %3, %3 row_shr:" #n " row_mask:0xf bank_mask:0xf\n\t"
    asm volatile("s_nop 1\n\t" SM4_STEP(1) SM4_STEP(2) SM4_STEP(4) SM4_STEP(8) "s_nop 0" : "+v"(a), "+v"(b), "+v"(c), "+v"(d));
#undef SM4_STEP
}

struct EpiProj {
    static constexpr bool PERM = true;
    __device__ __forceinline__ int scale_a() const { return 0; } __device__ __forceinline__ int scale_b() const { return 0; }
    __device__ __forceinline__ void post(const Unit&, int) const {}
    bf16_t *QI, *KI, *V, *G; float* DEC; const float *LB, *COS, *SIN; const int* POS;
    __device__ __forceinline__ void operator()(const f32x4 (&acc)[2][2][4][2], const Unit& u, int wr, int wc, int fr, int fq) const {
        const int typ = u.pn >> 2, h = u.pn & 3, lane = threadIdx.x & 63;
        const int cb = wc * 32 + 8 * fq;
        const int rowb = u.pm * BM + wr * 64 + fr;
        if (typ == 0) {
            const f32x4 lb0 = *(const f32x4*)(LB + h * 128 + cb), lb1 = *(const f32x4*)(LB + h * 128 + cb + 4);
#pragma unroll
            for (int ai = 0; ai < 2; ++ai) {
                unsigned oq[4][4], ok[4][4]; f32x4 dec[2];
#pragma unroll
                for (int n = 0; n < 2; ++n) {
                    float qv[4][4], kv[4][4];
#pragma unroll
                    for (int jp = 0; jp < 2; ++jp) {
                        const int j = 2 * jp;
                        const f32x2 lb = n ? (f32x2){lb1[j], lb1[j + 1]} : (f32x2){lb0[j], lb0[j + 1]}, oml = 1.f - lb;
                        f32x2 lf[4], kk[4];
#pragma unroll
                        for (int m = 0; m < 4; ++m) { const f32x2 z = (f32x2){__builtin_amdgcn_fmed3f(acc[ai][1][m][n][j], -30.f, 30.f), __builtin_amdgcn_fmed3f(acc[ai][1][m][n][j + 1], -30.f, 30.f)} * -1.4426950408889634f;
                            const f32x2 e = (f32x2){__builtin_amdgcn_exp2f(z.x), __builtin_amdgcn_exp2f(z.y)}, d1 = e + 1.f; const f32x2 r = (f32x2){__builtin_amdgcn_rcpf(d1.x), __builtin_amdgcn_rcpf(d1.y)};
                            lf[m] = lb + oml * r; kk[m] = oml * e * r; }
                        { float a0 = lf[0].x, a1 = lf[1].x, a2 = lf[2].x, a3 = lf[3].x, b0 = lf[0].y, b1 = lf[1].y, b2 = lf[2].y, b3 = lf[3].y;
                          row_scanmul16x4(a0, a1, a2, a3); row_scanmul16x4(b0, b1, b2, b3);
                          lf[0] = (f32x2){a0, b0}; lf[1] = (f32x2){a1, b1}; lf[2] = (f32x2){a2, b2}; lf[3] = (f32x2){a3, b3}; }
                        const f32x2 t0 = (f32x2){dpp_mov0<0x15F>(lf[0].x), dpp_mov0<0x15F>(lf[0].y)}, t1 = (f32x2){dpp_mov0<0x15F>(lf[1].x), dpp_mov0<0x15F>(lf[1].y)}, t2 = (f32x2){dpp_mov0<0x15F>(lf[2].x), dpp_mov0<0x15F>(lf[2].y)};
                        const f32x2 t01 = t0 * t1; lf[1] = lf[1] * t0; lf[2] = lf[2] * t01; lf[3] = lf[3] * (t01 * t2);
#pragma unroll
                        for (int m = 0; m < 4; ++m) { const f32x2 eb = lf[m], x = (f32x2){acc[ai][0][m][n][j], acc[ai][0][m][n][j + 1]}, xs = x * -1.4426950408889634f;
                            const f32x2 d2 = (f32x2){__builtin_amdgcn_exp2f(xs.x), __builtin_amdgcn_exp2f(xs.y)} + 1.f;
                            const f32x2 q2 = x * (f32x2){__builtin_amdgcn_rcpf(d2.x), __builtin_amdgcn_rcpf(d2.y)} * eb, k2 = kk[m] * (f32x2){__builtin_amdgcn_rcpf(eb.x), __builtin_amdgcn_rcpf(eb.y)};
                            qv[m][j] = q2.x; qv[m][j + 1] = q2.y; kv[m][j] = k2.x; kv[m][j + 1] = k2.y; if (m == 3) { dec[n][j] = eb.x; dec[n][j + 1] = eb.y; } }
                    }
#pragma unroll
                    for (int m = 0; m < 4; ++m) { oq[m][2 * n] = cvt_pk_bf16(qv[m][0], qv[m][1]); oq[m][2 * n + 1] = cvt_pk_bf16(qv[m][2], qv[m][3]); ok[m][2 * n] = cvt_pk_bf16(kv[m][0], kv[m][1]); ok[m][2 * n + 1] = cvt_pk_bf16(kv[m][2], kv[m][3]); }
                }
#pragma unroll
                for (int m = 0; m < 4; ++m) { const size_t o = (size_t)(rowb + ai * HALF + m * 16) * DM + h * 128 + cb;
                    __builtin_nontemporal_store((u32x4){oq[m][0], oq[m][1], oq[m][2], oq[m][3]}, (u32x4*)(QI + o)); __builtin_nontemporal_store((u32x4){ok[m][0], ok[m][1], ok[m][2], ok[m][3]}, (u32x4*)(KI + o)); }
                if (fr == 15) { float* d = DEC + (size_t)(u.pm * 4 + ai * 2 + wr) * 1024 + h * 128 + cb; *(f32x4*)d = dec[0]; *(f32x4*)(d + 4) = dec[1]; }
            }
        } else if (typ == 2) {
            const bool isk = wc >= 2; const int i0 = (wc & 1) * 32 + 8 * fq;
            bf16_t* dst = isk ? KI : QI; const float l2g = log2gamma(h);
            float invr[8], posf[8];
#pragma unroll
            for (int k = 0; k < 8; ++k) invr[k] = exp2f(-(float)(2 * (i0 + k)) * (13.287712379549449f / 128.0f)) * 0.15915494309189535f;
#pragma unroll
            for (int q = 0; q < 8; ++q) posf[q] = (float)POS[rowb + (q >> 2) * HALF + (q & 3) * 16];
#pragma unroll
            for (int ai = 0; ai < 2; ++ai)
#pragma unroll
                for (int m = 0; m < 4; ++m) { const int row = rowb + ai * HALF + m * 16; const float e = (float)(m * 16 + fr + 1) * l2g;
                    const float sc = isk ? __builtin_amdgcn_exp2f(-e) : __builtin_amdgcn_exp2f(e) * 0.08838834764831845f;
                    f32x4 c0, c1, s0, s1; const float pf = posf[ai * 4 + m];
#pragma unroll
                    for (int k = 0; k < 4; ++k) { const float r0 = __builtin_amdgcn_fractf(pf * invr[k]), r1 = __builtin_amdgcn_fractf(pf * invr[4 + k]);
                        c0[k] = __builtin_amdgcn_cosf(r0); s0[k] = __builtin_amdgcn_sinf(r0); c1[k] = __builtin_amdgcn_cosf(r1); s1[k] = __builtin_amdgcn_sinf(r1); }
                    const f32x4 a0 = acc[ai][0][m][0], a1 = acc[ai][0][m][1], b0 = acc[ai][1][m][0], b1 = acc[ai][1][m][1];
                    const f32x4 x0 = (a0 * c0 - b0 * s0) * sc, x1 = (a1 * c1 - b1 * s1) * sc, y0 = (a0 * s0 + b0 * c0) * sc, y1 = (a1 * s1 + b1 * c1) * sc;
                    const size_t o = (size_t)row * DM + 512 + h * 128 + i0;
                    __builtin_nontemporal_store((u32x4){cvt_pk_bf16(x0[0], x0[1]), cvt_pk_bf16(x0[2], x0[3]), cvt_pk_bf16(x1[0], x1[1]), cvt_pk_bf16(x1[2], x1[3])}, (u32x4*)(dst + o));
                    __builtin_nontemporal_store((u32x4){cvt_pk_bf16(y0[0], y0[1]), cvt_pk_bf16(y0[2], y0[3]), cvt_pk_bf16(y1[0], y1[1]), cvt_pk_bf16(y1[2], y1[3])}, (u32x4*)(dst + o + 64)); }
        } else {
            const int mh = (typ == 1 ? 0 : 4) + h;
#pragma unroll
            for (int ai = 0; ai < 2; ++ai)
#pragma unroll
                for (int m = 0; m < 4; ++m) { const size_t o = (size_t)(rowb + ai * HALF + m * 16) * DM + mh * 128 + cb;
                    const f32x4 v0 = acc[ai][0][m][0], v1 = acc[ai][0][m][1]; f32x4 g0 = acc[ai][1][m][0], g1 = acc[ai][1][m][1];
#pragma unroll
                    for (int j = 0; j < 1; ++j) {
                        const f32x4 t0 = g0 * -1.4426950408889634f, t1 = g1 * -1.4426950408889634f;
                        const f32x4 d0 = (f32x4){__builtin_amdgcn_exp2f(t0[0]), __builtin_amdgcn_exp2f(t0[1]), __builtin_amdgcn_exp2f(t0[2]), __builtin_amdgcn_exp2f(t0[3])} + 1.f, d1 = (f32x4){__builtin_amdgcn_exp2f(t1[0]), __builtin_amdgcn_exp2f(t1[1]), __builtin_amdgcn_exp2f(t1[2]), __builtin_amdgcn_exp2f(t1[3])} + 1.f;
                        g0 = g0 * (f32x4){__builtin_amdgcn_rcpf(d0[0]), __builtin_amdgcn_rcpf(d0[1]), __builtin_amdgcn_rcpf(d0[2]), __builtin_amdgcn_rcpf(d0[3])};
                        g1 = g1 * (f32x4){__builtin_amdgcn_rcpf(d1[0]), __builtin_amdgcn_rcpf(d1[1]), __builtin_amdgcn_rcpf(d1[2]), __builtin_amdgcn_rcpf(d1[3])}; }
                    __builtin_nontemporal_store((u32x4){cvt_pk_bf16(v0[0], v0[1]), cvt_pk_bf16(v0[2], v0[3]), cvt_pk_bf16(v1[0], v1[1]), cvt_pk_bf16(v1[2], v1[3])}, (u32x4*)(V + o));
                    __builtin_nontemporal_store((u32x4){cvt_pk_bf16(g0[0], g0[1]), cvt_pk_bf16(g0[2], g0[3]), cvt_pk_bf16(g1[0], g1[1]), cvt_pk_bf16(g1[2], g1[3])}, (u32x4*)(G + o)); }
        }
    }
};

struct EpiResid {
    static constexpr bool PERM = true;
    __device__ __forceinline__ int scale_a() const { return 0; } __device__ __forceinline__ int scale_b() const { return 0; }
    __device__ __forceinline__ void post(const Unit&, int) const {}
    bf16_t* Y1;
    __device__ __forceinline__ void operator()(const f32x4 (&acc)[2][2][4][2], const Unit& u, int wr, int wc, int fr, int fq) const {
        const int row0 = u.pm * BM + wr * 64 + fr, col0 = u.pn * BM + wc * 32 + 8 * fq;
#pragma unroll
        for (int ai = 0; ai < 2; ++ai)
#pragma unroll
            for (int m = 0; m < 4; ++m)
#pragma unroll
                for (int bj = 0; bj < 2; ++bj) { const f32x4 v0 = acc[ai][bj][m][0], v1 = acc[ai][bj][m][1];
                    *(u32x4*)(Y1 + (size_t)(row0 + ai * HALF + m * 16) * DM + col0 + bj * HALF) = (u32x4){cvt_pk_bf16(v0[0], v0[1]), cvt_pk_bf16(v0[2], v0[3]), cvt_pk_bf16(v1[0], v1[1]), cvt_pk_bf16(v1[2], v1[3])}; }
    }
};

struct EpiSwiglu {
    static constexpr bool PERM = true;
    __device__ __forceinline__ int scale_a() const { return 0x7F7F7F7F; } __device__ __forceinline__ int scale_b() const { return 0x79797979; }
    unsigned char* ACT; unsigned* done;
    __device__ __forceinline__ void post(const Unit& u, int lane) const { asm volatile("s_waitcnt vmcnt(0)" ::: "memory"); if (lane == 0) (void)xb_add(done + 4 * u.pm, 1u); }
    __device__ __forceinline__ void operator()(const f32x4 (&acc)[2][2][4][2], const Unit& u, int wr, int wc, int fr, int fq) const {
        const int row0 = u.pm * BM + wr * 64 + fr, col0 = u.pn * HALF + wc * 32 + 8 * fq;
#pragma unroll
        for (int ai = 0; ai < 2; ++ai) { u32x2 pk[4];
#pragma unroll
            for (int m = 0; m < 4; ++m) { f32x4 a0 = acc[ai][0][m][0], a1 = acc[ai][0][m][1]; const f32x4 u0 = acc[ai][1][m][0], u1 = acc[ai][1][m][1];
#pragma unroll
                for (int j = 0; j < 1; ++j) {
                    const f32x4 t0 = a0 * -1.4426950408889634f, t1 = a1 * -1.4426950408889634f;
                    const f32x4 d0 = (f32x4){__builtin_amdgcn_exp2f(t0[0]), __builtin_amdgcn_exp2f(t0[1]), __builtin_amdgcn_exp2f(t0[2]), __builtin_amdgcn_exp2f(t0[3])} + 1.f, d1 = (f32x4){__builtin_amdgcn_exp2f(t1[0]), __builtin_amdgcn_exp2f(t1[1]), __builtin_amdgcn_exp2f(t1[2]), __builtin_amdgcn_exp2f(t1[3])} + 1.f;
                    a0 = (a0 * 4.f) * (f32x4){__builtin_amdgcn_rcpf(d0[0]), __builtin_amdgcn_rcpf(d0[1]), __builtin_amdgcn_rcpf(d0[2]), __builtin_amdgcn_rcpf(d0[3])} * u0;
                    a1 = (a1 * 4.f) * (f32x4){__builtin_amdgcn_rcpf(d1[0]), __builtin_amdgcn_rcpf(d1[1]), __builtin_amdgcn_rcpf(d1[2]), __builtin_amdgcn_rcpf(d1[3])} * u1; }
                int w0 = 0, w1 = 0;
                w0 = __builtin_amdgcn_cvt_pk_fp8_f32(a0[0], a0[1], w0, false); w0 = __builtin_amdgcn_cvt_pk_fp8_f32(a0[2], a0[3], w0, true);
                w1 = __builtin_amdgcn_cvt_pk_fp8_f32(a1[0], a1[1], w1, false); w1 = __builtin_amdgcn_cvt_pk_fp8_f32(a1[2], a1[3], w1, true);
                pk[m] = (u32x2){(unsigned)w0, (unsigned)w1};
                if (m & 1) {
                    u32x2 a = pk[m - 1], b = pk[m];
                    asm volatile("s_nop 1\n\tv_permlane16_swap_b32 %0, %1\n\tv_permlane16_swap_b32 %2, %3" : "+v"(a.x), "+v"(b.x), "+v"(a.y), "+v"(b.y));
                    *(u32x4*)(ACT + (size_t)(row0 + ai * HALF + (m - 1 + (fq & 1)) * 16) * DEXP + u.pn * HALF + wc * 32 + 16 * (fq >> 1)) = (u32x4){a.x, a.y, b.x, b.y}; } } }
    }
};
struct EpiY {
    static constexpr bool PERM = true;
    __device__ __forceinline__ int scale_a() const { return 0x7D7D7D7D; } __device__ __forceinline__ int scale_b() const { return 0x79797979; }
    unsigned char* Y;
    __device__ __forceinline__ void post(const Unit&, int) const {}
    __device__ __forceinline__ void operator()(const f32x4 (&acc)[2][2][4][2], const Unit& u, int wr, int wc, int fr, int fq) const {
        const int row0 = u.pm * BM + wr * 64 + fr, col0 = u.pn * BM + wc * 32 + 8 * fq;
#pragma unroll
        for (int ai = 0; ai < 2; ++ai)
#pragma unroll
            for (int bj = 0; bj < 2; ++bj) { u32x2 pk[4];
#pragma unroll
                for (int m = 0; m < 4; ++m) { const f32x4 v0 = acc[ai][bj][m][0] * 16.f, v1 = acc[ai][bj][m][1] * 16.f;
                    int w0 = 0, w1 = 0;
                    w0 = __builtin_amdgcn_cvt_pk_fp8_f32(v0[0], v0[1], w0, false); w0 = __builtin_amdgcn_cvt_pk_fp8_f32(v0[2], v0[3], w0, true);
                    w1 = __builtin_amdgcn_cvt_pk_fp8_f32(v1[0], v1[1], w1, false); w1 = __builtin_amdgcn_cvt_pk_fp8_f32(v1[2], v1[3], w1, true);
                    pk[m] = (u32x2){(unsigned)w0, (unsigned)w1};
                    if (m & 1) { u32x2 a = pk[m - 1], b = pk[m];
                        asm volatile("s_nop 1\n\tv_permlane16_swap_b32 %0, %1\n\tv_permlane16_swap_b32 %2, %3" : "+v"(a.x), "+v"(b.x), "+v"(a.y), "+v"(b.y));
                        *(u32x4*)(Y + (size_t)(row0 + ai * HALF + (m - 1 + (fq & 1)) * 16) * DM + u.pn * BM + wc * 32 + 16 * (fq >> 1) + bj * HALF) = (u32x4){a.x, a.y, b.x, b.y}; } } }
    }
};
struct MoeOrder {
    const LAS int* tab; bool up; const char* HBp; const char* ACTp; const char* W; const int* list; unsigned* done;
    __device__ __forceinline__ bool next(int i, Unit& u) const {
        const int lo = tab[121], hi = tab[122], r6 = tab[123], n7lo = tab[124], NWX = tab[125], w = tab[126], nloc = 4 * (hi - lo);
        int l;
        if (up || r6 == 0 || i < n7lo) l = w + NWX * i;
        else { if (w < r6) return false; l = NWX * n7lo + (NWX - r6) * (i - n7lo) + (w - r6); }
        if (l >= nloc) return false;
        const int g = l >> 5, within = l & 31, fm = lo + 8 * g, gsz = (hi - fm) < 8 ? (hi - fm) : 8;
        const int pn = (within >= gsz ? 1 : 0) + (within >= 2 * gsz ? 1 : 0) + (within >= 3 * gsz ? 1 : 0), mt = fm + within - pn * gsz;
        int e = 0;
#pragma unroll 1
        for (int k = 16; k > 0; k >>= 1) if (tab[e + k] <= mt) e += k;
        const int t = mt - tab[e], so = tab[40 + e], n = tab[80 + e];
        u.pm = (so >> 8) + t; u.pn = pn;
        if (up) { u.A = HBp; u.B = W + (size_t)e * (1024 * 1024) + (size_t)pn * (256 * 1024); u.rows = list + (size_t)e * MTOK + t * 256; u.nrows = n - t * 256; }
        else { u.A = ACTp + (size_t)u.pm * (256 * DEXP); u.B = W + (size_t)e * (1024 * DEXP) + (size_t)pn * (256 * DEXP); u.rows = nullptr; u.nrows = 256;
            unsigned sp = 0u; while (xb_ld(done + 4 * u.pm) < 32u) { __builtin_amdgcn_s_sleep(2); if (++sp > (1u << 16)) break; }
            asm volatile("s_waitcnt vmcnt(0)" ::: "memory"); }
        return true;
    }
};
}

struct Frame { LAS unsigned char* lds; int tid, lane, wave, vcu, G; };
struct Args { Ptrs p; int ph_lo, ph_hi, li, pad; };

__device__ __forceinline__ int srcmap_in(int d) {
    const int pn = d >> 8, bj = (d >> 7) & 1, cc = d & 127, t = pn >> 2, h = pn & 3;
    if (t == 0) return (bj ? 512 : 0) + h * 128 + cc;
    if (t == 1) return (bj ? 1536 : 1024) + h * 128 + cc;
    if (t == 2) return (cc < 64 ? 2048 : 2560 - 64) + h * 128 + bj * 64 + cc;
    return (bj ? 3584 : 3072) + h * 128 + cc;
}
__device__ __forceinline__ void tr_item(const float* W, int ldw, int scol0, int k0, bf16_t* WT, int K, int drow0, LAS float* scr, int lane) {
    float tv[32];
#pragma unroll
    for (int i = 0; i < 32; ++i) { const int kk = 2 * i + (lane >> 5); tv[i] = W[(size_t)(k0 + kk) * ldw + scol0 + (lane & 31)]; }
#pragma unroll
    for (int i = 0; i < 32; ++i) { const int kk = 2 * i + (lane >> 5); scr[kk * 33 + (lane & 31)] = tv[i]; }
    LDS_WAIT(); asm volatile("" ::: "memory");
    const int c = lane & 7;
#pragma unroll
    for (int j = 0; j < 4; ++j) { const int n = (lane >> 3) + 8 * j; const LAS float* s = scr + (8 * c) * 33 + n;
        u32x4 o; o.x = cvt_pk_bf16(s[0 * 33], s[1 * 33]); o.y = cvt_pk_bf16(s[2 * 33], s[3 * 33]); o.z = cvt_pk_bf16(s[4 * 33], s[5 * 33]); o.w = cvt_pk_bf16(s[6 * 33], s[7 * 33]);
        *(u32x4*)(WT + (size_t)(drow0 + n) * K + k0 + 8 * c) = o; }
    LDS_WAIT(); asm volatile("" ::: "memory");
}
__device__ __forceinline__ void tr_item8(const float* W, int ldw, int scol0, int k0, unsigned char* WT, int K, int drow0, LAS float* scr, int lane) {
    float tv[32];
#pragma unroll
    for (int i = 0; i < 32; ++i) { const int kk = 2 * i + (lane >> 5); tv[i] = W[(size_t)(k0 + kk) * ldw + scol0 + (lane & 31)]; }
#pragma unroll
    for (int i = 0; i < 32; ++i) { const int kk = 2 * i + (lane >> 5); scr[kk * 33 + (lane & 31)] = tv[i]; }
    LDS_WAIT(); asm volatile("" ::: "memory");
    const int c = lane & 3;
#pragma unroll
    for (int j = 0; j < 2; ++j) { const int n = (lane >> 2) + 16 * j; const LAS float* s = scr + (16 * c) * 33 + n;
        u32x4 o;
#pragma unroll
        for (int q = 0; q < 4; ++q) { int w = 0; w = __builtin_amdgcn_cvt_pk_fp8_f32(64.f * s[(4 * q + 0) * 33], 64.f * s[(4 * q + 1) * 33], w, false); w = __builtin_amdgcn_cvt_pk_fp8_f32(64.f * s[(4 * q + 2) * 33], 64.f * s[(4 * q + 3) * 33], w, true); o[q] = (unsigned)w; }
        *(u32x4*)(WT + (size_t)(drow0 + n) * K + k0 + 16 * c) = o; }
    LDS_WAIT(); asm volatile("" ::: "memory");
}
template <bool F8>
__device__ __forceinline__ void tr_item64(const float* W, int ldw, int scol0, int k0, void* WTv, int K, int drow0, LAS float* scr, int lane) {
    float tv[64];
#pragma unroll
    for (int i = 0; i < 64; ++i) tv[i] = __builtin_nontemporal_load(W + (size_t)(k0 + i) * ldw + scol0 + lane);
#pragma unroll
    for (int i = 0; i < 64; ++i) scr[i * 65 + lane] = tv[i];
    LDS_WAIT(); asm volatile("" ::: "memory");
    if (F8) {
        unsigned char* WT = (unsigned char*)WTv; const int c = lane & 3;
#pragma unroll
        for (int j = 0; j < 4; ++j) { const int n = (lane >> 2) + 16 * j; const LAS float* s = scr + (16 * c) * 65 + n;
            u32x4 o;
#pragma unroll
            for (int q = 0; q < 4; ++q) { int w = 0; w = __builtin_amdgcn_cvt_pk_fp8_f32(64.f * s[(4 * q + 0) * 65], 64.f * s[(4 * q + 1) * 65], w, false); w = __builtin_amdgcn_cvt_pk_fp8_f32(64.f * s[(4 * q + 2) * 65], 64.f * s[(4 * q + 3) * 65], w, true); o[q] = (unsigned)w; }
            __builtin_nontemporal_store(o, (u32x4*)(WT + (size_t)(drow0 + n) * K + k0 + 16 * c)); }
    } else {
        bf16_t* WT = (bf16_t*)WTv; const int c = lane & 7;
#pragma unroll
        for (int j = 0; j < 8; ++j) { const int n = (lane >> 3) + 8 * j; const LAS float* s = scr + (8 * c) * 65 + n;
            u32x4 o; o.x = cvt_pk_bf16(s[0 * 65], s[1 * 65]); o.y = cvt_pk_bf16(s[2 * 65], s[3 * 65]); o.z = cvt_pk_bf16(s[4 * 65], s[5 * 65]); o.w = cvt_pk_bf16(s[6 * 65], s[7 * 65]);
            *(u32x4*)(WT + (size_t)(drow0 + n) * K + k0 + 8 * c) = o; }
    }
    LDS_WAIT(); asm volatile("" ::: "memory");
}
__device__ __forceinline__ void p0_prologue(const Ptrs& p, const Frame& F) {
    float* mod = (float*)(p.ws + WS_MOD);
    for (int item = F.vcu; item < 96; item += F.G) {
        LAS float* sc = (LAS float*)F.lds; LAS float* part = (LAS float*)(F.lds + 32768);
        for (int i = F.tid; i < 8192; i += 512) sc[i] = siluf_(p.c[i]);
        __syncthreads();
        const int j = 64 * item + F.lane; float acc[8];
#pragma unroll
        for (int b = 0; b < 8; ++b) acc[b] = 0.f;
#pragma unroll 8
        for (int k = F.wave * 128; k < F.wave * 128 + 128; ++k) { const float w = __builtin_nontemporal_load(p.w_ada + (size_t)k * 6144 + j);
#pragma unroll
            for (int b = 0; b < 8; ++b) acc[b] += sc[b * 1024 + k] * w; }
#pragma unroll
        for (int b = 0; b < 8; ++b) part[(F.wave * 8 + b) * 64 + F.lane] = acc[b];
        __syncthreads();
        { const int b = F.wave; float s = p.b_ada[j];
#pragma unroll
            for (int w = 0; w < 8; ++w) s += part[(w * 8 + b) * 64 + F.lane];
            mod[b * 6144 + j] = s; }
        __syncthreads();
    }
    if (F.vcu == F.G - 1) { float* lb = (float*)(p.ws + WS_LB); const int i = F.tid; const float a = p.hgrn_lb[i], b = p.hgrn_lb[512 + i]; const float mx = fmaxf(a, b); const float ea = __expf(a - mx), eb = __expf(b - mx); lb[i] = ea / (ea + eb); }
    { float* dec = (float*)(p.ws + WS_DEC);
      for (int i = F.vcu * 512 + F.tid; i < NCHUNK * 512; i += F.G * 512) dec[(size_t)(i >> 9) * 1024 + 512 + (i & 511)] = exp2f(64.f * log2gamma((i >> 7) & 3)); }
    __syncthreads();
    LAS float* scr = (LAS float*)(F.lds + F.wave * 16640);
    const int gw = F.vcu * NWAVES + F.wave, NGW = F.G * NWAVES;
    constexpr int I_IN = 16 * 64, I_OUT = 16 * 16, I_GU = 32 * 16 * 16, I_DN = 32 * 8 * 16;
    bf16_t* WIN = (bf16_t*)(p.ws + WS_WIN); bf16_t* WOUT = (bf16_t*)(p.ws + WS_WOUT); unsigned char* WGU = (unsigned char*)(p.ws + WS_WGU); unsigned char* WDN = (unsigned char*)(p.ws + WS_WDN);
    for (int it = NGW - 1 - gw; it < I_IN + I_OUT + I_GU + I_DN; it += NGW) {
        int r = it;
        if (r < I_IN) { const int kb = r >> 6, nb = r & 63; tr_item64<false>(p.w_in, DPROJ, srcmap_in(64 * nb), 64 * kb, WIN, DM, 64 * nb, scr, F.lane); continue; } r -= I_IN;
        if (r < I_OUT) { const int kb = r >> 4, nb = r & 15; tr_item64<false>(p.w_out, DM, 64 * nb, 64 * kb, WOUT, DM, 64 * nb, scr, F.lane); continue; } r -= I_OUT;
        if (r < I_GU) { const int e = r >> 8, kb = (r >> 4) & 15, nb = r & 15, d0 = 64 * nb, pn = d0 >> 8, bj = (d0 >> 7) & 1, cc = d0 & 127;
            tr_item64<true>((bj ? p.w_up : p.w_gate) + (size_t)e * DM * DEXP, DEXP, 128 * pn + cc, 64 * kb, WGU + (size_t)e * 1024 * 1024, DM, d0, scr, F.lane); continue; } r -= I_GU;
        { const int e = r >> 7, kb = (r >> 4) & 7, nb = r & 15; tr_item64<true>(p.w_down + (size_t)e * DEXP * DM, DM, 64 * nb, 64 * kb, WDN + (size_t)e * 1024 * DEXP, DEXP, 64 * nb, scr, F.lane); }
    }
}

template <int CTRL, int RM, int BMK, bool BC> __device__ __forceinline__ float dppf(float v) { return __builtin_bit_cast(float, __builtin_amdgcn_update_dpp(0, __builtin_bit_cast(int, v), CTRL, RM, BMK, BC)); }
__device__ __forceinline__ float lane63_sum(float v) {
    v += dppf<0x111, 0xf, 0xf, true>(v); v += dppf<0x112, 0xf, 0xf, true>(v); v += dppf<0x114, 0xf, 0xf, true>(v); v += dppf<0x118, 0xf, 0xf, true>(v);
    v += dppf<0x142, 0xa, 0xf, false>(v); v += dppf<0x143, 0xc, 0xf, false>(v); return v;
}
__device__ __forceinline__ float rdlane(float v, int l) { return __builtin_bit_cast(float, __builtin_amdgcn_readlane(__builtin_bit_cast(int, v), l)); }
__device__ __forceinline__ float wsum(float v) { return rdlane(lane63_sum(v), 63); }
__device__ __forceinline__ float hsum4(f32x4 v) { return (v.x + v.y) + (v.z + v.w); }
__device__ __forceinline__ void p1_h1(const Ptrs& p, const Frame& F, const bool xl) {
    const float* mod = (const float*)(p.ws + WS_MOD); bf16_t* hb = (bf16_t*)(p.ws + WS_HB);
    const int gw = xl ? (F.vcu >> 5) * NS + (F.vcu & 31) * NWAVES + F.wave : F.vcu * NWAVES + F.wave, NGW = xl ? 32 * NWAVES : F.G * NWAVES, mlim = xl ? ((F.vcu >> 5) + 1) * NS : MTOK;
    const int m0 = xl ? gw + 14 * NGW : gw, ms = xl ? -2 * NGW : 2 * NGW;
    f32x4 vn[2][4], shr[4], sclr[4]; int curb = -1;
#pragma unroll
    for (int r = 0; r < 2; ++r) { const int mm = m0 + r * NGW; if (mm < mlim) {
#pragma unroll
        for (int j = 0; j < 4; ++j) vn[r][j] = __builtin_nontemporal_load((const f32x4*)(p.x + (size_t)mm * DM) + F.lane + 64 * j); } }
    for (int m = m0; m >= gw && m < mlim; m += ms) {
        f32x4 v[2][4];
#pragma unroll
        for (int r = 0; r < 2; ++r)
#pragma unroll
            for (int j = 0; j < 4; ++j) v[r][j] = vn[r][j];
#pragma unroll
        for (int r = 0; r < 2; ++r) { const int mm = m + ms + r * NGW; if (mm >= gw && mm < mlim) {
#pragma unroll
            for (int j = 0; j < 4; ++j) vn[r][j] = __builtin_nontemporal_load((const f32x4*)(p.x + (size_t)mm * DM) + F.lane + 64 * j); } }
#pragma unroll
        for (int r = 0; r < 2; ++r) { const int mm = m + r * NGW; if (mm < mlim) {
            const int b = mm / NS; float s = 0.f;
#pragma unroll
            for (int j = 0; j < 4; ++j) s += (v[r][j].x + v[r][j].y) + (v[r][j].z + v[r][j].w);
            const float mean = wsum(s) * (1.f / DM); float q = 0.f;
#pragma unroll
            for (int j = 0; j < 4; ++j) { v[r][j] = v[r][j] - mean; q += (v[r][j].x * v[r][j].x + v[r][j].y * v[r][j].y) + (v[r][j].z * v[r][j].z + v[r][j].w * v[r][j].w); }
            const float rstd = __builtin_amdgcn_rsqf(wsum(q) * (1.f / DM) + LN_EPS);
            if (b != curb) { curb = b;
#pragma unroll
                for (int j = 0; j < 4; ++j) { shr[j] = ((const f32x4*)(mod + b * 6144))[F.lane + 64 * j]; sclr[j] = ((const f32x4*)(mod + b * 6144 + 1024))[F.lane + 64 * j] + 1.f; } }
            u32x2* o8 = (u32x2*)(hb + (size_t)mm * DM) + F.lane;
#pragma unroll
            for (int j = 0; j < 4; ++j) { const f32x4 t = v[r][j] * rstd * sclr[j] + shr[j]; o8[64 * j] = (u32x2){cvt_pk_bf16(t.x, t.y), cvt_pk_bf16(t.z, t.w)}; } } }
    }
}

__device__ __forceinline__ void p3_mixer_naive(const Ptrs& p, const Frame& F) {
    if (F.vcu >= 64) return;
    LAS float* qs = (LAS float*)F.lds; LAS float* ks = qs + 128; LAS float* part = ks + 128; LAS float* red = part + 512;
    const int b = F.vcu >> 3, mh = F.vcu & 7, tid = F.tid, j = tid & 127, g = tid >> 7;
    const bf16_t* QI = (const bf16_t*)(p.ws + WS_QI); const bf16_t* KI = (const bf16_t*)(p.ws + WS_KI); const bf16_t* V = (const bf16_t*)(p.ws + WS_V); const bf16_t* G = (const bf16_t*)(p.ws + WS_G);
    const float* DEC = (const float*)(p.ws + WS_DEC); bf16_t* O = (bf16_t*)(p.ws + WS_HB);
    float st[32];
#pragma unroll
    for (int i = 0; i < 32; ++i) st[i] = 0.f;
    const float nw = mh < 4 ? p.hgrn_nw[mh * 128 + j] : p.ret_nw[(mh - 4) * 128 + j];
    for (int s = 0; s < NS; ++s) {
        const size_t m = (size_t)b * NS + s;
        __syncthreads();
        if (tid < 128) qs[tid] = bf2f(QI[m * DM + mh * 128 + tid]); else if (tid < 256) ks[tid - 128] = bf2f(KI[m * DM + mh * 128 + tid - 128]);
        const float v = bf2f(V[m * DM + mh * 128 + j]);
        __syncthreads();
        float acc = 0.f;
#pragma unroll
        for (int i = 0; i < 32; ++i) { st[i] += ks[g * 32 + i] * v; acc += st[i] * qs[g * 32 + i]; }
        part[g * 128 + j] = acc;
        if ((s & 63) == 63) { const int ch = (int)(m >> 6);
#pragma unroll
            for (int i = 0; i < 32; ++i) { const float d = DEC[(size_t)ch * 1024 + mh * 128 + g * 32 + i]; st[i] *= d; } }
        __syncthreads();
        float o = 0.f, s1 = 0.f, s2 = 0.f;
        if (tid < 128) { o = part[j] + part[128 + j] + part[256 + j] + part[384 + j]; s1 = wave_sum(o); s2 = wave_sum(o * o); if ((tid & 63) == 0) { red[(tid >> 6) * 2] = s1; red[(tid >> 6) * 2 + 1] = s2; } }
        __syncthreads();
        if (tid < 128) { const float t1 = red[0] + red[2], t2 = red[1] + red[3]; float r;
            if (mh < 4) r = o * (__builtin_amdgcn_rsqf(t2 * (1.f / 128.f) + LN_EPS));
            else { const float mu = t1 * (1.f / 128.f); const float var = fmaxf(t2 * (1.f / 128.f) - mu * mu, 0.f); r = (o - mu) * (__builtin_amdgcn_rsqf(var + LN_EPS)); }
            O[m * DM + mh * 128 + j] = f2bf(r * nw * bf2f(G[m * DM + mh * 128 + j])); }
    }
    __syncthreads();
}


namespace mix {
typedef short s16x4 __attribute__((ext_vector_type(4)));
typedef short s16x8 __attribute__((ext_vector_type(8)));
typedef float f32x16 __attribute__((ext_vector_type(16)));
typedef float f32x8 __attribute__((ext_vector_type(8)));
typedef __bf16 bf16v8 __attribute__((ext_vector_type(8)));
typedef __bf16 bf16v4 __attribute__((ext_vector_type(4)));
constexpr int NSEG = 4, SEGC = 16;
constexpr int PART_OFF = 131072, DECB_OFF = 135168, XCH_OFF = 137216, DECA_OFF = 131072, NW_OFF = 153600;
constexpr size_t WS_LST = 454 * MiB, WS_DPR = 452 * MiB;
#define MFMA32(a, b, c) __builtin_amdgcn_mfma_f32_32x32x16_bf16((a), (b), (c), 0, 0, 0)
__device__ __forceinline__ unsigned img_off(unsigned row, unsigned ch) { return 256u * row + 16u * (ch ^ (((row & 3u) << 2) | ((row >> 2) & 3u))); }
__device__ __forceinline__ s16x4 trd(LAS unsigned char* base, unsigned R0, unsigned c32, unsigned lane) {
    const unsigned blk = (lane >> 4) & 1u, q = (lane & 15u) >> 2, p = lane & 3u;
    typedef short v4i16 __attribute__((ext_vector_type(4)));
    return __builtin_bit_cast(s16x4, __builtin_amdgcn_ds_read_tr16_b64_v4i16((LAS v4i16*)(base + img_off(R0 + q, 4u * c32 + 2u * blk + (p >> 1)) + 8u * (p & 1u))));
}
__device__ __forceinline__ s16x8 cat8(s16x4 a, s16x4 b) { return __builtin_shufflevector(a, b, 0, 1, 2, 3, 4, 5, 6, 7); }
__device__ __forceinline__ unsigned tra(LAS unsigned char* base, unsigned R0, unsigned c32, unsigned lane) {
    const unsigned blk = (lane >> 4) & 1u, q = (lane & 15u) >> 2, p = lane & 3u;
    return (unsigned)(size_t)base + img_off(R0 + q, 4u * c32 + 2u * blk + (p >> 1)) + 8u * (p & 1u);
}
__device__ __forceinline__ void tr_read4(const unsigned (&a)[4], s16x4 (&r)[4]) {
    asm volatile("ds_read_b64_tr_b16 %0, %4\n\tds_read_b64_tr_b16 %1, %5\n\tds_read_b64_tr_b16 %2, %6\n\tds_read_b64_tr_b16 %3, %7\n\ts_waitcnt lgkmcnt(0)"
                 : "=&v"(r[0]), "=&v"(r[1]), "=&v"(r[2]), "=&v"(r[3]) : "v"(a[0]), "v"(a[1]), "v"(a[2]), "v"(a[3]) : "memory");
}
template <int OFF>
__device__ __forceinline__ void tr_read10(const unsigned (&a)[10], s16x4 (&r)[10]) {
    asm volatile("ds_read_b64_tr_b16 %0, %10 offset:%20\n\tds_read_b64_tr_b16 %1, %11 offset:%20\n\tds_read_b64_tr_b16 %2, %12 offset:%20\n\tds_read_b64_tr_b16 %3, %13 offset:%20\n\tds_read_b64_tr_b16 %4, %14 offset:%20\n\t"
                 "ds_read_b64_tr_b16 %5, %15 offset:%20\n\tds_read_b64_tr_b16 %6, %16 offset:%20\n\tds_read_b64_tr_b16 %7, %17 offset:%20\n\tds_read_b64_tr_b16 %8, %18 offset:%20\n\tds_read_b64_tr_b16 %9, %19 offset:%20\n\ts_waitcnt lgkmcnt(0)"
                 : "=&v"(r[0]), "=&v"(r[1]), "=&v"(r[2]), "=&v"(r[3]), "=&v"(r[4]), "=&v"(r[5]), "=&v"(r[6]), "=&v"(r[7]), "=&v"(r[8]), "=&v"(r[9])
                 : "v"(a[0]), "v"(a[1]), "v"(a[2]), "v"(a[3]), "v"(a[4]), "v"(a[5]), "v"(a[6]), "v"(a[7]), "v"(a[8]), "v"(a[9]), "n"(OFF) : "memory");
}
template <int OFF>
__device__ __forceinline__ void tr_read6(const unsigned (&a)[6], s16x4 (&r)[6]) {
    asm volatile("ds_read_b64_tr_b16 %0, %6 offset:%12\n\tds_read_b64_tr_b16 %1, %7 offset:%12\n\tds_read_b64_tr_b16 %2, %8 offset:%12\n\tds_read_b64_tr_b16 %3, %9 offset:%12\n\tds_read_b64_tr_b16 %4, %10 offset:%12\n\t"
                 "ds_read_b64_tr_b16 %5, %11 offset:%12\n\ts_waitcnt lgkmcnt(0)"
                 : "=&v"(r[0]), "=&v"(r[1]), "=&v"(r[2]), "=&v"(r[3]), "=&v"(r[4]), "=&v"(r[5])
                 : "v"(a[0]), "v"(a[1]), "v"(a[2]), "v"(a[3]), "v"(a[4]), "v"(a[5]), "n"(OFF) : "memory");
}
__device__ __forceinline__ int crow(int reg, int h) { return (reg & 3) + 8 * (reg >> 2) + 4 * h; }
__device__ __forceinline__ s16x8 permrd(LAS unsigned char* base, unsigned row, int i, int s2, int h) {
    const s16x4 a = *(const LAS s16x4*)(base + img_off(row, 4 * i + 2 * s2) + 8 * h), b = *(const LAS s16x4*)(base + img_off(row, 4 * i + 2 * s2 + 1) + 8 * h);
    return cat8(a, b);
}
__device__ __forceinline__ s16x8 packacc(const f32x16& x, int s2) {
    f32x8 e;
#pragma unroll
    for (int i = 0; i < 8; ++i) e[i] = x[8 * s2 + i];
    return __builtin_bit_cast(s16x8, __builtin_convertvector(e, bf16v8));
}
#define GLDS16(src, dst) __builtin_amdgcn_global_load_lds((const unsigned*)(src), (LAS unsigned*)(dst), 16, 0, 0)
#define GLDS16NT(src, dst) __builtin_amdgcn_global_load_lds((const unsigned*)(src), (LAS unsigned*)(dst), 16, 0, 2)
template <bool NT = false>
__device__ __forceinline__ void stage_tile(const bf16_t* X, size_t m0, int mh, LAS unsigned char* dst, int tid, int wave) {
#pragma unroll
    for (int i = 0; i < 2; ++i) { const unsigned pc = tid + 512 * i, row = pc >> 4, chp = pc & 15u, ch = chp ^ (((row & 3u) << 2) | ((row >> 2) & 3u));
        if (NT) GLDS16NT(X + (m0 + row) * DM + mh * 128 + ch * 8, dst + wave * 1024 + i * 8192); else GLDS16(X + (m0 + row) * DM + mh * 128 + ch * 8, dst + wave * 1024 + i * 8192); }
}
__device__ __forceinline__ void state_update(f32x16 (&S)[4], LAS unsigned char* Kb, LAS unsigned char* Vb, const LAS float* dec, int cb, int h, int lane) {
    unsigned ad[10];
    ad[0] = tra(Vb, 8 * h, cb, lane); ad[1] = tra(Vb, 8 * h + 4, cb, lane);
#pragma unroll
    for (int i = 0; i < 4; ++i) { ad[2 + 2 * i] = tra(Kb, 8 * h, i, lane); ad[3 + 2 * i] = tra(Kb, 8 * h + 4, i, lane); }
#define SU_STEP(kk) do { s16x4 rr[10]; tr_read10<4096 * (kk)>(ad, rr); const s16x8 vb = cat8(rr[0], rr[1]); \
        _Pragma("unroll") for (int i = 0; i < 4; ++i) S[i] = MFMA32(cat8(rr[2 + 2 * i], rr[3 + 2 * i]), vb, S[i]); } while (0)
    SU_STEP(0); SU_STEP(1); SU_STEP(2); SU_STEP(3);
#undef SU_STEP
#pragma unroll
    for (int i = 0; i < 4; ++i)
#pragma unroll
        for (int g = 0; g < 4; ++g) { const f32x4 d = *(const LAS f32x4*)(dec + 32 * i + 8 * g + 4 * h);
#pragma unroll
            for (int j = 0; j < 4; ++j) S[i][4 * g + j] *= d[j]; }
}

__device__ __forceinline__ void state_update_half(f32x16 (&S)[2], LAS unsigned char* Kb, LAS unsigned char* Vb, const LAS float* dec, int cb, int h, int lane, int i0) {
    unsigned ad[6];
    ad[0] = tra(Vb, 8 * h, cb, lane); ad[1] = tra(Vb, 8 * h + 4, cb, lane);
#pragma unroll
    for (int i = 0; i < 2; ++i) { ad[2 + 2 * i] = tra(Kb, 8 * h, i0 + i, lane); ad[3 + 2 * i] = tra(Kb, 8 * h + 4, i0 + i, lane); }
#define SU_STEP(kk) do { s16x4 rr[6]; tr_read6<4096 * (kk)>(ad, rr); const s16x8 vb = cat8(rr[0], rr[1]); \
        _Pragma("unroll") for (int i = 0; i < 2; ++i) S[i] = MFMA32(cat8(rr[2 + 2 * i], rr[3 + 2 * i]), vb, S[i]); } while (0)
    SU_STEP(0); SU_STEP(1); SU_STEP(2); SU_STEP(3);
#undef SU_STEP
#pragma unroll
    for (int i = 0; i < 2; ++i)
#pragma unroll
        for (int g = 0; g < 4; ++g) { const f32x4 d = *(const LAS f32x4*)(dec + 32 * (i0 + i) + 8 * g + 4 * h);
#pragma unroll
            for (int j = 0; j < 4; ++j) S[i][4 * g + j] *= d[j]; }
}

__device__ __forceinline__ void pass_a(const Ptrs& p, const Frame& F, int item, int b, int mh, int seg) {
    LAS unsigned char* lds = F.lds;
    const int tid = F.tid, lane = F.lane, wave = F.wave, h = lane >> 5, rb = wave >> 2, cb = wave & 3;
    const bf16_t* KI = (const bf16_t*)(p.ws + WS_KI); const bf16_t* V = (const bf16_t*)(p.ws + WS_V); const float* DEC = (const float*)(p.ws + WS_DEC);
    const int dcol = mh * 128;
    const int c0 = seg * SEGC;
    f32x16 S[2];
#pragma unroll
    for (int i = 0; i < 2; ++i)
#pragma unroll
        for (int k = 0; k < 16; ++k) S[i][k] = 0.f;
#define STAGE_A(n, slot) do { const size_t m0_ = (size_t)b * NS + (size_t)(n) * 64; stage_tile<true>(KI, m0_, mh, lds + (slot) * 32768, tid, wave); stage_tile<true>(V, m0_, mh, lds + (slot) * 32768 + 16384, tid, wave); \
        if (lane < 32) GLDS16(DEC + ((size_t)b * 64 + (n)) * 1024 + dcol + lane * 4, lds + DECA_OFF + ((slot) * 8 + wave) * 512); } while (0)
    STAGE_A(c0, 0); STAGE_A(c0 + 1, 1); STAGE_A(c0 + 2, 2);
    float dprod = 1.f;
    for (int it = 0; it < SEGC; ++it) {
        const int slot = it & 3;
        asm volatile("s_waitcnt vmcnt(10)" ::: "memory");
        __builtin_amdgcn_s_barrier(); asm volatile("" ::: "memory");
        { const int n2 = it + 3 < SEGC ? it + 3 : SEGC - 1; STAGE_A(c0 + n2, (it + 3) & 3); }
        state_update_half(S, lds + slot * 32768, lds + slot * 32768 + 16384, (const LAS float*)(lds + DECA_OFF + (slot * 8 + wave) * 512), cb, h, lane, 2 * rb);
        if (tid < 128) dprod *= ((const LAS float*)(lds + DECA_OFF + (slot * 8 + wave) * 512))[tid];
        asm volatile("s_waitcnt lgkmcnt(0)" ::: "memory");
    }
#undef STAGE_A
    asm volatile("s_waitcnt vmcnt(0)" ::: "memory");
    __syncthreads();
    if (tid < 128) ((float*)(p.ws + WS_DPR))[(size_t)item * 128 + tid] = dprod;
    { f32x4* dst = (f32x4*)((float*)(p.ws + WS_LST) + ((size_t)item * 4 + cb) * 4096) + lane;
#pragma unroll
        for (int i = 0; i < 2; ++i)
#pragma unroll
            for (int g = 0; g < 4; ++g) dst[((2 * rb + i) * 4 + g) * 64] = (f32x4){S[i][4 * g], S[i][4 * g + 1], S[i][4 * g + 2], S[i][4 * g + 3]}; }
}

__device__ __forceinline__ void pass_b(const Ptrs& p, const Frame& F, int item, int b, int mh, int seg) {
    LAS unsigned char* lds = F.lds;
    const int tid = F.tid, lane = F.lane, wave = F.wave, r = lane & 31, h = lane >> 5, role = wave >> 2, cb = wave & 3;
    const bf16_t* QI = (const bf16_t*)(p.ws + WS_QI); const bf16_t* KI = (const bf16_t*)(p.ws + WS_KI); const bf16_t* V = (const bf16_t*)(p.ws + WS_V); const bf16_t* Gp = (const bf16_t*)(p.ws + WS_G);
    bf16_t* Op = (bf16_t*)(p.ws + WS_G); const float* DEC = (const float*)(p.ws + WS_DEC);
    const bool hg = mh < 4; const int dcol = mh * 128;
    const float* nwp = hg ? p.hgrn_nw + mh * 128 : p.ret_nw + (mh - 4) * 128;
    const int c0 = seg * SEGC;
#define STAGE_B(n, buf) do { const size_t m0_ = (size_t)b * NS + (size_t)(n) * 64; LAS unsigned char* d_ = lds + (buf) * 65536; \
        stage_tile<true>(QI, m0_, mh, d_, tid, wave); stage_tile<true>(KI, m0_, mh, d_ + 16384, tid, wave); stage_tile<true>(V, m0_, mh, d_ + 32768, tid, wave); stage_tile<true>(Gp, m0_, mh, d_ + 49152, tid, wave); \
        if (wave == 0) GLDS16(DEC + ((size_t)b * 64 + (n)) * 1024 + dcol + (lane & 31) * 4, lds + DECB_OFF + (buf) * 1024); } while (0)
#define STAGE_T(X, off, n, buf) do { const size_t m0_ = (size_t)b * NS + (size_t)(n) * 64; stage_tile<true>(X, m0_, mh, lds + (buf) * 65536 + (off), tid, wave); } while (0)
#define STAGE_D(n, buf) do { if (wave == 0) GLDS16(DEC + ((size_t)b * 64 + (n)) * 1024 + dcol + (lane & 31) * 4, lds + DECB_OFF + (buf) * 1024); } while (0)
    STAGE_B(c0, 0);
    f32x16 S[4];
#pragma unroll
    for (int i = 0; i < 4; ++i)
#pragma unroll
        for (int k = 0; k < 16; ++k) S[i][k] = 0.f;
    if (role == 0)
    for (int j = 0; j < seg; ++j) {
        const int itj = item - seg + j; const f32x4* L = (const f32x4*)((const float*)(p.ws + WS_LST) + ((size_t)itj * 4 + cb) * 4096) + lane; const float* dp = (const float*)(p.ws + WS_DPR) + (size_t)itj * 128;
#pragma unroll
        for (int i = 0; i < 4; ++i)
#pragma unroll
            for (int g = 0; g < 4; ++g) { const f32x4 d = *(const f32x4*)(dp + 32 * i + 8 * g + 4 * h); const f32x4 lv = L[(i * 4 + g) * 64];
#pragma unroll
                for (int k = 0; k < 4; ++k) S[i][4 * g + k] = d[k] * S[i][4 * g + k] + lv[k]; }
    }
    LAS float* NW = (LAS float*)(lds + NW_OFF);
    if (tid < 128) NW[tid] = nwp[tid];
    __syncthreads();
    STAGE_B(c0 + 1, 1);
    for (int it = 0; it < SEGC; ++it) {
        const int n = c0 + it, cur = it & 1;
        const size_t m0 = (size_t)b * NS + (size_t)n * 64;
        const bool more = it >= 1 && it + 1 < SEGC;
        if (more) STAGE_T(KI, 16384, n + 1, cur ^ 1);
        LAS unsigned char* Qb = lds + cur * 65536; LAS unsigned char* Kb = Qb + 16384; LAS unsigned char* Vb = Qb + 32768; LAS unsigned char* Gb = Qb + 49152;
        f32x16 own, snd;
#pragma unroll
        for (int k = 0; k < 16; ++k) { own[k] = 0.f; snd[k] = 0.f; }
        if (role == 0) {
#pragma unroll
            for (int tb = 0; tb < 2; ++tb) { s16x8 qf[4][2];
#pragma unroll
                for (int i = 0; i < 4; ++i)
#pragma unroll
                    for (int s2 = 0; s2 < 2; ++s2) qf[i][s2] = permrd(Qb, 32 * tb + r, i, s2, h);
#pragma unroll
                for (int i = 0; i < 4; ++i)
#pragma unroll
                    for (int s2 = 0; s2 < 2; ++s2) { if (tb == 0) own = MFMA32(packacc(S[i], s2), qf[i][s2], own); else snd = MFMA32(packacc(S[i], s2), qf[i][s2], snd); } }
            if (more) STAGE_T(V, 32768, n + 1, cur ^ 1);
            state_update(S, Kb, Vb, (const LAS float*)(lds + DECB_OFF + cur * 1024), cb, h, lane);
        } else {
            s16x8 qf[4][2], kf[4][2];
#pragma unroll
            for (int blk = 0; blk < 3; ++blk) { const int sb = blk == 2 ? 1 : 0, tb = blk == 0 ? 0 : 1;
                if (blk != 2) {
#pragma unroll
                    for (int i = 0; i < 4; ++i)
#pragma unroll
                        for (int s2 = 0; s2 < 2; ++s2) qf[i][s2] = permrd(Qb, 32 * tb + r, i, s2, h); }
                if (blk == 1 && more) STAGE_T(V, 32768, n + 1, cur ^ 1);
                if (blk != 1) {
#pragma unroll
                    for (int i = 0; i < 4; ++i)
#pragma unroll
                        for (int s2 = 0; s2 < 2; ++s2) kf[i][s2] = permrd(Kb, 32 * sb + r, i, s2, h); }
                f32x16 x;
#pragma unroll
                for (int k = 0; k < 16; ++k) x[k] = 0.f;
#pragma unroll
                for (int i = 0; i < 4; ++i)
#pragma unroll
                    for (int s2 = 0; s2 < 2; ++s2) x = MFMA32(kf[i][s2], qf[i][s2], x);
                if (sb == tb) {
#pragma unroll
                    for (int k = 0; k < 16; ++k) x[k] = (r >= crow(k, h)) ? x[k] : 0.f;
                }
                { unsigned ad[4]; s16x4 rr[4];
#pragma unroll
                  for (int s2 = 0; s2 < 2; ++s2) { ad[2 * s2] = tra(Vb, 32 * sb + 16 * s2 + 4 * h, cb, lane); ad[2 * s2 + 1] = tra(Vb, 32 * sb + 16 * s2 + 8 + 4 * h, cb, lane); }
                  tr_read4(ad, rr);
#pragma unroll
                  for (int s2 = 0; s2 < 2; ++s2) { if (tb == 0) snd = MFMA32(cat8(rr[2 * s2], rr[2 * s2 + 1]), packacc(x, s2), snd); else own = MFMA32(cat8(rr[2 * s2], rr[2 * s2 + 1]), packacc(x, s2), own); } }
            }
        }
        if (more) STAGE_T(Gp, 49152, n + 1, cur ^ 1);
        { LAS u32x4* xw = (LAS u32x4*)(lds + XCH_OFF + wave * 2048 + lane * 32);
          const s16x8 p0 = packacc(snd, 0), p1 = packacc(snd, 1);
          xw[0] = __builtin_bit_cast(u32x4, p0); xw[1] = __builtin_bit_cast(u32x4, p1); }
        u32x2 gv[4];
#pragma unroll
        for (int g = 0; g < 4; ++g) gv[g] = *(const LAS u32x2*)(Gb + img_off(32 * role + r, 4 * cb + g) + 8 * h);
        asm volatile("s_waitcnt lgkmcnt(0)" ::: "memory"); __builtin_amdgcn_s_barrier(); asm volatile("" ::: "memory");
        { const LAS u32x4* xr = (const LAS u32x4*)(lds + XCH_OFF + (wave ^ 4) * 2048 + lane * 32);
          const u32x4 q0 = xr[0], q1 = xr[1];
#pragma unroll
          for (int k = 0; k < 4; ++k) { own[2 * k] += __builtin_bit_cast(float, q0[k] << 16); own[2 * k + 1] += __builtin_bit_cast(float, q0[k] & 0xffff0000u);
                                        own[8 + 2 * k] += __builtin_bit_cast(float, q1[k] << 16); own[9 + 2 * k] += __builtin_bit_cast(float, q1[k] & 0xffff0000u); } }
        float s1 = 0.f, s2v = 0.f;
#pragma unroll
        for (int k = 0; k < 16; ++k) { s1 += own[k]; s2v += own[k] * own[k]; }
        s1 += __shfl_xor(s1, 32); s2v += __shfl_xor(s2v, 32);
        LAS f32x2* PART = (LAS f32x2*)(lds + PART_OFF + cur * 2048);
        if (h == 0) PART[(32 * role + r) * 4 + cb] = (f32x2){s1, s2v};
        __syncthreads();
        if (it + 2 < SEGC) { STAGE_T(QI, 0, n + 2, cur); STAGE_D(n + 2, cur); }
        { const f32x2 p0 = PART[(32 * role + r) * 4 + 0], p1 = PART[(32 * role + r) * 4 + 1], p2 = PART[(32 * role + r) * 4 + 2], p3 = PART[(32 * role + r) * 4 + 3];
          const float t1 = (p0.x + p1.x) + (p2.x + p3.x), t2 = (p0.y + p1.y) + (p2.y + p3.y);
          float mu = 0.f, rstd;
          if (hg) rstd = __builtin_amdgcn_rsqf(t2 * (1.f / 128.f) + LN_EPS);
          else { mu = t1 * (1.f / 128.f); rstd = __builtin_amdgcn_rsqf(fmaxf(t2 * (1.f / 128.f) - mu * mu, 0.f) + LN_EPS); }
          const size_t tok = m0 + 32 * role + r;
          u32x2 pk[4];
#pragma unroll
          for (int g = 0; g < 4; ++g) { f32x4 ov; const f32x4 nwv = *(const LAS f32x4*)(NW + 32 * cb + 8 * g + 4 * h);
              const float g0 = __builtin_bit_cast(float, gv[g].x << 16), g1 = __builtin_bit_cast(float, gv[g].x & 0xffff0000u), g2 = __builtin_bit_cast(float, gv[g].y << 16), g3 = __builtin_bit_cast(float, gv[g].y & 0xffff0000u);
              ov[0] = (own[4 * g + 0] - mu) * rstd * nwv[0] * g0; ov[1] = (own[4 * g + 1] - mu) * rstd * nwv[1] * g1;
              ov[2] = (own[4 * g + 2] - mu) * rstd * nwv[2] * g2; ov[3] = (own[4 * g + 3] - mu) * rstd * nwv[3] * g3;
              pk[g] = __builtin_bit_cast(u32x2, __builtin_convertvector(ov, bf16v4)); }
#pragma unroll
          for (int g = 0; g < 4; g += 2) { u32x2 a = pk[g], b = pk[g + 1];
              asm volatile("s_nop 1\n\tv_permlane32_swap_b32 %0, %1\n\tv_permlane32_swap_b32 %2, %3" : "+v"(a.x), "+v"(b.x), "+v"(a.y), "+v"(b.y));
              *(u32x4*)(Op + tok * DM + mh * 128 + 32 * cb + 8 * g + 8 * h) = (u32x4){a.x, a.y, b.x, b.y}; } }
    }
#undef STAGE_B
#undef STAGE_T
#undef STAGE_D
    __syncthreads();
}
#undef MFMA32
#undef GLDS16
#undef GLDS16NT
}

struct RowRaw { f32x4 x[4]; u32x2 y[4]; };
template <bool LASTUSE = false>
__device__ __forceinline__ void row_load(const Ptrs& p, int m, int lane, RowRaw& r) {
    const f32x4* xr = (const f32x4*)(p.x + (size_t)m * DM) + lane; const u32x2* yr = (const u32x2*)((const bf16_t*)(p.ws + WS_Y1) + (size_t)m * DM) + lane;
#pragma unroll
    for (int j = 0; j < 4; ++j) { r.x[j] = __builtin_nontemporal_load(xr + 64 * j); r.y[j] = LASTUSE ? __builtin_nontemporal_load(yr + 64 * j) : yr[64 * j]; }
}
__device__ __forceinline__ void row_u(const RowRaw& r, const float* mod, int b, int lane, f32x4 (&v)[4]) {
    const f32x4* g1 = (const f32x4*)(mod + b * 6144 + 2048) + lane;
#pragma unroll
    for (int j = 0; j < 4; ++j) { const f32x4 y = (f32x4){__builtin_bit_cast(float, r.y[j].x << 16), __builtin_bit_cast(float, r.y[j].x & 0xffff0000u), __builtin_bit_cast(float, r.y[j].y << 16), __builtin_bit_cast(float, r.y[j].y & 0xffff0000u)};
        v[j] = r.x[j] * DN_ALPHA + g1[64 * j] * y; }
}
__device__ __forceinline__ void p5_route(const Ptrs& p, const Frame& F, const bool xl) {
    LAS float* WL = (LAS float*)F.lds;
    { f32x4 t[18];
#pragma unroll
      for (int k = 0; k < 18; ++k) { const int i = F.tid + 512 * k, col = i / 9, q = i - col * 9; t[k] = q == 0 ? *(const f32x4*)(p.w_rg + col * 4) : *(const f32x4*)(p.w_re + col * 32 + 4 * (q - 1)); }
#pragma unroll
      for (int k = 0; k < 18; ++k) { const int i = F.tid + 512 * k, col = i / 9, q = i - col * 9; const int pos = ((col >> 2) & 63) + 64 * (4 * (col >> 8) + (col & 3)); *(LAS f32x4*)(WL + pos * 36 + 4 * q) = t[k]; } }
    LAS f32x4* PL = (LAS f32x4*)(F.lds + 147456);
    { int t_ = F.tid; asm volatile("" : "+v"(t_)); PL[t_] = t_ < 256 ? ((const f32x4*)p.ln1w)[t_] : ((const f32x4*)p.ln1b)[t_ - 256]; }
    const float* mod = (const float*)(p.ws + WS_MOD); unsigned char* hb = p.ws + WS_H2;
    f32x4 g1r[4], sclr[4]; int curb = -1;
    int* cnt = (int*)(p.ws + WS_CTL) + CW_CNT; int* list = (int*)(p.ws + WS_LIST);
    int* re = (int*)(p.ws + WS_ROUTE); int* rp = re + 2 * MTOK; float* rg = (float*)(rp + 2 * MTOK);
    const int lane = F.lane, gw = xl ? (F.vcu >> 5) * NS + (F.vcu & 31) * NWAVES + F.wave : F.vcu * NWAVES + F.wave, NGW = xl ? 32 * NWAVES : F.G * NWAVES, mlim = xl ? ((F.vcu >> 5) + 1) * NS : MTOK;
    const float brg[4] = {p.b_rg[0], p.b_rg[1], p.b_rg[2], p.b_rg[3]};
    LAS int* lcnt = (LAS int*)(F.lds + TAB_OFF + 512); LAS int* lbase = lcnt + 32; LAS int* recm = lbase + 32;
    LAS float* lbre = (LAS float*)(recm + 512);
    if (F.tid < NEXP) lbre[F.tid] = p.b_re[F.tid];
#define RED_ALL2(arr, N) do { \
        _Pragma("unroll") for (int r_ = 0; r_ < 2; ++r_) _Pragma("unroll") for (int i_ = 0; i_ < N; ++i_) arr[r_][i_] += dppf<0x111, 0xf, 0xf, true>(arr[r_][i_]); \
        _Pragma("unroll") for (int r_ = 0; r_ < 2; ++r_) _Pragma("unroll") for (int i_ = 0; i_ < N; ++i_) arr[r_][i_] += dppf<0x112, 0xf, 0xf, true>(arr[r_][i_]); \
        _Pragma("unroll") for (int r_ = 0; r_ < 2; ++r_) _Pragma("unroll") for (int i_ = 0; i_ < N; ++i_) arr[r_][i_] += dppf<0x114, 0xf, 0xf, true>(arr[r_][i_]); \
        _Pragma("unroll") for (int r_ = 0; r_ < 2; ++r_) _Pragma("unroll") for (int i_ = 0; i_ < N; ++i_) arr[r_][i_] += dppf<0x118, 0xf, 0xf, true>(arr[r_][i_]); \
        _Pragma("unroll") for (int r_ = 0; r_ < 2; ++r_) _Pragma("unroll") for (int i_ = 0; i_ < N; ++i_) arr[r_][i_] += dppf<0x142, 0xa, 0xf, false>(arr[r_][i_]); \
        _Pragma("unroll") for (int r_ = 0; r_ < 2; ++r_) _Pragma("unroll") for (int i_ = 0; i_ < N; ++i_) arr[r_][i_] += dppf<0x143, 0xc, 0xf, false>(arr[r_][i_]); } while (0)
    for (int mb = 0; mb < (xl ? NS : MTOK); mb += NGW * 16) {
    for (int i = F.tid; i < 64 + 128 * 4; i += 512) lcnt[i] = i < 64 ? 0 : -1;
    __syncthreads();
    RowRaw rnA[2], rnB[2];
#pragma unroll
    for (int r = 0; r < 2; ++r) { const int mm = mb + gw + ((xl ? 14 : 0) + r) * NGW; if (mm < mlim) row_load<true>(p, mm, lane, rnA[r]); }
    auto body = [&](const int it, RowRaw (&rn)[2], RowRaw (&rnx)[2]) -> bool {
        const int m = mb + gw + 2 * (xl ? 7 - it : it) * NGW;
        if (m >= mlim) return false;
        int mmr[2]; bool ok[2];
#pragma unroll
        for (int r = 0; r < 2; ++r) { mmr[r] = m + r * NGW; ok[r] = mmr[r] < mlim; if (!ok[r]) mmr[r] = m; }
        f32x4 v[2][4];
        { const int b = mmr[0] / NS;
          if (b != curb) { curb = b;
#pragma unroll
              for (int j = 0; j < 4; ++j) { g1r[j] = ((const f32x4*)(mod + b * 6144 + 2048))[lane + 64 * j]; sclr[j] = ((const f32x4*)(mod + b * 6144 + 4096))[lane + 64 * j] + 1.f; }
#pragma unroll
              for (int j = 0; j < 4; ++j) { asm volatile("" : "+v"(g1r[j])); asm volatile("" : "+v"(sclr[j])); } } }
#pragma unroll
        for (int r = 0; r < 2; ++r)
#pragma unroll
            for (int j = 0; j < 4; ++j) { const u32x2 yy = rn[r].y[j]; const f32x4 y = (f32x4){__builtin_bit_cast(float, yy.x << 16), __builtin_bit_cast(float, yy.x & 0xffff0000u), __builtin_bit_cast(float, yy.y << 16), __builtin_bit_cast(float, yy.y & 0xffff0000u)};
                v[r][j] = rn[r].x[j] * DN_ALPHA + g1r[j] * y; }
        if (it < 7) {
#pragma unroll
            for (int r = 0; r < 2; ++r) { const int mn = xl ? m + (r - 2) * NGW : m + (2 + r) * NGW; if (mn < mlim) row_load<true>(p, mn, lane, rnx[r]); } }
        float mean[2], rstd[2], sq[2];
#pragma unroll
        for (int r = 0; r < 2; ++r) sq[r] = hsum4((v[r][0] + v[r][1]) + (v[r][2] + v[r][3]));
#pragma unroll
        for (int r = 0; r < 2; ++r) mean[r] = wsum(sq[r]) * (1.f / DM);
#pragma unroll
        for (int r = 0; r < 2; ++r) { sq[r] = 0.f;
#pragma unroll
            for (int j = 0; j < 4; ++j) v[r][j] = v[r][j] - mean[r];
            sq[r] = hsum4((v[r][0] * v[r][0] + v[r][1] * v[r][1]) + (v[r][2] * v[r][2] + v[r][3] * v[r][3])); }
#pragma unroll
        for (int r = 0; r < 2; ++r) rstd[r] = __builtin_amdgcn_rsqf(wsum(sq[r]) * (1.f / DM) + LN_EPS);
#pragma unroll
        for (int r = 0; r < 2; ++r) { sq[r] = 0.f;
#pragma unroll
            for (int j = 0; j < 4; ++j) { v[r][j] = v[r][j] * rstd[r] * PL[lane + 64 * j] + PL[256 + lane + 64 * j];
#ifdef X1BF16
                if (ok[r]) __builtin_nontemporal_store((u32x2){cvt_pk_bf16(v[r][j].x, v[r][j].y), cvt_pk_bf16(v[r][j].z, v[r][j].w)}, (u32x2*)((bf16_t*)(p.ws + WS_U) + (size_t)mmr[r] * DM) + lane + 64 * j);
#endif
            }
            sq[r] = hsum4((v[r][0] + v[r][1]) + (v[r][2] + v[r][3])); }
#pragma unroll
        for (int r = 0; r < 2; ++r) mean[r] = wsum(sq[r]) * (1.f / DM);
#pragma unroll
        for (int r = 0; r < 2; ++r) { sq[r] = 0.f;
#pragma unroll
            for (int j = 0; j < 4; ++j) v[r][j] = v[r][j] - mean[r];
            sq[r] = hsum4((v[r][0] * v[r][0] + v[r][1] * v[r][1]) + (v[r][2] * v[r][2] + v[r][3] * v[r][3])); }
#pragma unroll
        for (int r = 0; r < 2; ++r) rstd[r] = __builtin_amdgcn_rsqf(wsum(sq[r]) * (1.f / DM) + LN_EPS);
        f32x4 shv[4];
        { const f32x4* sh = (const f32x4*)(mod + (mmr[0] / NS) * 6144 + 3072) + lane;
#pragma unroll
          for (int j = 0; j < 4; ++j) shv[j] = sh[64 * j]; }
#pragma unroll
        for (int r = 0; r < 2; ++r) {
            unsigned* o8 = (unsigned*)((unsigned char*)hb + (size_t)mmr[r] * DM) + lane;
#pragma unroll
            for (int j = 0; j < 4; ++j) { const f32x4 hv = v[r][j] * rstd[r] * sclr[j] + shv[j]; v[r][j] = hv;
                int w = 0; w = __builtin_amdgcn_cvt_pk_fp8_f32(hv.x, hv.y, w, false); w = __builtin_amdgcn_cvt_pk_fp8_f32(hv.z, hv.w, w, true); if (ok[r]) o8[64 * j] = (unsigned)w; } }
        f32x4 gacc[2] = {(f32x4){0.f, 0.f, 0.f, 0.f}, (f32x4){0.f, 0.f, 0.f, 0.f}};
#pragma unroll
        for (int j = 0; j < 4; ++j)
#pragma unroll
            for (int c = 0; c < 4; ++c) { const f32x4 w = *(const LAS f32x4*)(WL + (lane + 64 * (4 * j + c)) * 36); gacc[0] += w * v[0][j][c]; gacc[1] += w * v[1][j][c]; }
        float gp[2][4];
#pragma unroll
        for (int r = 0; r < 2; ++r)
#pragma unroll
            for (int c = 0; c < 4; ++c) gp[r][c] = gacc[r][c];
        RED_ALL2(gp, 4);
        int gs[2]; float pstar[2];
#pragma unroll
        for (int r = 0; r < 2; ++r) { const float g0 = rdlane(gp[r][0], 63) + brg[0], g1 = rdlane(gp[r][1], 63) + brg[1], g2 = rdlane(gp[r][2], 63) + brg[2], g3 = rdlane(gp[r][3], 63) + brg[3];
            int g = 0; float gmax = g0;
            if (g1 > gmax) { gmax = g1; g = 1; } if (g2 > gmax) { gmax = g2; g = 2; } if (g3 > gmax) { gmax = g3; g = 3; }
            gs[r] = g; pstar[r] = __builtin_amdgcn_rcpf(__expf(g0 - gmax) + __expf(g1 - gmax) + __expf(g2 - gmax) + __expf(g3 - gmax)); }
        float ev[2][8];
#pragma unroll
        for (int r = 0; r < 2; ++r) { f32x4 e0 = (f32x4){0.f, 0.f, 0.f, 0.f}, e1 = e0; const LAS float* wg = WL + 4 + 8 * gs[r];
#pragma unroll
            for (int j = 0; j < 4; ++j)
#pragma unroll
                for (int c = 0; c < 4; ++c) { const LAS f32x4* wr = (const LAS f32x4*)(wg + (lane + 64 * (4 * j + c)) * 36); e0 += wr[0] * v[r][j][c]; e1 += wr[1] * v[r][j][c]; }
#pragma unroll
            for (int c = 0; c < 4; ++c) { ev[r][c] = e0[c]; ev[r][4 + c] = e1[c]; } }
        RED_ALL2(ev, 8);
#pragma unroll
        for (int r = 0; r < 2; ++r) {
            float el[8];
#pragma unroll
            for (int e = 0; e < 8; ++e) el[e] = rdlane(ev[r][e], 63) + lbre[gs[r] * 8 + e];
            int i1 = 0; float v1 = el[0];
#pragma unroll
            for (int e = 1; e < 8; ++e) if (el[e] > v1) { v1 = el[e]; i1 = e; }
            int i2 = -1; float v2 = -3.0e38f;
#pragma unroll
            for (int e = 0; e < 8; ++e) if (e != i1 && el[e] > v2) { v2 = el[e]; i2 = e; }
            if (lane == 0 && ok[r]) {
                const int mm = mmr[r], ri = (2 * it + r) * 8 + F.wave;
                const float w1 = __builtin_amdgcn_rcpf(1.f + __expf(v2 - v1));
                const int e1 = gs[r] * 8 + i1, e2 = gs[r] * 8 + i2;
                const int l1 = __hip_atomic_fetch_add(lcnt + e1, 1, __ATOMIC_RELAXED, __HIP_MEMORY_SCOPE_WORKGROUP), l2 = __hip_atomic_fetch_add(lcnt + e2, 1, __ATOMIC_RELAXED, __HIP_MEMORY_SCOPE_WORKGROUP);
                recm[ri * 4 + 0] = mm; recm[ri * 4 + 1] = (e1 << 16) | e2; recm[ri * 4 + 2] = l1; recm[ri * 4 + 3] = l2;
                re[mm] = e1; re[MTOK + mm] = e2; rg[mm] = pstar[r] * w1; rg[MTOK + mm] = pstar[r] * (1.f - w1);
            }
        }
        return true;
    };
    for (int it = 0; it < 8; it += 2) { if (!body(it, rnA, rnB)) break; if (!body(it + 1, rnB, rnA)) break; }
    __syncthreads();
    if (F.tid < NEXP) { const int c = lcnt[F.tid]; lbase[F.tid] = c ? atomicAdd(&cnt[64 * F.tid], c) : 0; }
    __syncthreads();
    for (int i = F.tid; i < 128; i += 512) { const int mm = recm[i * 4 + 0], ee = recm[i * 4 + 1], e1 = ee >> 16, e2 = ee & 0xffff;
        if (mm >= 0) { const int p1 = lbase[e1] + recm[i * 4 + 2], p2 = lbase[e2] + recm[i * 4 + 3];
            list[e1 * MTOK + p1] = mm; list[e2 * MTOK + p2] = mm; rp[mm] = p1; rp[MTOK + mm] = p2; } }
    __syncthreads();
    }
#undef RED_ALL2
}

__device__ __forceinline__ int moe_tables(const Ptrs& p, const Frame& F) {
    LAS int* tab = (LAS int*)(F.lds + TAB_OFF);
    const int* cnt = (const int*)(p.ws + WS_CTL) + CW_CNT;
    if (F.tid < 64) {
        const int e = F.tid & 31; const int c = __hip_atomic_load(cnt + 64 * e, __ATOMIC_RELAXED, __HIP_MEMORY_SCOPE_AGENT); const int tiles = (c + 255) >> 8;
        int incl = tiles;
#pragma unroll
        for (int o = 1; o < 32; o <<= 1) { const int t = __shfl_up(incl, o, 32); if (e >= o) incl += t; }
        if (F.tid < 32) { tab[e] = incl - tiles; tab[40 + e] = (incl - tiles) * 256; tab[80 + e] = c; if (e == 31) tab[120] = incl; } }
    __syncthreads();
    return tab[120];
}


#ifdef MXTEST
typedef int v8i_t __attribute__((ext_vector_type(8)));
__device__ __forceinline__ int mx_a(int i, int k) { return ((i * 3 + k * 5 + (k >> 5)) % 5) - 2; }
__device__ __forceinline__ int mx_b(int k, int j) { return ((k * 7 + j * 2 + (k >> 4)) % 5) - 2; }
__device__ __forceinline__ int mx_kmap(int hyp, int g, int v, int byte) {
    if (hyp == 0) return 32 * g + 4 * v + byte;
    if (hyp == 1) return 64 * (v >> 2) + 16 * g + 4 * (v & 3) + byte;
    return 32 * (v >> 1) + 8 * g + 4 * (v & 1) + byte;
}
__device__ __forceinline__ bool mx_try(int hyp, int lane, int sa, int sb, float mult) {
    const int i = lane & 15, g = lane >> 4;
    v8i_t a, b;
#pragma unroll
    for (int v = 0; v < 8; ++v) {
        int pa = 0, pb = 0;
        pa = __builtin_amdgcn_cvt_pk_fp8_f32((float)mx_a(i, mx_kmap(hyp, g, v, 0)), (float)mx_a(i, mx_kmap(hyp, g, v, 1)), pa, false);
        pa = __builtin_amdgcn_cvt_pk_fp8_f32((float)mx_a(i, mx_kmap(hyp, g, v, 2)), (float)mx_a(i, mx_kmap(hyp, g, v, 3)), pa, true);
        pb = __builtin_amdgcn_cvt_pk_fp8_f32((float)mx_b(mx_kmap(hyp, g, v, 0), i), (float)mx_b(mx_kmap(hyp, g, v, 1), i), pb, false);
        pb = __builtin_amdgcn_cvt_pk_fp8_f32((float)mx_b(mx_kmap(hyp, g, v, 2), i), (float)mx_b(mx_kmap(hyp, g, v, 3), i), pb, true);
        a[v] = pa; b[v] = pb;
    }
    f32x4 c = {0.f, 0.f, 0.f, 0.f};
    c = __builtin_amdgcn_mfma_scale_f32_16x16x128_f8f6f4(a, b, c, 0, 0, 0, sa, 0, sb);
    bool ok = true;
#pragma unroll
    for (int rgi = 0; rgi < 4; ++rgi) { const int row = g * 4 + rgi; int acc = 0;
        for (int k = 0; k < 128; ++k) acc += mx_a(row, k) * mx_b(k, i);
        ok = ok && (c[rgi] == mult * (float)acc); }
    return __all(ok);
}
__device__ __forceinline__ float mx_selftest(int lane) {
    const int one = 0x7F7F7F7F;
    for (int hyp = 0; hyp < 3; ++hyp) {
        if (mx_try(hyp, lane, one, one, 1.f)) {
            const bool sc = mx_try(hyp, lane, 0x81818181, 0x7E7E7E7E, 2.f);
            return (hyp == 0 ? 1.f : hyp == 1 ? 1.25f : 1.5f) + (sc ? 0.f : 0.125f);
        }
    }
    return 2.f;
}
#endif
struct RowMoe { int ya[4], yc[4]; float g1s, g2s; };
template <class SEAM_T>
__device__ __forceinline__ void p8_final(const Ptrs& p, const Frame& F, float* dst, SEAM_T&& seam) {
    const LAS int* tab = (const LAS int*)(F.lds + TAB_OFF);
    const float* mod = (const float*)(p.ws + WS_MOD); const unsigned char* Y = (const unsigned char*)(p.ws + WS_Y);
    const int* re = (const int*)(p.ws + WS_ROUTE); const int* rp = re + 2 * MTOK; const float* rg = (const float*)(rp + 2 * MTOK);
#ifdef HALFCU
    if (F.vcu & 1) return;
    const int lane = F.lane, gw = (F.vcu >> 1) * NWAVES + F.wave, NGW = (F.G >> 1) * NWAVES;
#else
    const int lane = F.lane, gw = F.vcu * NWAVES + F.wave, NGW = F.G * NWAVES;
#endif
#if defined(MXTEST)
    const float tscale = mx_selftest(lane);
#else
    const float tscale = 1.f;
#endif
    RowRaw rn[2]; RowMoe mn[2]; size_t s1n[2], s2n[2]; float g1n[2], g2n[2];
#ifdef X1BF16
#define P8_ROWLOAD(mm_, r) do { const u32x2* xr_ = (const u32x2*)((const bf16_t*)(p.ws + WS_U) + (size_t)(mm_) * DM) + lane; _Pragma("unroll") for (int j = 0; j < 4; ++j) rn[r].y[j] = __builtin_nontemporal_load(xr_ + 64 * j); } while (0)
#else
#define P8_ROWLOAD(mm_, r) row_load<true>(p, mm_, lane, rn[r])
#endif
    int e1r[2], e2r[2], p1r[2], p2r[2]; float g1w[2], g2w[2];
#define P8_ROUTE(mmv, r) do { const int mm_ = (mmv); if (mm_ < MTOK) { e1r[r] = re[mm_]; e2r[r] = re[MTOK + mm_]; p1r[r] = rp[mm_]; p2r[r] = rp[MTOK + mm_]; g1w[r] = rg[mm_]; g2w[r] = rg[MTOK + mm_]; } } while (0)
#define P8_RESOLVE(r) do { s1n[r] = (size_t)(tab[40 + e1r[r]] + p1r[r]); s2n[r] = (size_t)(tab[40 + e2r[r]] + p2r[r]); g1n[r] = g1w[r] * (1.f / 16.f); g2n[r] = g2w[r] * (1.f / 16.f); } while (0)
#define P8_LOAD(mmv, r) do { const int mm_ = (mmv); if (mm_ < MTOK) { P8_RESOLVE(r); P8_ROWLOAD(mm_, r); const unsigned* y1_ = (const unsigned*)(Y + s1n[r] * DM) + lane; const unsigned* y2_ = (const unsigned*)(Y + s2n[r] * DM) + lane; \
        _Pragma("unroll") for (int j = 0; j < 4; ++j) { mn[r].ya[j] = (int)__builtin_nontemporal_load(y1_ + 64 * j); mn[r].yc[j] = (int)__builtin_nontemporal_load(y2_ + 64 * j); } mn[r].g1s = g1n[r]; mn[r].g2s = g2n[r]; } } while (0)
    f32x4 pfv[5]; int t0_ = F.tid; asm volatile("" : "+v"(t0_));
    seam([&]() {
#pragma unroll
        for (int k = 0; k < 5; ++k) { const int i = t0_ + k * (NWAVES * 64); pfv[k] = i < 256 ? ((const f32x4*)p.ln2w)[i] : i < 512 ? ((const f32x4*)p.ln2b)[i - 256] : *(const f32x4*)(mod + ((i - 512) >> 8) * 6144 + 5120 + 4 * ((i - 512) & 255)); }
#pragma unroll
        for (int r = 0; r < 2; ++r) P8_ROUTE(gw + r * NGW, r);
#pragma unroll
        for (int r = 0; r < 2; ++r) { const int mm_ = gw + r * NGW; if (mm_ < MTOK) P8_ROWLOAD(mm_, r); }
    });
    { LAS f32x4* pl = (LAS f32x4*)F.lds;
#pragma unroll
      for (int k = 0; k < 5; ++k) pl[t0_ + k * (NWAVES * 64)] = pfv[k];
      __syncthreads(); }
#pragma unroll
    for (int r = 0; r < 2; ++r) { const int mm_ = gw + r * NGW; if (mm_ < MTOK) { P8_RESOLVE(r); const unsigned* y1_ = (const unsigned*)(Y + s1n[r] * DM) + lane; const unsigned* y2_ = (const unsigned*)(Y + s2n[r] * DM) + lane;
#pragma unroll
        for (int j = 0; j < 4; ++j) { mn[r].ya[j] = (int)__builtin_nontemporal_load(y1_ + 64 * j); mn[r].yc[j] = (int)__builtin_nontemporal_load(y2_ + 64 * j); } mn[r].g1s = g1n[r]; mn[r].g2s = g2n[r]; } }
#pragma unroll
    for (int r = 0; r < 2; ++r) P8_ROUTE(gw + (2 + r) * NGW, r);
    for (int m = gw; m < MTOK; m += 2 * NGW) {
        f32x4 v[2][4]; RowMoe mc[2];
#pragma unroll
        for (int r = 0; r < 2; ++r) { const int mm = m + r * NGW; if (mm < MTOK) {
#ifdef X1BF16
#pragma unroll
            for (int j = 0; j < 4; ++j) v[r][j] = (f32x4){__builtin_bit_cast(float, rn[r].y[j].x << 16), __builtin_bit_cast(float, rn[r].y[j].x & 0xffff0000u), __builtin_bit_cast(float, rn[r].y[j].y << 16), __builtin_bit_cast(float, rn[r].y[j].y & 0xffff0000u)};
#else
            row_u(rn[r], mod, mm / NS, lane, v[r]);
#endif
            mc[r] = mn[r]; } }
#pragma unroll
        for (int r = 0; r < 2; ++r) P8_LOAD(m + (2 + r) * NGW, r);
#pragma unroll
        for (int r = 0; r < 2; ++r) P8_ROUTE(m + (4 + r) * NGW, r);
#pragma unroll
        for (int r = 0; r < 2; ++r) { const int mm = m + r * NGW; if (mm < MTOK) {
            const int b = mm / NS;
            const f32x4* w1 = (const f32x4*)p.ln1w + lane; const f32x4* b1 = (const f32x4*)p.ln1b + lane;
            const LAS f32x4* gm = (const LAS f32x4*)F.lds + 512 + b * 256 + lane;
            float s = 0.f, mean, q, rstd;
#ifndef X1BF16
#pragma unroll
            for (int j = 0; j < 4; ++j) s += (v[r][j].x + v[r][j].y) + (v[r][j].z + v[r][j].w);
            mean = wsum(s) * (1.f / DM); q = 0.f;
#pragma unroll
            for (int j = 0; j < 4; ++j) { v[r][j] = v[r][j] - mean; q += (v[r][j].x * v[r][j].x + v[r][j].y * v[r][j].y) + (v[r][j].z * v[r][j].z + v[r][j].w * v[r][j].w); }
            rstd = __builtin_amdgcn_rsqf(wsum(q) * (1.f / DM) + LN_EPS);
            s = 0.f;
#endif
#pragma unroll
            for (int j = 0; j < 4; ++j) {
#ifdef X1BF16
                const f32x4 x1 = v[r][j];
#else
                const f32x4 x1 = v[r][j] * rstd * w1[64 * j] + b1[64 * j];
#endif
                const int a = mc[r].ya[j], c = mc[r].yc[j];
                const f32x2 a01 = __builtin_amdgcn_cvt_pk_f32_fp8(a, false), a23 = __builtin_amdgcn_cvt_pk_f32_fp8(a, true), c01 = __builtin_amdgcn_cvt_pk_f32_fp8(c, false), c23 = __builtin_amdgcn_cvt_pk_f32_fp8(c, true);
                const float g1s = mc[r].g1s, g2s = mc[r].g2s;
                f32x4 y; y.x = g1s * a01.x + g2s * c01.x; y.y = g1s * a01.y + g2s * c01.y; y.z = g1s * a23.x + g2s * c23.x; y.w = g1s * a23.y + g2s * c23.y;
                v[r][j] = x1 * DN_ALPHA + gm[64 * j] * y; s += (v[r][j].x + v[r][j].y) + (v[r][j].z + v[r][j].w); }
            mean = wsum(s) * (1.f / DM); q = 0.f;
#pragma unroll
            for (int j = 0; j < 4; ++j) { v[r][j] = v[r][j] - mean; q += (v[r][j].x * v[r][j].x + v[r][j].y * v[r][j].y) + (v[r][j].z * v[r][j].z + v[r][j].w * v[r][j].w); }
            rstd = __builtin_amdgcn_rsqf(wsum(q) * (1.f / DM) + LN_EPS);
            const LAS f32x4* w2 = (const LAS f32x4*)F.lds + lane; const LAS f32x4* b2 = w2 + 256;
            f32x4* dr = (f32x4*)(dst + (size_t)mm * DM) + lane;
#pragma unroll
            for (int j = 0; j < 4; ++j) __builtin_nontemporal_store((v[r][j] * rstd * w2[64 * j] + b2[64 * j]) * tscale, dr + 64 * j); } }
    }
#undef P8_ROUTE
#undef P8_LOAD
#undef P8_ROWLOAD
}
__device__ __forceinline__ Ptrs reload_ptrs() {
#if defined(__HIP_DEVICE_COMPILE__)
    typedef const void* cvp_t; typedef __attribute__((address_space(4))) cvp_t kp_t;
    const kp_t* q = (const kp_t*)__builtin_amdgcn_kernarg_segment_ptr();
    asm volatile("" : "+s"(q));
    Ptrs r; cvp_t* d = (cvp_t*)&r;
#pragma unroll
    for (int i = 0; i < (int)(sizeof(Ptrs) / sizeof(void*)); ++i) d[i] = q[i];
    return r;
#else
    return Ptrs{};
#endif
}
__global__ void __launch_bounds__(NWAVES * 64, 2) mega_fwd(Args args) {
    extern __shared__ __attribute__((aligned(16))) unsigned char lds_raw[];
    Frame F; F.lds = (LAS unsigned char*)lds_raw;
    F.tid = threadIdx.x; F.lane = F.tid & 63; F.wave = __builtin_amdgcn_readfirstlane(F.tid >> 6);
    F.G = gridDim.x; { const int bx = blockIdx.x; F.vcu = (F.G % 8 == 0) ? (bx % 8) * (F.G / 8) + bx / 8 : bx; }
    const Ptrs& p = args.p;
    volatile LAS unsigned* MISC = (volatile LAS unsigned*)(F.lds + MISC_OFF);
    for (int u = F.tid; u < 256; u += NWAVES * 64) MISC[u] = 0u;
    __syncthreads();
    unsigned* ctl = (unsigned*)(p.ws + WS_CTL);
    XcdBarrier bar = xcd_barrier_post(ctl + CW_BAR + args.li * XCD_BAR_WORDS, MISC + 8);
    if (F.tid == 0) ctl[CW_XCC + blockIdx.x] = xb_xcc_id() + 1u;
    const int lo = args.ph_lo, hi = args.ph_hi;
#ifdef XBAR
#pragma unroll 1
    for (int xb_ = 0; xb_ < XBAR; ++xb_) xcd_barrier(bar);
#endif
#ifndef PHMASK
#define PHMASK 0x1ff
#endif
#define IN(k) (((PHMASK >> (k)) & 1) && lo <= (k) && (k) < hi)
#define SEAM(k) do { if (IN(k) && IN((k) + 1)) xcd_barrier(bar); } while (0)
#ifndef DUP
#define DUP -1
#endif
#define REPS(k) _Pragma("unroll") for (int rep_ = 0; rep_ < ((DUP) == (k) ? 2 : 1); ++rep_)
#define REPBAR() do { if (rep_) xcd_barrier(bar); } while (0)
#ifdef TSA
#define STAMP(k) do { if (blockIdx.x == 0 && F.tid == 0) ((unsigned long long*)(p.ws + WS_CTL + 65536))[k] = __builtin_amdgcn_s_memrealtime(); } while (0)
#else
#define STAMP(k) do {} while (0)
#endif
    STAMP(0);
#ifdef NPASS
#pragma unroll 1
    for (int pass_ = 0; pass_ < NPASS; ++pass_) {
    if (pass_) { xcd_barrier(bar); if (blockIdx.x == 0 && F.tid < 32) __hip_atomic_store((int*)(p.ws + WS_CTL) + CW_CNT + 64 * F.tid, 0, __ATOMIC_RELAXED, __HIP_MEMORY_SCOPE_AGENT); xcd_barrier(bar); }
#endif
    if (IN(0)) REPS(0) { REPBAR(); const Ptrs p = reload_ptrs(); p0_prologue(p, F); } SEAM(0); STAMP(1);
    { bool okx = lo == 0 && hi == 9 && F.G == 256;
#ifdef NO_XL
      okx = false;
#endif
      for (int t = F.tid; t < F.G; t += NWAVES * 64) { const unsigned a = xb_ld(ctl + CW_XCC + t), b = xb_ld(ctl + CW_XCC + (t & 7)); okx = okx && a != 0u && a == b; }
      if (F.tid == 0) MISC[16] = 1u;
      __syncthreads();
      if (!okx) MISC[16] = 0u;
      __syncthreads(); }
#define XL() (__builtin_amdgcn_readfirstlane((int)MISC[16]) != 0)
#define LSEAM(k) do { if (IN(k) && IN((k) + 1)) { if (XL()) xcd_local_barrier<((k) >= 3)>(ctl + CW_XL + 16 * ((int)blockIdx.x & 7) + (k), 32u); else xcd_barrier(bar); } } while (0)
    if (IN(1)) REPS(1) { REPBAR(); const Ptrs p = reload_ptrs(); p1_h1(p, F, XL()); } LSEAM(1); STAMP(2);

    if (IN(2)) REPS(2) { REPBAR(); const Ptrs p = reload_ptrs();
        pg8::DenseOrder S{(const char*)(p.ws + WS_HB), (const char*)(p.ws + WS_WIN), MTOK / 256, DPROJ / 256, DM, F.G, (int)blockIdx.x};
        pg8::EpiProj E{(bf16_t*)(p.ws + WS_QI), (bf16_t*)(p.ws + WS_KI), (bf16_t*)(p.ws + WS_V), (bf16_t*)(p.ws + WS_G), (float*)(p.ws + WS_DEC), (const float*)(p.ws + WS_LB), (const float*)(p.ws + WS_COS), (const float*)(p.ws + WS_SIN), p.pos};
        pg8::gemm_phase<pg8::EpiProj, pg8::DenseOrder, false>(F.lds, DM, S, E);
    } LSEAM(2); STAMP(3);
    if (IN(3)) REPS(3) { REPBAR(); const Ptrs p = reload_ptrs();
#ifdef NAIVE_MIXER
        p3_mixer_naive(p, F);
#else
        const int item = F.vcu, seg = item & 3, bm = item >> 2, mb = bm >> 3, mmh = bm & 7;
#ifndef MIX_NO_A
        if (item < 256 && seg < mix::NSEG - 1) mix::pass_a(p, F, item, mb, mmh, seg);
#endif
        if (XL()) xcd_local_barrier<false>(ctl + CW_XL + 16 * ((int)blockIdx.x & 7) + 8, 32u); else xcd_barrier(bar);
#ifndef MIX_NO_B
        if (item < 256) mix::pass_b(p, F, item, mb, mmh, seg);
#endif
#endif
    } LSEAM(3); STAMP(4);
    if (IN(4)) REPS(4) { REPBAR(); const Ptrs p = reload_ptrs();
        pg8::DenseOrder S{(const char*)(p.ws + WS_G), (const char*)(p.ws + WS_WOUT), MTOK / 256, DM / 256, DM, F.G, (int)blockIdx.x};
        pg8::EpiResid E{(bf16_t*)(p.ws + WS_Y1)};
        pg8::gemm_phase<pg8::EpiResid, pg8::DenseOrder, false>(F.lds, DM, S, E);
    } LSEAM(4); STAMP(5);
    if (IN(5)) { const Ptrs p = reload_ptrs();
#if DUP == 5
        p5_route(p, F, false); xcd_barrier(bar);
        if (blockIdx.x == 0 && F.tid < 32) __hip_atomic_store((int*)(p.ws + WS_CTL) + CW_CNT + 64 * F.tid, 0, __ATOMIC_RELAXED, __HIP_MEMORY_SCOPE_AGENT);
        xcd_barrier(bar);
#endif
        p5_route(p, F, XL()); } SEAM(5); STAMP(6);
    int nT = 0;
    if (IN(6) || IN(7) || IN(8)) { const Ptrs p = reload_ptrs(); nT = moe_tables(p, F); }
    (void)nT;
    { LAS int* tab = (LAS int*)(F.lds + TAB_OFF); const int NX = (F.G % 8 == 0) ? 8 : 1;
      if (F.tid == 0) {
          const int nTt = tab[120], NWX = F.G / NX, x = (int)blockIdx.x % NX, w = (int)blockIdx.x / NX, lo_ = (x * nTt) / NX, hi_ = ((x + 1) * nTt) / NX, nloc = 4 * (hi_ - lo_);
          const int base6 = nloc / NWX, r6 = nloc % NWX, T = (3 * nloc + NWX - 1) / NWX; int n7lo = T - 2 * (base6 + 1); n7lo = n7lo < 0 ? 0 : n7lo;
          tab[121] = lo_; tab[122] = hi_; tab[123] = r6; tab[124] = n7lo; tab[125] = NWX; tab[126] = w; }
      __syncthreads(); }
    if (IN(6)) REPS(6) { REPBAR(); const Ptrs p = reload_ptrs();
        pg8::MoeOrder S{(const LAS int*)(F.lds + TAB_OFF), true, (const char*)(p.ws + WS_H2), nullptr, (const char*)(p.ws + WS_WGU), (const int*)(p.ws + WS_LIST), nullptr};
        pg8::EpiSwiglu E{(unsigned char*)(p.ws + WS_ACT), (unsigned*)(p.ws + WS_CTL) + CW_DONE};
        pg8::gemm_phase<pg8::EpiSwiglu, pg8::MoeOrder, true, true>(F.lds, DM / 2, S, E);
    } if (!XL()) SEAM(6); STAMP(7);

    if (IN(7)) REPS(7) { REPBAR(); const Ptrs p = reload_ptrs();
        pg8::MoeOrder S{(const LAS int*)(F.lds + TAB_OFF), false, nullptr, (const char*)(p.ws + WS_ACT), (const char*)(p.ws + WS_WDN), nullptr, (unsigned*)(p.ws + WS_CTL) + CW_DONE};
        pg8::EpiY E{(unsigned char*)(p.ws + WS_Y)};
        pg8::gemm_phase<pg8::EpiY, pg8::MoeOrder, false, true>(F.lds, DEXP / 2, S, E);
    } STAMP(8);
    if (IN(8)) { const Ptrs p = reload_ptrs();
        p8_final(p, F, p.out, [&](auto&& pre) { if (IN(7)) xcd_barrier(bar, pre); else pre(); }); }
    else SEAM(7);
#ifdef NPASS
    }
#endif
#undef IN
#undef SEAM
#undef LSEAM
#undef XL
}

static int g_grid = 0;
static bool mega_setup() {
    if (g_grid != 0) return g_grid > 0;
    int dev = 0, cus = 0, per_cu = 0;
    if (hipGetDevice(&dev) != hipSuccess || hipDeviceGetAttribute(&cus, hipDeviceAttributeMultiprocessorCount, dev) != hipSuccess) { g_grid = -1; return false; }
    if (hipFuncSetAttribute((const void*)mega_fwd, hipFuncAttributeMaxDynamicSharedMemorySize, LDS_BYTES) != hipSuccess) { fprintf(stderr, "kernel_launch: hipFuncSetAttribute failed\n"); g_grid = -1; return false; }
    if (hipOccupancyMaxActiveBlocksPerMultiprocessor(&per_cu, (const void*)mega_fwd, NWAVES * 64, LDS_BYTES) != hipSuccess || per_cu < 1) { fprintf(stderr, "kernel_launch: occupancy query says %d blocks/CU; not launching\n", per_cu); (void)hipGetLastError(); g_grid = -1; return false; }
    g_grid = cus;
    return true;
}
static void mega_launch(const Ptrs& p, int lo, int hi, int li, hipStream_t stream) {
    Args a{}; a.p = p; a.ph_lo = lo; a.ph_hi = hi; a.li = li; a.pad = 0;
    hipLaunchKernelGGL(mega_fwd, dim3(g_grid), dim3(NWAVES * 64), LDS_BYTES, stream, a);
}

extern "C" void kernel_launch(void* const* d_in, const int* in_sizes, int n_in, void* d_out, int out_size, void* d_ws, size_t ws_size, hipStream_t stream) {
    if (n_in != 21 || out_size != MTOK * DM || ws_size < WS_END) { fprintf(stderr, "kernel_launch: unexpected shapes (n_in %d out %d ws %zu)\n", n_in, out_size, ws_size); return; }
    if (!mega_setup()) return;
    Ptrs p{};
    p.x = (const float*)d_in[0]; p.c = (const float*)d_in[1]; p.pos = (const int*)d_in[2]; p.w_ada = (const float*)d_in[3]; p.b_ada = (const float*)d_in[4];
    p.w_in = (const float*)d_in[5]; p.w_out = (const float*)d_in[6]; p.hgrn_lb = (const float*)d_in[7]; p.hgrn_nw = (const float*)d_in[8]; p.ret_nw = (const float*)d_in[9];
    p.ln1w = (const float*)d_in[10]; p.ln1b = (const float*)d_in[11]; p.w_rg = (const float*)d_in[12]; p.b_rg = (const float*)d_in[13]; p.w_re = (const float*)d_in[14]; p.b_re = (const float*)d_in[15];
    p.w_gate = (const float*)d_in[16]; p.w_up = (const float*)d_in[17]; p.w_down = (const float*)d_in[18]; p.ln2w = (const float*)d_in[19]; p.ln2b = (const float*)d_in[20];
    p.out = (float*)d_out; p.ws = (unsigned char*)d_ws;
    (void)hipMemsetAsync((char*)d_ws + WS_CTL, 0, 32768, stream);
    mega_launch(p, 0, 9, 0, stream);
}
```
